# Optimizing an MI355X kernel written in HIP

```python
import jax, jax.numpy as jnp
from jax import lax
import numpy as np

D_MODEL = 1024
BATCH = 32
SEQ = 2048
DEPTH = 4

GRID_W = 64
CTX_LEN = 256
HEAD_DIM = 64
NA_HEADS = 6
NA_WIN_ROWS = 8
NA_WIN_COLS = 16
GQA_Q_HEADS = 6
GQA_KV_HEADS = 2
GQA_GROUP = GQA_Q_HEADS // GQA_KV_HEADS
Q_BLOCK = 128
ROPE_THETA = 10000.0
POOL_WINDOWS = (2, 4, 8, 16)
POOL_GROUP_DIM = 64
POOL_GROUPS = len(POOL_WINDOWS)
POOL_WIDTH = POOL_GROUPS * POOL_GROUP_DIM

NA_WIDTH = NA_HEADS * HEAD_DIM
GQA_WIDTH = GQA_Q_HEADS * HEAD_DIM
GQA_KV_WIDTH = GQA_KV_HEADS * HEAD_DIM
N_BRANCH = 3
D_FF = -(-8 * D_MODEL // (3 * 256)) * 256
N_MOD = 6
EPS = 1e-6
NEG_INF = -1e30
IN_SIZES = (NA_WIDTH, NA_WIDTH, NA_WIDTH, GQA_WIDTH, GQA_KV_WIDTH, GQA_KV_WIDTH, POOL_WIDTH, N_BRANCH * D_MODEL)
IN_WIDTH = sum(IN_SIZES)

kernel_name = "hybrid_natten_gqa_pool_diffusion_trunk"


def rms_norm(x, g):
    xf = x.astype(jnp.float32)
    y = xf * lax.rsqrt(jnp.mean(xf * xf, axis=-1, keepdims=True) + EPS)
    return (y * g.astype(jnp.float32)).astype(x.dtype)


def modulate(x, shift, scale):
    return x * (1 + scale) + shift


def axial_rope(x, row, col):
    quarter = HEAD_DIM // 4
    half = HEAD_DIM // 2
    freqs = ROPE_THETA ** (-jnp.arange(quarter, dtype=jnp.float32) / quarter)

    def rot(xa, pos):
        ang = pos.astype(jnp.float32)[:, None] * freqs[None, :]
        cos = jnp.cos(ang)[None, :, None, :]
        sin = jnp.sin(ang)[None, :, None, :]
        x1 = xa[..., :quarter].astype(jnp.float32)
        x2 = xa[..., quarter:].astype(jnp.float32)
        return jnp.concatenate([x1 * cos - x2 * sin, x2 * cos + x1 * sin], axis=-1)

    out = jnp.concatenate([rot(x[..., :half], row), rot(x[..., half:], col)], axis=-1)
    return out.astype(x.dtype)


def dense_attention(q, k, v):
    s = jnp.einsum('bqhgd,bkhd->bhgqk', q, k).astype(jnp.float32) * (HEAD_DIM ** -0.5)
    p = jax.nn.softmax(s, axis=-1).astype(v.dtype)
    return jnp.einsum('bhgqk,bkhd->bqhgd', p, v)


def gqa_block_attention(q, k, v):
    B, S = q.shape[0], q.shape[1]
    nb = S // Q_BLOCK
    qb = q.reshape(B, nb, Q_BLOCK, GQA_KV_HEADS, GQA_GROUP, HEAD_DIM).swapaxes(0, 1)
    out = lax.map(lambda qi: dense_attention(qi, k, v), qb)
    return out.swapaxes(0, 1).reshape(B, S, GQA_WIDTH)


def neighborhood_attention(q, k, v, k_ctx, v_ctx, rpb):
    B, S, H, dh = q.shape
    rows = S // GRID_W
    wr = min(NA_WIN_ROWS, rows)
    qg = q.reshape(B, rows, GRID_W, H, dh)
    kg = k.reshape(B, rows, GRID_W, H, dh)
    vg = v.reshape(B, rows, GRID_W, H, dh)
    cq = jnp.arange(GRID_W)
    col_start = jnp.clip(cq - NA_WIN_COLS // 2, 0, GRID_W - NA_WIN_COLS)
    col_valid = (cq[None, :] >= col_start[:, None]) & (cq[None, :] < col_start[:, None] + NA_WIN_COLS)
    dc_idx = jnp.clip(cq[None, :] - cq[:, None] + NA_WIN_COLS - 1, 0, 2 * NA_WIN_COLS - 2)
    scale = dh ** -0.5

    def row_step(r):
        rs = jnp.clip(r - wr // 2, 0, rows - wr)
        k_rows = lax.dynamic_slice_in_dim(kg, rs, wr, axis=1)
        v_rows = lax.dynamic_slice_in_dim(vg, rs, wr, axis=1)
        q_row = lax.dynamic_index_in_dim(qg, r, axis=1, keepdims=False)
        s_loc = jnp.einsum('bqhd,brkhd->bhqrk', q_row, k_rows).astype(jnp.float32) * scale
        dr = rs + jnp.arange(wr) - r + NA_WIN_ROWS - 1
        bias = rpb[:, dr[None, :, None], dc_idx[:, None, :]].astype(jnp.float32)
        s_loc = jnp.where(col_valid[:, None, :], s_loc + bias[None], NEG_INF)
        s_ctx = jnp.einsum('bqhd,blhd->bhql', q_row, k_ctx).astype(jnp.float32) * scale
        s = jnp.concatenate([s_loc.reshape(B, H, GRID_W, wr * GRID_W), s_ctx], axis=-1)
        p = jax.nn.softmax(s, axis=-1).astype(v.dtype)
        p_loc = p[..., :wr * GRID_W].reshape(B, H, GRID_W, wr, GRID_W)
        p_ctx = p[..., wr * GRID_W:]
        return (jnp.einsum('bhqrk,brkhd->bqhd', p_loc, v_rows)
                + jnp.einsum('bhql,blhd->bqhd', p_ctx, v_ctx))

    out = lax.map(row_step, jnp.arange(rows))
    return jnp.moveaxis(out, 0, 1).reshape(B, S, H * dh)


def multiscale_pool(v, w_pool, scale):
    B, N, _ = v.shape
    vf = v.astype(jnp.float32)
    cs = jnp.concatenate([jnp.zeros((B, 1, POOL_WIDTH), jnp.float32), jnp.cumsum(vf, axis=1)], axis=1)
    t = jnp.arange(N)
    means = []
    for g, win in enumerate(POOL_WINDOWS):
        lo = jnp.clip(t - win // 2, 0, N)
        hi = jnp.clip(t + win // 2, 0, N)
        csg = cs[..., g * POOL_GROUP_DIM:(g + 1) * POOL_GROUP_DIM]
        means.append((csg[:, hi] - csg[:, lo]) / (hi - lo).astype(jnp.float32)[None, :, None])
    pooled = (jnp.concatenate(means, axis=-1) - vf).astype(v.dtype)
    pooled = pooled.reshape(B, N, POOL_GROUPS, POOL_GROUP_DIM)
    y = jnp.einsum('bngc,gcd->bngd', pooled, w_pool).reshape(B, N, POOL_WIDTH)
    return y * scale


def project(u, w_in, qn_a, kn_a, qn_b, kn_b):
    B, N, _ = u.shape
    z = u @ w_in
    pieces = []
    off = 0
    for sz in IN_SIZES:
        pieces.append(z[..., off:off + sz])
        off += sz
    qa, ka, va, qb, kb, vb, pc, gates = pieces
    qa = rms_norm(qa.reshape(B, N, NA_HEADS, HEAD_DIM), qn_a)
    ka = rms_norm(ka.reshape(B, N, NA_HEADS, HEAD_DIM), kn_a)
    va = va.reshape(B, N, NA_HEADS, HEAD_DIM)
    qb = rms_norm(qb.reshape(B, N, GQA_Q_HEADS, HEAD_DIM), qn_b)
    kb = rms_norm(kb.reshape(B, N, GQA_KV_HEADS, HEAD_DIM), kn_b)
    vb = vb.reshape(B, N, GQA_KV_HEADS, HEAD_DIM)
    return qa, ka, va, qb, kb, vb, pc, gates


def merge_branches(ya, yb, yc, gates, w_br_a, w_br_b, w_br_c, w_out):
    g = jax.nn.sigmoid(gates)
    ga = g[..., :D_MODEL]
    gb = g[..., D_MODEL:2 * D_MODEL]
    gc = g[..., 2 * D_MODEL:]
    m = ga * (ya @ w_br_a) + gb * (yb @ w_br_b) + gc * (yc @ w_br_c)
    return m @ w_out


def swiglu(u, w1, w3, w2):
    return (jax.nn.silu(u @ w1) * (u @ w3)) @ w2


def setup_inputs(seed: int = 0) -> dict:
    key = jax.random.key(seed)
    ks = jax.random.split(key, 32)
    f32 = jnp.float32

    def nrm(k, shape, scale):
        return jax.random.normal(k, shape, f32) * scale

    L = DEPTH
    D = D_MODEL
    return {
        "x": nrm(ks[0], (BATCH, SEQ, D), 1.0),
        "c": nrm(ks[1], (BATCH, D), 1.0),
        "ctx": nrm(ks[2], (BATCH, CTX_LEN, D), 1.0),
        "c_ctx": nrm(ks[3], (D,), 1.0),
        "w_mod": nrm(ks[4], (L, D, N_MOD * D), 0.5 * D ** -0.5),
        "b_mod": nrm(ks[5], (L, N_MOD * D), 0.01),
        "norm1_g": 1.0 + nrm(ks[6], (L, D), 0.02),
        "norm2_g": 1.0 + nrm(ks[7], (L, D), 0.02),
        "w_in": nrm(ks[8], (L, D, IN_WIDTH), D ** -0.5),
        "q_norm_a": 1.0 + nrm(ks[9], (L, HEAD_DIM), 0.02),
        "k_norm_a": 1.0 + nrm(ks[10], (L, HEAD_DIM), 0.02),
        "q_norm_b": 1.0 + nrm(ks[11], (L, HEAD_DIM), 0.02),
        "k_norm_b": 1.0 + nrm(ks[12], (L, HEAD_DIM), 0.02),
        "rpb_a": nrm(ks[13], (L, NA_HEADS, 2 * NA_WIN_ROWS - 1, 2 * NA_WIN_COLS - 1), 0.2),
        "w_pool": nrm(ks[14], (L, POOL_GROUPS, POOL_GROUP_DIM, POOL_GROUP_DIM), POOL_GROUP_DIM ** -0.5),
        "pool_scale": 1.0 + nrm(ks[15], (L, POOL_WIDTH), 0.1),
        "w_br_a": nrm(ks[16], (L, NA_WIDTH, D), NA_WIDTH ** -0.5),
        "w_br_b": nrm(ks[17], (L, GQA_WIDTH, D), GQA_WIDTH ** -0.5),
        "w_br_c": nrm(ks[18], (L, POOL_WIDTH, D), POOL_WIDTH ** -0.5),
        "w_out": nrm(ks[19], (L, D, D), D ** -0.5),
        "w_ff1": nrm(ks[20], (L, D, D_FF), D ** -0.5),
        "w_ff3": nrm(ks[21], (L, D, D_FF), D ** -0.5),
        "w_ff2": nrm(ks[22], (L, D_FF, D), D_FF ** -0.5),
    }


def reference(x, c, ctx, c_ctx, w_mod, b_mod, norm1_g, norm2_g, w_in, q_norm_a, k_norm_a,
              q_norm_b, k_norm_b, rpb_a, w_pool, pool_scale, w_br_a, w_br_b, w_br_c, w_out,
              w_ff1, w_ff3, w_ff2):
    B, S, _ = x.shape
    Lc = ctx.shape[1]
    t = jnp.arange(S)
    row = t // GRID_W
    col = t % GRID_W
    h = ctx
    sc = jax.nn.silu(c)
    sh = jax.nn.silu(c_ctx)
    for l in range(DEPTH):
        last = l == DEPTH - 1
        mod_x = (sc @ w_mod[l] + b_mod[l])[:, None, :]
        mod_h = sh @ w_mod[l] + b_mod[l]
        sx1, cx1, gx1, sx2, cx2, gx2 = jnp.split(mod_x, N_MOD, axis=-1)
        sh1, ch1, gh1, sh2, ch2, gh2 = jnp.split(mod_h, N_MOD, axis=-1)

        ux = modulate(rms_norm(x, norm1_g[l]), sx1, cx1)
        uh = modulate(rms_norm(h, norm1_g[l]), sh1, ch1)
        qa, ka, va, qb, kb, vb, pc, gates = project(ux, w_in[l], q_norm_a[l], k_norm_a[l], q_norm_b[l], k_norm_b[l])
        qa_h, ka_h, va_h, qb_h, kb_h, vb_h, pc_h, gates_h = project(uh, w_in[l], q_norm_a[l], k_norm_a[l], q_norm_b[l], k_norm_b[l])

        ya = neighborhood_attention(qa, ka, va, ka_h, va_h, rpb_a[l])
        qb_r = axial_rope(qb, row, col).reshape(B, S, GQA_KV_HEADS, GQA_GROUP, HEAD_DIM)
        kb_r = axial_rope(kb, row, col)
        yb = gqa_block_attention(qb_r, jnp.concatenate([kb_h, kb_r], axis=1),
                                 jnp.concatenate([vb_h, vb], axis=1))
        yc = multiscale_pool(pc, w_pool[l], pool_scale[l])
        x = x + gx1 * merge_branches(ya, yb, yc, gates, w_br_a[l], w_br_b[l], w_br_c[l], w_out[l])

        u2 = modulate(rms_norm(x, norm2_g[l]), sx2, cx2)
        x = x + gx2 * swiglu(u2, w_ff1[l], w_ff3[l], w_ff2[l])

        if not last:
            ya_h = dense_attention(qa_h[:, :, :, None, :], ka_h, va_h).reshape(B, Lc, NA_WIDTH)
            yb_h = dense_attention(qb_h.reshape(B, Lc, GQA_KV_HEADS, GQA_GROUP, HEAD_DIM), kb_h, vb_h).reshape(B, Lc, GQA_WIDTH)
            yc_h = multiscale_pool(pc_h, w_pool[l], pool_scale[l])
            h = h + gh1 * merge_branches(ya_h, yb_h, yc_h, gates_h, w_br_a[l], w_br_b[l], w_br_c[l], w_out[l])
            u2h = modulate(rms_norm(h, norm2_g[l]), sh2, ch2)
            h = h + gh2 * swiglu(u2h, w_ff1[l], w_ff3[l], w_ff2[l])
    return x
```

```cpp
#include <hip/hip_runtime.h>
#include <hip/hip_cooperative_groups.h>
#include <cstdio>
#include <cstdint>
#include <cmath>
namespace cg = cooperative_groups;

#ifndef MK_PER_PHASE
#define MK_PER_PHASE 0
#endif

#define LAS __attribute__((address_space(3)))
typedef unsigned short bf16_t;
typedef short bf16x8 __attribute__((ext_vector_type(8)));
typedef float f32x4 __attribute__((ext_vector_type(4)));
typedef float f32x2 __attribute__((ext_vector_type(2)));
typedef float f32x16 __attribute__((ext_vector_type(16)));
typedef unsigned u32x4 __attribute__((ext_vector_type(4)));
typedef unsigned u32x2 __attribute__((ext_vector_type(2)));

constexpr int D = 1024, NB = 32, SEQ = 2048, DEPTH = 4, LCTX = 256, GW = 64;
constexpr int TL = NB * SEQ, TC = NB * LCTX, T = TL + TC;
constexpr int NIN = 5120, FF = 2816, NMOD = 6144;
constexpr float EPS = 1e-6f;
constexpr float LOG2E = 1.4426950408889634f;
constexpr float QSCALE = 0.125f * LOG2E;
constexpr int NPH = 2 + 8 * DEPTH;

constexpr size_t WS_CTL = 0, CTL_BYTES = 65536;
constexpr size_t WS_ROPE = WS_CTL + CTL_BYTES;
constexpr size_t WS_MOD = WS_ROPE + 8192;
constexpr size_t WS_SC = WS_MOD + (size_t)DEPTH * 33 * NMOD * 4;
constexpr size_t WS_H = WS_SC + 256 * 1024 * 2;
constexpr size_t WS_WIN = WS_H + (size_t)TC * D * 4;
constexpr size_t WS_WBR = WS_WIN + (size_t)DEPTH * NIN * D * 2;
constexpr size_t WS_WOUT = WS_WBR + (size_t)DEPTH * D * D * 2;
constexpr size_t WS_W13 = WS_WOUT + (size_t)DEPTH * D * D * 2;
constexpr size_t WS_W2 = WS_W13 + (size_t)DEPTH * 2 * FF * D * 2;
constexpr size_t WS_U = WS_W2 + (size_t)DEPTH * D * FF * 2;
constexpr size_t WS_BIG = WS_U + (size_t)T * D * 2;
constexpr size_t WS_END = WS_BIG + (size_t)T * NIN * 2;
static_assert(WS_END <= (size_t)1073741824, "workspace map exceeds 1 GiB");
constexpr size_t B_QA = 0, B_KA = B_QA + (size_t)T * 384, B_VAT = B_KA + (size_t)T * 384, B_QB = B_VAT + (size_t)T * 384, B_KB = B_QB + (size_t)T * 384,
                 B_VBT = B_KB + (size_t)T * 128, B_PC = B_VBT + (size_t)T * 128, B_G = B_PC + (size_t)T * 256;
static_assert(B_G == (size_t)T * 2048, "BIG layout");

constexpr int LDS_BYTES = 131072 + 1024;
constexpr int LDS_MISC = 131072;

__device__ __forceinline__ unsigned f2bf(float f) { unsigned u = __builtin_bit_cast(unsigned, f); return (u + 0x7fffu + ((u >> 16) & 1u)) >> 16; }
__device__ __forceinline__ unsigned pk2(float lo, float hi) { return f2bf(lo) | (f2bf(hi) << 16); }
__device__ __forceinline__ float bf2f(unsigned short h) { return __builtin_bit_cast(float, (unsigned)h << 16); }
__device__ __forceinline__ float bflo(unsigned w) { return __builtin_bit_cast(float, w << 16); }
__device__ __forceinline__ float bfhi(unsigned w) { return __builtin_bit_cast(float, w & 0xffff0000u); }
__device__ __forceinline__ float wave_sum(float v) {
#pragma unroll
    for (int o = 1; o < 64; o <<= 1) v += __shfl_xor(v, o);
    return v;
}
__device__ __forceinline__ float fast_exp2(float x) { return __builtin_amdgcn_exp2f(x); }
__device__ __forceinline__ float fast_rcp(float x) { return __builtin_amdgcn_rcpf(x); }
__device__ __forceinline__ float sigmoidf_(float x) { return 1.0f / (1.0f + __expf(-x)); }

namespace pg8 {
constexpr int BM = 256, BK = 64, HALF = 128, HTB = HALF * BK * 2, NXCD = 8, WGM = 8;
__host__ __device__ __forceinline__ int lds_byte(int r, int c) { const int st = (r >> 4) * 2 + (c >> 5), rr = r & 15, cc = c & 31, ob = rr * 64 + cc * 2; return st * 1024 + (ob ^ (((ob >> 9) & 1) << 5)); }
__host__ __device__ __forceinline__ void stage_rc(int b, int& R, int& C) { const int st = b / 1024, sb = b % 1024, swz = sb ^ (((sb >> 9) & 1) << 5); R = (st >> 1) * 16 + swz / 64; C = (st & 1) * 32 + (swz % 64) / 2; }

struct Unit { int pm, pn; };
struct Gemm { const bf16_t* A; const bf16_t* Bt; int M, N, K; };

struct StaticOrder {
    int nM, nN, nwg, G, c;
    __device__ void init(int M, int N, int G_, int c_) { nM = M / BM; nN = N / BM; nwg = nM * nN; G = G_; c = c_; }
    __device__ bool next(int i, Unit& u) const {
        const long L = (long)i * G + c; if (L >= nwg) return false;
        int wgid = (int)L; { const int q = nwg / NXCD, r = nwg % NXCD, xcd = wgid % NXCD, off = wgid / NXCD; wgid = (xcd < r ? xcd * (q + 1) : r * (q + 1) + (xcd - r) * q) + off; }
        const int nig = WGM * nN, gid = wgid / nig, fm = gid * WGM, gsz = (nM - fm) < WGM ? (nM - fm) : WGM;
        u.pm = fm + ((wgid % nig) % gsz); u.pn = (wgid % nig) / gsz; return true;
    }
};

template <class Epi, class Sched, bool ALIGN_EPI = false, bool SP2 = false>
__device__ __forceinline__ void gemm_phase(LAS unsigned char* lds, const Gemm g, const Sched& S, const Epi& E, const int tid) {
    const int wid = __builtin_amdgcn_readfirstlane(tid >> 6), lane = tid & 63, wr = wid >> 2, wc = wid & 3, fr = lane & 15, fq = lane >> 4;
    const int K = g.K, nt = K / BK;
    unsigned voffA[2], voffB[2];
#pragma unroll
    for (int i = 0; i < 2; ++i) { int R, C; stage_rc(tid * 16 + i * 8192, R, C); voffA[i] = (unsigned)(R * K + C) * 2u; voffB[i] = (unsigned)(R * K + C) * 2u; }
    const size_t kstep = (size_t)(BK * 2);
    const size_t hstep = (size_t)HALF * K * 2;
    const size_t tstep = 2 * hstep;
    const unsigned ldsw = (unsigned)wid * 1024u;
    const int aoff = lds_byte(wr * 64 + fr, fq * 8), boff = lds_byte(wc * 32 + fr, fq * 8);
#define PG8_SA(b, h) (((b) * 2 + (h)) * HTB)
#define PG8_SB(b, h) ((4 + (b) * 2 + (h)) * HTB)
#define PG8_STAGE(bufoff, gbase, voff) do { _Pragma("unroll") for (int _i = 0; _i < 2; ++_i) \
        __builtin_amdgcn_global_load_lds((const unsigned*)((const char*)(gbase) + (voff)[_i]), (LAS unsigned*)(lds + (bufoff) + ldsw + _i * 8192), 16, 0, 0); } while (0)
#define PG8_LDA(dst, b, h) do { _Pragma("unroll") for (int m = 0; m < 4; ++m) _Pragma("unroll") for (int k = 0; k < 2; ++k) dst[m][k] = *(const LAS bf16x8*)(lds + PG8_SA(b, h) + aoff + m * 2048 + k * 1024); } while (0)
#define PG8_LDB(dst, b, h) do { _Pragma("unroll") for (int n = 0; n < 2; ++n) _Pragma("unroll") for (int k = 0; k < 2; ++k) dst[n][k] = *(const LAS bf16x8*)(lds + PG8_SB(b, h) + boff + n * 2048 + k * 1024); } while (0)
#define PG8_MMA(ai, bj, At, Bt) do { __builtin_amdgcn_s_setprio(1); _Pragma("unroll") for (int m = 0; m < 4; ++m) _Pragma("unroll") for (int n = 0; n < 2; ++n) _Pragma("unroll") for (int k = 0; k < 2; ++k) \
        acc[ai][bj][m][n] = __builtin_amdgcn_mfma_f32_16x16x32_bf16(Bt[n][k], At[m][k], acc[ai][bj][m][n], 0, 0, 0); __builtin_amdgcn_s_setprio(0); } while (0)
#define PG8_WAIT_V(n) asm volatile("s_waitcnt vmcnt(" #n ")" ::: "memory")
#define PG8_WAIT_L(n) asm volatile("s_waitcnt lgkmcnt(" #n ")" ::: "memory")
#define PG8_BAR __builtin_amdgcn_s_barrier()
#define PG8_SCHED __builtin_amdgcn_sched_barrier(0)
    Unit cur, nxt; int ui = 0;
    if (!S.next(0, cur)) return;
    f32x4 acc[2][2][4][2];
#pragma unroll
    for (int a = 0; a < 2; ++a)
#pragma unroll
        for (int b = 0; b < 2; ++b)
#pragma unroll
            for (int m = 0; m < 4; ++m)
#pragma unroll
                for (int n = 0; n < 2; ++n) acc[a][b][m][n] = (f32x4){0.f, 0.f, 0.f, 0.f};
    bf16x8 At[4][2], B0[2][2], B1[2][2];
    const char* cA = (const char*)g.A + (size_t)cur.pm * tstep; const char* cB = (const char*)g.Bt + (size_t)cur.pn * tstep;
    if constexpr (SP2) {
        PG8_STAGE(PG8_SB(0, 0), cB, voffB); PG8_STAGE(PG8_SB(0, 1), cB + hstep, voffB); PG8_STAGE(PG8_SA(0, 0), cA, voffA); PG8_STAGE(PG8_SA(0, 1), cA + hstep, voffA);
        if (wr == 1) PG8_BAR;
        PG8_WAIT_V(2); PG8_BAR;
        PG8_STAGE(PG8_SB(1, 0), cB + kstep, voffB); PG8_STAGE(PG8_SA(1, 0), cA + kstep, voffA); PG8_STAGE(PG8_SB(1, 1), cB + hstep + kstep, voffB);
        PG8_WAIT_V(6); PG8_BAR;
    } else {
        PG8_STAGE(PG8_SB(0, 0), cB, voffB); PG8_STAGE(PG8_SA(0, 0), cA, voffA); PG8_STAGE(PG8_SB(0, 1), cB + hstep, voffB); PG8_STAGE(PG8_SA(0, 1), cA + hstep, voffA);
        if (wr == 1) PG8_BAR;
        PG8_WAIT_V(4); PG8_BAR;
        PG8_STAGE(PG8_SB(1, 0), cB + kstep, voffB); PG8_STAGE(PG8_SA(1, 0), cA + kstep, voffA); PG8_STAGE(PG8_SB(1, 1), cB + hstep + kstep, voffB);
        PG8_WAIT_V(6); PG8_BAR;
    }
    for (;;) {
        const bool has_next = S.next(ui + 1, nxt);
        const char* nA = has_next ? (const char*)g.A + (size_t)nxt.pm * tstep : cA; const char* nB = has_next ? (const char*)g.Bt + (size_t)nxt.pn * tstep : cB;
        for (int t = 0; t < nt; t += 2) {
            if constexpr (Epi::MID) { if (t == 6 || t == 12) E.mid(acc, cur, t == 6 ? 0 : 1, wr, wc, fr, fq); }
            const bool last = (t == nt - 2);
            const char* a1 = cA + (size_t)(t + 1) * kstep;
            const char* a2 = last ? nA : cA + (size_t)(t + 2) * kstep; const char* b2 = last ? nB : cB + (size_t)(t + 2) * kstep;
            const char* a3 = a2 + kstep; const char* b3 = b2 + kstep;
            if constexpr (SP2) {
            PG8_LDB(B0, 0, 0); PG8_LDB(B1, 0, 1); PG8_SCHED; PG8_LDA(At, 0, 0); PG8_STAGE(PG8_SA(1, 1), a1 + hstep, voffA);
            PG8_WAIT_V(8); PG8_WAIT_L(0); PG8_BAR; PG8_MMA(0, 0, At, B0); PG8_MMA(0, 1, At, B1); PG8_BAR; PG8_SCHED;
            PG8_LDA(At, 0, 1); PG8_STAGE(PG8_SB(0, 0), b2, voffB); PG8_STAGE(PG8_SB(0, 1), b2 + hstep, voffB); PG8_STAGE(PG8_SA(0, 0), a2, voffA);
            PG8_WAIT_V(8); PG8_WAIT_L(0); PG8_BAR; PG8_MMA(1, 0, At, B0); PG8_MMA(1, 1, At, B1); PG8_BAR; PG8_SCHED;
            PG8_LDB(B0, 1, 0); PG8_LDB(B1, 1, 1); PG8_SCHED; PG8_LDA(At, 1, 0); PG8_STAGE(PG8_SA(0, 1), a2 + hstep, voffA);
            PG8_WAIT_V(8); PG8_WAIT_L(0); PG8_BAR; PG8_MMA(0, 0, At, B0); PG8_MMA(0, 1, At, B1); PG8_BAR; PG8_SCHED;
            PG8_LDA(At, 1, 1); PG8_STAGE(PG8_SB(1, 0), b3, voffB); PG8_STAGE(PG8_SB(1, 1), b3 + hstep, voffB); PG8_STAGE(PG8_SA(1, 0), a3, voffA);
            PG8_WAIT_V(8); PG8_WAIT_L(0); PG8_BAR; PG8_MMA(1, 0, At, B0); PG8_MMA(1, 1, At, B1); PG8_BAR; PG8_SCHED;
            } else {
            PG8_LDB(B0, 0, 0); PG8_SCHED; PG8_LDA(At, 0, 0); PG8_STAGE(PG8_SA(1, 1), a1 + hstep, voffA);
            PG8_WAIT_L(8); PG8_BAR; PG8_WAIT_L(0); PG8_MMA(0, 0, At, B0); PG8_BAR; PG8_SCHED;
            PG8_LDB(B1, 0, 1); PG8_STAGE(PG8_SB(0, 0), b2, voffB);
            PG8_BAR; PG8_WAIT_L(0); PG8_MMA(0, 1, At, B1); PG8_BAR;
            PG8_LDA(At, 0, 1); PG8_STAGE(PG8_SA(0, 0), a2, voffA);
            PG8_BAR; PG8_WAIT_L(0); PG8_MMA(1, 0, At, B0); PG8_BAR; PG8_SCHED;
            PG8_STAGE(PG8_SB(0, 1), b2 + hstep, voffB);
            PG8_WAIT_V(6); PG8_BAR; PG8_MMA(1, 1, At, B1); PG8_BAR;
            PG8_LDB(B0, 1, 0); PG8_SCHED; PG8_LDA(At, 1, 0); PG8_STAGE(PG8_SA(0, 1), a2 + hstep, voffA);
            PG8_WAIT_L(8); PG8_BAR; PG8_WAIT_L(0); PG8_MMA(0, 0, At, B0); PG8_BAR; PG8_SCHED;
            PG8_LDB(B1, 1, 1); PG8_STAGE(PG8_SB(1, 0), b3, voffB);
            PG8_BAR; PG8_WAIT_L(0); PG8_MMA(0, 1, At, B1); PG8_BAR;
            PG8_LDA(At, 1, 1); PG8_STAGE(PG8_SA(1, 0), a3, voffA);
            PG8_BAR; PG8_WAIT_L(0); PG8_MMA(1, 0, At, B0); PG8_BAR; PG8_SCHED;
            PG8_STAGE(PG8_SB(1, 1), b3 + hstep, voffB);
            PG8_WAIT_V(6); PG8_BAR; PG8_MMA(1, 1, At, B1); PG8_BAR;
            }
        }
        if constexpr (ALIGN_EPI) { if (wr == 0) PG8_BAR; }
        E(acc, cur, wr, wc, fr, fq);
        if (!has_next) break;
#pragma unroll
        for (int a = 0; a < 2; ++a)
#pragma unroll
            for (int b = 0; b < 2; ++b)
#pragma unroll
                for (int m = 0; m < 4; ++m)
#pragma unroll
                    for (int n = 0; n < 2; ++n) acc[a][b][m][n] = (f32x4){0.f, 0.f, 0.f, 0.f};
        cur = nxt; cA = nA; cB = nB; ++ui;
        if constexpr (ALIGN_EPI) { if (wr == 1) PG8_BAR; }
    }
    PG8_WAIT_V(0);
    if constexpr (!ALIGN_EPI) { if (wr == 0) PG8_BAR; }
    PG8_BAR;
#undef PG8_SA
#undef PG8_SB
#undef PG8_STAGE
#undef PG8_LDA
#undef PG8_LDB
#undef PG8_MMA
#undef PG8_WAIT_V
#undef PG8_WAIT_L
#undef PG8_BAR
#undef PG8_SCHED
}
}
using pg8::Unit;

struct EpiIn {
    static constexpr bool MID = false;
    bf16_t* big; const float* qn_a; const float* kn_a; const float* qn_b; const float* kn_b; const f32x2* rope;
    __device__ __forceinline__ void operator()(const f32x4 (&acc)[2][2][4][2], const Unit& u, int wr, int wc, int fr, int fq) const {
        const int hg = u.pn * 4 + wc;
        int kind; bf16_t* dst; int pitch, hcol; const float* gain = nullptr;
        if (hg < 6)       { kind = 1 | 256; dst = big + B_QA; pitch = 384; hcol = hg * 64; gain = qn_a; }
        else if (hg < 12) { kind = 1;       dst = big + B_KA; pitch = 384; hcol = (hg - 6) * 64; gain = kn_a; }
        else if (hg < 18) { kind = 3;       dst = big + B_VAT; pitch = T; hcol = (hg - 12) * 64; }
        else if (hg < 24) { kind = 2 | 256; dst = big + B_QB; pitch = 384; hcol = (hg - 18) * 64; gain = qn_b; }
        else if (hg < 26) { kind = 2;       dst = big + B_KB; pitch = 128; hcol = (hg - 24) * 64; gain = kn_b; }
        else if (hg < 28) { kind = 3;       dst = big + B_VBT; pitch = T; hcol = (hg - 26) * 64; }
        else if (hg < 32) { kind = 0;       dst = big + B_PC; pitch = 256; hcol = (hg - 28) * 64; }
        else              { kind = 4;       dst = big + B_G; pitch = 3072; hcol = (hg - 32) * 64; }
        const int k = kind & 255; const float qs = (kind & 256) ? QSCALE : 1.0f;
        f32x4 gv[2][2];
        if (k == 1 || k == 2) {
#pragma unroll
            for (int bj = 0; bj < 2; ++bj)
#pragma unroll
                for (int n = 0; n < 2; ++n) gv[bj][n] = *(const f32x4*)(gain + 32 * bj + 16 * n + 4 * fq) * qs;
        }
#pragma unroll
        for (int ai = 0; ai < 2; ++ai)
#pragma unroll
            for (int m = 0; m < 4; ++m) {
                const int row = u.pm * 256 + ai * 128 + wr * 64 + m * 16 + fr;
                f32x4 v[2][2];
#pragma unroll
                for (int bj = 0; bj < 2; ++bj)
#pragma unroll
                    for (int n = 0; n < 2; ++n) v[bj][n] = acc[ai][bj][m][n];
                if (k == 1 || k == 2) {
                    float ss = 0.f;
#pragma unroll
                    for (int bj = 0; bj < 2; ++bj)
#pragma unroll
                        for (int n = 0; n < 2; ++n) { const f32x4 x = v[bj][n]; ss += (x[0] * x[0] + x[1] * x[1]) + (x[2] * x[2] + x[3] * x[3]); }
                    ss += __shfl_xor(ss, 16); ss += __shfl_xor(ss, 32);
                    const float rinv = rsqrtf(ss * (1.0f / 64.0f) + EPS);
#pragma unroll
                    for (int bj = 0; bj < 2; ++bj)
#pragma unroll
                        for (int n = 0; n < 2; ++n) v[bj][n] = v[bj][n] * rinv * gv[bj][n];
                    if (k == 2 && row < TL) {
                        const int t = row & (SEQ - 1);
#pragma unroll
                        for (int bj = 0; bj < 2; ++bj) {
                            const int pos = bj ? (t & 63) : (t >> 6);
                            const f32x2* rp = rope + pos * 16 + 4 * fq;
#pragma unroll
                            for (int j = 0; j < 4; ++j) { const f32x2 cs = rp[j]; const float x1 = v[bj][0][j], x2 = v[bj][1][j];
                                v[bj][0][j] = x1 * cs.x - x2 * cs.y; v[bj][1][j] = x2 * cs.x + x1 * cs.y; }
                        }
                    }
                } else if (k == 4) {
#pragma unroll
                    for (int bj = 0; bj < 2; ++bj)
#pragma unroll
                        for (int n = 0; n < 2; ++n)
#pragma unroll
                            for (int j = 0; j < 4; ++j) v[bj][n][j] = sigmoidf_(v[bj][n][j]);
                }
                if (k == 3) {
#pragma unroll
                    for (int bj = 0; bj < 2; ++bj)
#pragma unroll
                        for (int n = 0; n < 2; ++n)
#pragma unroll
                            for (int j = 0; j < 4; ++j) dst[(size_t)(hcol + 32 * bj + 16 * n + 4 * fq + j) * T + row] = (bf16_t)f2bf(v[bj][n][j]);
                } else {
                    bf16_t* rp = dst + (size_t)row * pitch + hcol + 4 * fq;
#pragma unroll
                    for (int bj = 0; bj < 2; ++bj)
#pragma unroll
                        for (int n = 0; n < 2; ++n) { u32x2 w; w.x = pk2(v[bj][n][0], v[bj][n][1]); w.y = pk2(v[bj][n][2], v[bj][n][3]); *(u32x2*)(rp + 32 * bj + 16 * n) = w; }
                }
            }
    }
};

struct EpiMerge {
    static constexpr bool MID = true;
    const bf16_t* G; bf16_t* Mo;
    __device__ __forceinline__ void mid(f32x4 (&acc)[2][2][4][2], const Unit& u, int which, int wr, int wc, int fr, int fq) const {
#pragma unroll
        for (int ai = 0; ai < 2; ++ai)
#pragma unroll
            for (int m = 0; m < 4; ++m) {
                const int row = u.pm * 256 + ai * 128 + wr * 64 + m * 16 + fr;
#pragma unroll
                for (int bj = 0; bj < 2; ++bj) {
                    const bf16_t* gp = G + (size_t)row * 3072 + which * 1024 + u.pn * 256 + 128 * bj + 32 * wc + 8 * fq;
                    const u32x4 a = *(const u32x4*)gp, b = *(const u32x4*)(gp + 1024);
#pragma unroll
                    for (int n = 0; n < 2; ++n) {
                        const unsigned a0 = n ? a.z : a.x, a1 = n ? a.w : a.y, b0 = n ? b.z : b.x, b1 = n ? b.w : b.y;
                        acc[ai][bj][m][n][0] *= bflo(a0) / bflo(b0); acc[ai][bj][m][n][1] *= bfhi(a0) / bfhi(b0);
                        acc[ai][bj][m][n][2] *= bflo(a1) / bflo(b1); acc[ai][bj][m][n][3] *= bfhi(a1) / bfhi(b1);
                    }
                }
            }
    }
    __device__ __forceinline__ void operator()(const f32x4 (&acc)[2][2][4][2], const Unit& u, int wr, int wc, int fr, int fq) const {
#pragma unroll
        for (int ai = 0; ai < 2; ++ai)
#pragma unroll
            for (int m = 0; m < 4; ++m) {
                const int row = u.pm * 256 + ai * 128 + wr * 64 + m * 16 + fr;
#pragma unroll
                for (int bj = 0; bj < 2; ++bj) {
                    const int col = u.pn * 256 + 128 * bj + 32 * wc + 8 * fq;
                    const u32x4 c = *(const u32x4*)(G + (size_t)row * 3072 + 2048 + col);
                    const f32x4 x0 = acc[ai][bj][m][0], x1 = acc[ai][bj][m][1];
                    u32x4 w;
                    w.x = pk2(x0[0] * bflo(c.x), x0[1] * bfhi(c.x)); w.y = pk2(x0[2] * bflo(c.y), x0[3] * bfhi(c.y));
                    w.z = pk2(x1[0] * bflo(c.z), x1[1] * bfhi(c.z)); w.w = pk2(x1[2] * bflo(c.w), x1[3] * bfhi(c.w));
                    *(u32x4*)(Mo + (size_t)row * D + col) = w;
                }
            }
    }
};

struct EpiRes {
    static constexpr bool MID = false;
    const float* xs; float* xd; const float* hs; float* hd; const float* modl; int goff;
    __device__ __forceinline__ void operator()(const f32x4 (&acc)[2][2][4][2], const Unit& u, int wr, int wc, int fr, int fq) const {
        const int row0 = u.pm * 256; const bool lat = row0 < TL;
        const int b = lat ? (row0 >> 11) : 32;
        const float* src = lat ? xs + (size_t)row0 * D : hs + (size_t)(row0 - TL) * D;
        float* dst = lat ? xd + (size_t)row0 * D : hd + (size_t)(row0 - TL) * D;
        const float* gp = modl + (size_t)b * NMOD + goff;
#pragma unroll
        for (int bj = 0; bj < 2; ++bj) {
            const int col = u.pn * 256 + 128 * bj + 32 * wc + 8 * fq;
            const f32x4 g0 = *(const f32x4*)(gp + col), g1 = *(const f32x4*)(gp + col + 4);
#pragma unroll
            for (int ai = 0; ai < 2; ++ai)
#pragma unroll
                for (int m = 0; m < 4; ++m) {
                    const size_t o = (size_t)(ai * 128 + wr * 64 + m * 16 + fr) * D + col;
                    const f32x4 s0 = *(const f32x4*)(src + o), s1 = *(const f32x4*)(src + o + 4);
                    *(f32x4*)(dst + o) = s0 + g0 * acc[ai][bj][m][0];
                    *(f32x4*)(dst + o + 4) = s1 + g1 * acc[ai][bj][m][1];
                }
        }
    }
};

struct EpiFF1 {
    static constexpr bool MID = false;
    bf16_t* H1;
    __device__ __forceinline__ void operator()(const f32x4 (&acc)[2][2][4][2], const Unit& u, int wr, int wc, int fr, int fq) const {
        const int col = u.pn * 128 + 32 * wc + 8 * fq;
#pragma unroll
        for (int ai = 0; ai < 2; ++ai)
#pragma unroll
            for (int m = 0; m < 4; ++m) {
                const int row = u.pm * 256 + ai * 128 + wr * 64 + m * 16 + fr;
                float r[8];
#pragma unroll
                for (int n = 0; n < 2; ++n)
#pragma unroll
                    for (int j = 0; j < 4; ++j) { const float a = acc[ai][0][m][n][j], b = acc[ai][1][m][n][j]; r[4 * n + j] = a * sigmoidf_(a) * b; }
                u32x4 w; w.x = pk2(r[0], r[1]); w.y = pk2(r[2], r[3]); w.z = pk2(r[4], r[5]); w.w = pk2(r[6], r[7]);
                *(u32x4*)(H1 + (size_t)row * FF + col) = w;
            }
    }
};

struct EpiMod {
    static constexpr bool MID = false;
    float* mod; const float* bmod;
    __device__ __forceinline__ void operator()(const f32x4 (&acc)[2][2][4][2], const Unit& u, int wr, int wc, int fr, int fq) const {
        if (wr != 0) return;
#pragma unroll
        for (int m = 0; m < 3; ++m) {
            const int row = m * 16 + fr; if (row >= 33) continue;
#pragma unroll
            for (int bj = 0; bj < 2; ++bj)
#pragma unroll
                for (int n = 0; n < 2; ++n) {
                    const int nn = u.pn * 256 + 128 * bj + 32 * wc + 16 * n + 4 * fq;
                    const int l = nn / NMOD, c = nn - l * NMOD;
                    const f32x4 bv = *(const f32x4*)(bmod + nn);
                    *(f32x4*)(mod + ((size_t)l * 33 + row) * NMOD + c) = acc[0][bj][m][n] + bv;
                }
        }
    }
};

struct Args { const float* in[23]; float* out; unsigned char* ws; float freq[16]; int ph_lo, ph_hi; };
typedef const __attribute__((address_space(4))) Args* KArgsPtr;

__device__ __forceinline__ int p8map(int p) { return (p & 0xe0) | (((p >> 2) & 3) << 3) | (((p >> 4) & 1) << 2) | (p & 3); }
__device__ __forceinline__ void prep_item(KArgsPtr a, unsigned char* ws, int l, int mid, int item, LAS float* scr, int lane) {
    int K, N; if (mid == 0) { K = D; N = NIN; } else if (mid == 1 || mid == 2) { K = D; N = D; } else if (mid == 3) { K = D; N = 2 * FF; } else if (mid == 4) { K = FF; N = D; } else { K = D; N = NMOD; }
    const int nblk = N / 32, kb = item / nblk, nb = item % nblk, k0 = 64 * kb, n0 = 32 * nb;
    const int r = n0 + (lane & 31), tile = r >> 8, p = r & 255;
    const float* src; int ld, col, krow = k0; bf16_t* WT;
    if (mid == 0) { src = a->in[8] + (size_t)l * D * NIN; ld = NIN; col = tile * 256 + ((p >> 5) & 3) * 64 + (p >> 7) * 32 + (p & 31); WT = (bf16_t*)(ws + WS_WIN) + (size_t)l * NIN * D; }
    else if (mid == 1) { ld = D; col = tile * 256 + p8map(p); WT = (bf16_t*)(ws + WS_WBR) + (size_t)l * D * D;
        if (k0 < 384) { src = a->in[16] + (size_t)l * 384 * D; } else if (k0 < 768) { src = a->in[17] + (size_t)l * 384 * D; krow = k0 - 384; } else { src = a->in[18] + (size_t)l * 256 * D; krow = k0 - 768; } }
    else if (mid == 2) { src = a->in[19] + (size_t)l * D * D; ld = D; col = tile * 256 + p8map(p); WT = (bf16_t*)(ws + WS_WOUT) + (size_t)l * D * D; }
    else if (mid == 3) { src = ((p >> 7) ? a->in[21] : a->in[20]) + (size_t)l * D * FF; ld = FF; col = tile * 128 + (p8map(p) & 127); WT = (bf16_t*)(ws + WS_W13) + (size_t)l * 2 * FF * D; }
    else if (mid == 4) { src = a->in[22] + (size_t)l * FF * D; ld = D; col = tile * 256 + p8map(p); WT = (bf16_t*)(ws + WS_W2) + (size_t)l * D * FF; }
    else { src = a->in[4] + (size_t)l * D * NMOD; ld = NMOD; col = r; WT = (bf16_t*)(ws + WS_BIG) + (size_t)l * NMOD * D; }
#pragma unroll 8
    for (int i = 0; i < 32; ++i) { const int kk = 2 * i + (lane >> 5); scr[kk * 33 + (lane & 31)] = src[(size_t)(krow + kk) * ld + col]; }
    asm volatile("s_waitcnt lgkmcnt(0)" ::: "memory");
    const int c = lane & 7;
#pragma unroll
    for (int j = 0; j < 4; ++j) { const int n = (lane >> 3) + 8 * j; const LAS float* s = scr + (8 * c) * 33 + n;
        u32x4 o; o.x = pk2(s[0 * 33], s[1 * 33]); o.y = pk2(s[2 * 33], s[3 * 33]); o.z = pk2(s[4 * 33], s[5 * 33]); o.w = pk2(s[6 * 33], s[7 * 33]);
        *(u32x4*)(WT + (size_t)(n0 + n) * K + k0 + 8 * c) = o; }
    asm volatile("s_waitcnt lgkmcnt(0)" ::: "memory");
}

__device__ __forceinline__ void prep_phase(KArgsPtr a, LAS unsigned char* lds, int tid, int wid, int lane, int bid, int nblk_) {
    unsigned char* ws = a->ws;
    LAS float* scr = (LAS float*)(lds + wid * 8704);
    const int gw = bid * 8 + wid, NGW = nblk_ * 8;
    constexpr int I0 = 16 * 160, I1 = 16 * 32, I2 = 16 * 32, I3 = 16 * 176, I4 = 44 * 32, I5 = 16 * 192, IL = I0 + I1 + I2 + I3 + I4 + I5;
    for (int it = gw; it < IL * DEPTH; it += NGW) {
        const int l = it / IL; int r = it - l * IL; int mid;
        if (r < I0) mid = 0; else if ((r -= I0) < I1) mid = 1; else if ((r -= I1) < I2) mid = 2; else if ((r -= I2) < I3) mid = 3; else if ((r -= I3) < I4) mid = 4; else { r -= I4; mid = 5; }
        prep_item(a, ws, l, mid, r, scr, lane);
    }
    bf16_t* SC = (bf16_t*)(ws + WS_SC);
    for (int i = bid * 512 + tid; i < 256 * 1024; i += nblk_ * 512) {
        const int row = i >> 10, k = i & 1023; float v = 0.f;
        if (row < 32) v = a->in[1][row * D + k]; else if (row == 32) v = a->in[3][k];
        SC[i] = (bf16_t)f2bf(row <= 32 ? v * sigmoidf_(v) : 0.f);
    }
    f32x2* rope = (f32x2*)(ws + WS_ROPE);
    for (int i = bid * 512 + tid; i < 64 * 16; i += nblk_ * 512) {
        const int pos = i >> 4, fi = i & 15;
        const float ang = (float)pos * a->freq[fi];
        float rev = ang * 0.15915494309189535f; rev = rev - floorf(rev);
        rope[i] = (f32x2){__builtin_amdgcn_cosf(rev), __builtin_amdgcn_sinf(rev)};
    }
}

__device__ __forceinline__ void norm_phase(const float* xl, const float* xc, const float* gain, const float* modl, int shift_off, int nrows, bf16_t* U, int wid, int lane, int bid, int nblk_) {
    const int gw = bid * 8 + wid, NGW = nblk_ * 8;
    f32x4 gv[4];
#pragma unroll
    for (int j = 0; j < 4; ++j) gv[j] = *(const f32x4*)(gain + 4 * (lane + 64 * j));
    for (int row = gw; row < nrows; row += NGW) {
        const bool lat = row < TL; const int b = lat ? (row >> 11) : 32;
        const float* src = lat ? xl + (size_t)row * D : xc + (size_t)(row - TL) * D;
        const float* mp = modl + (size_t)b * NMOD + shift_off;
        f32x4 v[4]; float ss = 0.f;
#pragma unroll
        for (int j = 0; j < 4; ++j) { v[j] = *(const f32x4*)(src + 4 * (lane + 64 * j)); ss += (v[j][0] * v[j][0] + v[j][1] * v[j][1]) + (v[j][2] * v[j][2] + v[j][3] * v[j][3]); }
        const float rstd = rsqrtf(wave_sum(ss) * (1.0f / D) + EPS);
#pragma unroll
        for (int j = 0; j < 4; ++j) {
            const int c = 4 * (lane + 64 * j);
            const f32x4 sh = *(const f32x4*)(mp + c), sc = *(const f32x4*)(mp + D + c);
            const f32x4 y = v[j] * rstd * gv[j] * (sc + 1.0f) + sh;
            u32x2 w; w.x = pk2(y[0], y[1]); w.y = pk2(y[2], y[3]);
            *(u32x2*)(U + (size_t)row * D + c) = w;
        }
    }
}

struct AttnJob {
    const bf16_t* Q; int qpitch;
    const bf16_t* K; int kpitch;
    const bf16_t* Vt;
    bf16_t* O;
    int ctx_row0, lat_row0, ntiles;
    int na, r0, rlo;
};
#define MFMA32(a, b, c) __builtin_amdgcn_mfma_f32_32x32x16_bf16((a), (b), (c), 0, 0, 0)

__device__ __forceinline__ void attn_unit(LAS unsigned char* lds, const AttnJob& J, const LAS float* biasL, int tid, int wid, int lane) {
    const int q = lane & 31, hi = lane >> 5;
    bf16x8 qf[4];
    { const bf16_t* qrow = J.Q + (size_t)(wid * 32 + q) * J.qpitch + 8 * hi;
#pragma unroll
      for (int ks = 0; ks < 4; ++ks) qf[ks] = *(const bf16x8*)(qrow + 16 * ks); }
    f32x16 o0, o1;
#pragma unroll
    for (int i = 0; i < 16; ++i) { o0[i] = 0.f; o1[i] = 0.f; }
    float mrun = -1e30f, lrun = 0.f;
    const int srow = tid >> 3, sch = tid & 7;
    const unsigned soff = (unsigned)(srow * 128 + ((sch ^ ((srow >> 1) & 7)) << 4));
    const int pi = (q & 0x13) | ((q & 4) << 1) | ((q & 8) >> 1);
    const int kx = (pi >> 1) & 7, vx = (q >> 1) & 7;
    const int rq = J.r0 + (wid >> 1), cq = (wid & 1) * 32 + q;
    const int rs_ = min(max(rq - 4, 0), 24), cs_ = min(max(cq - 8, 0), 48);

    u32x4 kreg, vreg;
    { const int tok = J.ctx_row0;
      kreg = *(const u32x4*)(J.K + (size_t)(tok + srow) * J.kpitch + sch * 8);
      vreg = *(const u32x4*)(J.Vt + (size_t)srow * T + tok + sch * 8); }
    *(LAS u32x4*)(lds + soff) = kreg; *(LAS u32x4*)(lds + 8192 + soff) = vreg;
    __syncthreads();
    for (int it = 0; it < J.ntiles; ++it) {
        LAS unsigned char* kb_ = lds + (it & 1) * 16384;
        LAS unsigned char* vb_ = kb_ + 8192;
        const bool more = it + 1 < J.ntiles;
        if (more) { const int i1 = it + 1; const int tok = i1 < 4 ? J.ctx_row0 + 64 * i1 : J.lat_row0 + 64 * (i1 - 4);
            kreg = *(const u32x4*)(J.K + (size_t)(tok + srow) * J.kpitch + sch * 8);
            vreg = *(const u32x4*)(J.Vt + (size_t)srow * T + tok + sch * 8); }
        const int kr = J.rlo + it - 4;
        const bool local = J.na && it >= 4;
        const bool active = !local || (kr >= rs_ && kr < rs_ + 8);
        if (active) {
            f32x16 s0, s1;
#pragma unroll
            for (int i = 0; i < 16; ++i) { s0[i] = 0.f; s1[i] = 0.f; }
#pragma unroll
            for (int ks = 0; ks < 4; ++ks) {
                const bf16x8 a0 = *(const LAS bf16x8*)(kb_ + pi * 128 + (((2 * ks + hi) ^ kx) << 4));
                const bf16x8 a1 = *(const LAS bf16x8*)(kb_ + (32 + pi) * 128 + (((2 * ks + hi) ^ kx) << 4));
                s0 = MFMA32(a0, qf[ks], s0); s1 = MFMA32(a1, qf[ks], s1);
            }
            if (local) {
                const LAS float* bp = biasL + (kr - rq + 7) * 31;
#pragma unroll
                for (int i = 0; i < 16; ++i) {
                    const int kc0 = 16 * (i >> 3) + 8 * hi + (i & 7), kc1 = kc0 + 32;
                    const int d0 = kc0 - cq + 15, d1 = kc1 - cq + 15;
                    const float b0 = bp[min(max(d0, 0), 30)], b1 = bp[min(max(d1, 0), 30)];
                    s0[i] = ((unsigned)(kc0 - cs_) < 16u) ? s0[i] + b0 : -1e30f;
                    s1[i] = ((unsigned)(kc1 - cs_) < 16u) ? s1[i] + b1 : -1e30f;
                }
            }
            float mt = fmaxf(s0[0], s1[0]);
#pragma unroll
            for (int i = 1; i < 16; ++i) mt = fmaxf(mt, fmaxf(s0[i], s1[i]));
            mt = fmaxf(mt, __shfl_xor(mt, 32));
            const float mn = fmaxf(mrun, mt);
            const float alpha = fast_exp2(mrun - mn); mrun = mn;
            float rs = 0.f;
#pragma unroll
            for (int i = 0; i < 16; ++i) { s0[i] = fast_exp2(s0[i] - mn); s1[i] = fast_exp2(s1[i] - mn); rs += s0[i] + s1[i]; }
            rs += __shfl_xor(rs, 32);
            lrun = lrun * alpha + rs;
#pragma unroll
            for (int i = 0; i < 16; ++i) { o0[i] *= alpha; o1[i] *= alpha; }
            bf16x8 pf[2][2];
#pragma unroll
            for (int cc = 0; cc < 2; ++cc) {
                u32x4 w0, w1;
                w0.x = pk2(s0[8 * cc + 0], s0[8 * cc + 1]); w0.y = pk2(s0[8 * cc + 2], s0[8 * cc + 3]); w0.z = pk2(s0[8 * cc + 4], s0[8 * cc + 5]); w0.w = pk2(s0[8 * cc + 6], s0[8 * cc + 7]);
                w1.x = pk2(s1[8 * cc + 0], s1[8 * cc + 1]); w1.y = pk2(s1[8 * cc + 2], s1[8 * cc + 3]); w1.z = pk2(s1[8 * cc + 4], s1[8 * cc + 5]); w1.w = pk2(s1[8 * cc + 6], s1[8 * cc + 7]);
                pf[0][cc] = __builtin_bit_cast(bf16x8, w0); pf[1][cc] = __builtin_bit_cast(bf16x8, w1);
            }
#pragma unroll
            for (int kb = 0; kb < 2; ++kb)
#pragma unroll
                for (int cc = 0; cc < 2; ++cc) {
                    const int ch = 4 * kb + 2 * cc + hi;
                    const bf16x8 v0 = *(const LAS bf16x8*)(vb_ + q * 128 + ((ch ^ vx) << 4));
                    const bf16x8 v1 = *(const LAS bf16x8*)(vb_ + (32 + q) * 128 + ((ch ^ vx) << 4));
                    o0 = MFMA32(v0, pf[kb][cc], o0); o1 = MFMA32(v1, pf[kb][cc], o1);
                }
        }
        if (more) { LAS unsigned char* nb = lds + ((it + 1) & 1) * 16384; *(LAS u32x4*)(nb + soff) = kreg; *(LAS u32x4*)(nb + 8192 + soff) = vreg; }
        __syncthreads();
    }
    const float inv = 1.0f / lrun;
    bf16_t* orow = J.O + (size_t)(wid * 32 + q) * D + 4 * hi;
#pragma unroll
    for (int c = 0; c < 4; ++c) {
        u32x2 w0, w1;
        w0.x = pk2(o0[4 * c] * inv, o0[4 * c + 1] * inv); w0.y = pk2(o0[4 * c + 2] * inv, o0[4 * c + 3] * inv);
        w1.x = pk2(o1[4 * c] * inv, o1[4 * c + 1] * inv); w1.y = pk2(o1[4 * c + 2] * inv, o1[4 * c + 3] * inv);
        *(u32x2*)(orow + 8 * c) = w0; *(u32x2*)(orow + 32 + 8 * c) = w1;
    }
}

__device__ __forceinline__ void pool_unit(LAS unsigned char* lds, const bf16_t* PC, const float* wpool, const float* pscale, bf16_t* Y, int unit, int tid) {
    const int row0 = unit * 64;
    const int seq0 = row0 < TL ? (row0 & ~(SEQ - 1)) : TL + ((row0 - TL) & ~(LCTX - 1));
    const int N = row0 < TL ? SEQ : LCTX;
    const int t0 = row0 - seq0;
    LAS unsigned short* vin = (LAS unsigned short*)lds;
    LAS float* pooled = (LAS float*)(lds + 40960);
    for (int i = tid; i < 80 * 32; i += 512) {
        const int lr = i >> 5, ch8 = i & 31, t = t0 - 8 + lr;
        u32x4 v = (u32x4){0u, 0u, 0u, 0u};
        if (t >= 0 && t < N) v = *(const u32x4*)(PC + (size_t)(seq0 + t) * 256 + ch8 * 8);
        *(LAS u32x4*)(lds + (lr * 256 + ch8 * 8) * 2) = v;
    }
    __syncthreads();
    {
        const int ch = tid & 255, th = tid >> 8, g = ch >> 6, hw = 1 << g;
        for (int i = 0; i < 32; ++i) {
            const int tl = th * 32 + i, t = t0 + tl;
            const int lo = max(t - hw, 0), hi2 = min(t + hw, N);
            float s = 0.f;
            for (int tt = lo; tt < hi2; ++tt) s += bf2f(vin[(tt - t0 + 8) * 256 + ch]);
            pooled[tl * 256 + ch] = s / (float)(hi2 - lo) - bf2f(vin[(tl + 8) * 256 + ch]);
        }
    }
    __syncthreads();
    {
        const int col = tid & 255, th = tid >> 8, g = col >> 6, d = col & 63;
        float w[64];
#pragma unroll
        for (int c = 0; c < 64; ++c) w[c] = wpool[(size_t)(g * 64 + c) * 64 + d];
        const float sc = pscale[col];
        for (int i = 0; i < 32; ++i) {
            const int tl = th * 32 + i;
            const LAS f32x4* pp = (const LAS f32x4*)(pooled + tl * 256 + g * 64);
            float acc = 0.f;
#pragma unroll
            for (int c4 = 0; c4 < 16; ++c4) { const f32x4 pv = pp[c4]; acc += pv[0] * w[4 * c4] + pv[1] * w[4 * c4 + 1] + pv[2] * w[4 * c4 + 2] + pv[3] * w[4 * c4 + 3]; }
            Y[(size_t)(row0 + tl) * D + 768 + col] = (bf16_t)f2bf(acc * sc);
        }
    }
    __syncthreads();
}

__device__ __forceinline__ void mixer_phase(KArgsPtr a, int l, bool lastl, LAS unsigned char* lds, unsigned* ctr, int tid, int wid, int lane) {
    unsigned char* ws = a->ws;
    const bf16_t* big = (const bf16_t*)(ws + WS_BIG);
    bf16_t* Y = (bf16_t*)(ws + WS_U);
    constexpr int NG = NB * 6 * 8, NN = NB * 6 * 8, NCA = NB * 6, NCB = NB * 6;
    const int ncx = lastl ? 0 : NCA + NCB;
    const int npool = (lastl ? TL : T) / 64;
    const int total = NG + NN + ncx + npool;
    LAS int* shu = (LAS int*)(lds + LDS_MISC);
    LAS float* biasL = (LAS float*)(lds + 32768);
    for (;;) {
        __syncthreads();
        if (tid == 0) shu[0] = (int)atomicAdd(ctr, 1u);
        __syncthreads();
        int u = shu[0];
        if (u >= total) break;
        AttnJob J;
        if (u < NG) {
            const int qb = u & 7, hq = (u >> 3) % 6, b = u / 48, hkv = hq / 3;
            J.Q = big + B_QB + (size_t)(b * SEQ + qb * 256) * 384 + hq * 64; J.qpitch = 384;
            J.K = big + B_KB + hkv * 64; J.kpitch = 128; J.Vt = big + B_VBT + (size_t)(hkv * 64) * T;
            J.O = Y + (size_t)(b * SEQ + qb * 256) * D + 384 + hq * 64;
            J.ctx_row0 = TL + b * LCTX; J.lat_row0 = b * SEQ; J.ntiles = 4 + 32; J.na = 0; J.r0 = 0; J.rlo = 0;
            attn_unit(lds, J, biasL, tid, wid, lane);
        } else if ((u -= NG) < NN) {
            const int rg = u & 7, h = (u >> 3) % 6, b = u / 48, r0 = rg * 4;
            const int rlo = min(max(r0 - 4, 0), 24), rhi = min(max(r0 + 3 - 4, 0), 24) + 8;
            const float* rpb = a->in[13] + ((size_t)l * 6 + h) * 15 * 31;
            for (int i = tid; i < 465; i += 512) biasL[i] = rpb[i] * LOG2E;
            J.Q = big + B_QA + (size_t)(b * SEQ + r0 * 64) * 384 + h * 64; J.qpitch = 384;
            J.K = big + B_KA + h * 64; J.kpitch = 384; J.Vt = big + B_VAT + (size_t)(h * 64) * T;
            J.O = Y + (size_t)(b * SEQ + r0 * 64) * D + h * 64;
            J.ctx_row0 = TL + b * LCTX; J.lat_row0 = b * SEQ + rlo * 64; J.ntiles = 4 + (rhi - rlo); J.na = 1; J.r0 = r0; J.rlo = rlo;
            attn_unit(lds, J, biasL, tid, wid, lane);
        } else if ((u -= NN) < ncx) {
            const bool second = u >= NCA; if (second) u -= NCA;
            const int h = u % 6, b = u / 6;
            if (!second) { J.Q = big + B_QA + (size_t)(TL + b * LCTX) * 384 + h * 64; J.qpitch = 384; J.K = big + B_KA + h * 64; J.kpitch = 384; J.Vt = big + B_VAT + (size_t)(h * 64) * T; J.O = Y + (size_t)(TL + b * LCTX) * D + h * 64; }
            else { const int hkv = h / 3; J.Q = big + B_QB + (size_t)(TL + b * LCTX) * 384 + h * 64; J.qpitch = 384; J.K = big + B_KB + hkv * 64; J.kpitch = 128; J.Vt = big + B_VBT + (size_t)(hkv * 64) * T; J.O = Y + (size_t)(TL + b * LCTX) * D + 384 + h * 64; }
            J.ctx_row0 = TL + b * LCTX; J.lat_row0 = 0; J.ntiles = 4; J.na = 0; J.r0 = 0; J.rlo = 0;
            attn_unit(lds, J, biasL, tid, wid, lane);
        } else {
            u -= ncx;
            pool_unit(lds, big + B_PC, a->in[14] + (size_t)l * 4 * 64 * 64, a->in[15] + (size_t)l * 256, Y, u, tid);
        }
    }
}

__device__ __forceinline__ KArgsPtr fresh_args() {
    KArgsPtr p = (KArgsPtr)__builtin_amdgcn_kernarg_segment_ptr();
    asm volatile("" : "+s"(p) :: "memory");
    return p;
}
#define IN(k) (lo <= (k) && (k) < hi)
#define SEAM(k) do { if ((k) + 1 < hi) { __threadfence(); cg::this_grid().sync(); } } while (0)
#define PH_COMMON KArgsPtr a = fresh_args(); unsigned char* ws = a->ws; int tid = threadIdx.x; asm volatile("" : "+v"(tid)); const int lane = tid & 63, wid = __builtin_amdgcn_readfirstlane(tid >> 6); \
    int G = __builtin_amdgcn_readfirstlane((int)gridDim.x), c = __builtin_amdgcn_readfirstlane((int)blockIdx.x); \
    bf16_t* U = (bf16_t*)(ws + WS_U); bf16_t* BIG = (bf16_t*)(ws + WS_BIG); float* modall = (float*)(ws + WS_MOD); float* hbuf = (float*)(ws + WS_H); float* xout = a->out; \
    const bool lastl = (l == DEPTH - 1); const float* modl = modall + (size_t)l * 33 * NMOD; const float* xs = l == 0 ? a->in[0] : xout; const float* hs = l == 0 ? a->in[2] : hbuf; const int M = lastl ? TL : T; \
    (void)tid; (void)lane; (void)wid; (void)G; (void)c; (void)U; (void)BIG; (void)hbuf; (void)modl; (void)xs; (void)hs; (void)M; (void)lastl; (void)xout;
__global__ void __launch_bounds__(512, 2) mega_fwd(Args a_) {
    extern __shared__ __attribute__((aligned(16))) unsigned char lds_raw[];
    LAS unsigned char* lds = (LAS unsigned char*)lds_raw;
    const int lo = a_.ph_lo, hi = a_.ph_hi;
    if (IN(0)) { const int l = 0; PH_COMMON prep_phase(a, lds, tid, wid, lane, c, G); SEAM(0); }
    if (IN(1)) { const int l = 0; PH_COMMON
        pg8::Gemm g{(const bf16_t*)(ws + WS_SC), (const bf16_t*)(ws + WS_BIG), 256, DEPTH * NMOD, D};
        pg8::StaticOrder S; S.init(256, DEPTH * NMOD, G, c);
        EpiMod E{modall, a->in[5]};
        pg8::gemm_phase<EpiMod, pg8::StaticOrder, false, true>(lds, g, S, E, tid);
        SEAM(1);
    }
#pragma unroll 1
    for (int l = 0; l < DEPTH; ++l) {
        const int pb = 2 + 8 * l;
        if (IN(pb + 0)) { PH_COMMON norm_phase(xs, hs, a->in[6] + l * D, modl, 0, T, U, wid, lane, c, G); SEAM(pb + 0); }
        if (IN(pb + 1)) { PH_COMMON
            pg8::Gemm g{U, (const bf16_t*)(ws + WS_WIN) + (size_t)l * NIN * D, T, NIN, D};
            pg8::StaticOrder S; S.init(T, NIN, G, c);
            EpiIn E{BIG, a->in[9] + l * 64, a->in[10] + l * 64, a->in[11] + l * 64, a->in[12] + l * 64, (const f32x2*)(ws + WS_ROPE)};
            pg8::gemm_phase<EpiIn, pg8::StaticOrder, true, true>(lds, g, S, E, tid);
            SEAM(pb + 1);
        }
        if (IN(pb + 2)) { PH_COMMON mixer_phase(a, l, lastl, lds, (unsigned*)(ws + WS_CTL) + 64 * (1 + l), tid, wid, lane); SEAM(pb + 2); }
        if (IN(pb + 3)) { PH_COMMON
            pg8::Gemm g{U, (const bf16_t*)(ws + WS_WBR) + (size_t)l * D * D, M, D, D};
            pg8::StaticOrder S; S.init(M, D, G, c);
            EpiMerge E{BIG + B_G, BIG};
            pg8::gemm_phase<EpiMerge, pg8::StaticOrder, true, true>(lds, g, S, E, tid);
            SEAM(pb + 3);
        }
        if (IN(pb + 4)) { PH_COMMON
            pg8::Gemm g{BIG, (const bf16_t*)(ws + WS_WOUT) + (size_t)l * D * D, M, D, D};
            pg8::StaticOrder S; S.init(M, D, G, c);
            EpiRes E{xs, xout, hs, hbuf, modl, 2 * D};
            pg8::gemm_phase<EpiRes, pg8::StaticOrder, true, true>(lds, g, S, E, tid);
            SEAM(pb + 4);
        }
        if (IN(pb + 5)) { PH_COMMON norm_phase(xout, hbuf, a->in[7] + l * D, modl, 3 * D, M, U, wid, lane, c, G); SEAM(pb + 5); }
        if (IN(pb + 6)) { PH_COMMON
            pg8::Gemm g{U, (const bf16_t*)(ws + WS_W13) + (size_t)l * 2 * FF * D, M, 2 * FF, D};
            pg8::StaticOrder S; S.init(M, 2 * FF, G, c);
            EpiFF1 E{BIG};
            pg8::gemm_phase<EpiFF1, pg8::StaticOrder, true, true>(lds, g, S, E, tid);
            SEAM(pb + 6);
        }
        if (IN(pb + 7)) { PH_COMMON
            pg8::Gemm g{BIG, (const bf16_t*)(ws + WS_W2) + (size_t)l * D * FF, M, D, FF};
            pg8::StaticOrder S; S.init(M, D, G, c);
            EpiRes E{xout, xout, hbuf, hbuf, modl, 5 * D};
            pg8::gemm_phase<EpiRes, pg8::StaticOrder, true, true>(lds, g, S, E, tid);
            SEAM(pb + 7);
        }
    }
}
#undef IN
#undef SEAM

extern "C" void kernel_launch(void* const* d_in, const int* in_sizes, int n_in, void* d_out, int out_size, void* d_ws, size_t ws_size, hipStream_t stream) {
    static int grid = 0;
    if (grid == 0) {
        if (n_in != 23 || out_size != TL * D || ws_size < WS_END) { fprintf(stderr, "kernel_launch: unexpected shapes (n_in %d out %d ws %zu need %zu)\n", n_in, out_size, ws_size, (size_t)WS_END); grid = -1; return; }
        int dev = 0, cus = 0, per_cu = 0;
        hipGetDevice(&dev); hipDeviceGetAttribute(&cus, hipDeviceAttributeMultiprocessorCount, dev);
        if (hipFuncSetAttribute((const void*)mega_fwd, hipFuncAttributeMaxDynamicSharedMemorySize, LDS_BYTES) != hipSuccess) { fprintf(stderr, "kernel_launch: hipFuncSetAttribute failed\n"); grid = -1; return; }
        if (hipOccupancyMaxActiveBlocksPerMultiprocessor(&per_cu, (const void*)mega_fwd, 512, LDS_BYTES) != hipSuccess || per_cu < 1) { fprintf(stderr, "kernel_launch: occupancy query gave %d\n", per_cu); per_cu = 1; }
        (void)hipGetLastError();
        grid = cus;
        fprintf(stderr, "kernel_launch: cus %d per_cu %d grid %d ws %zu\n", cus, per_cu, grid, ws_size);
    }
    if (grid < 0) return;
    hipMemsetAsync((char*)d_ws + WS_CTL, 0, CTL_BYTES, stream);
    Args a{};
    for (int i = 0; i < 23; ++i) a.in[i] = (const float*)d_in[i];
    a.out = (float*)d_out; a.ws = (unsigned char*)d_ws;
    for (int i = 0; i < 16; ++i) a.freq[i] = (float)pow(10000.0, -(double)i / 16.0);
#if MK_PER_PHASE
    for (int ph = 0; ph < NPH; ++ph) { a.ph_lo = ph; a.ph_hi = ph + 1; hipLaunchKernelGGL(mega_fwd, dim3(grid), dim3(512), LDS_BYTES, stream, a); }
#else
    a.ph_lo = 0; a.ph_hi = NPH;
    void* args[] = {&a};
    hipError_t e = hipLaunchCooperativeKernel((const void*)mega_fwd, dim3(grid), dim3(512), args, LDS_BYTES, stream);
    if (e != hipSuccess) fprintf(stderr, "kernel_launch: cooperative launch failed: %s (grid %d)\n", hipGetErrorString(e), grid);
#endif
}
```

```cpp
#include <hip/hip_runtime.h>
#include <hip/hip_cooperative_groups.h>
#include <cstdio>
#include <cstdint>
#include <cmath>
namespace cg = cooperative_groups;

#ifndef REP_MASK
#define REP_MASK 0
#endif
#ifndef EPI_DOUBLE
#define EPI_DOUBLE 0
#endif
#ifndef PREP_DOUBLE
#define PREP_DOUBLE 0
#endif
#ifndef MIX_DUP
#define MIX_DUP 0
#endif
#ifndef GEMM_DOUBLE
#define GEMM_DOUBLE 0
#endif
#ifndef STG_K1024
#define STG_K1024 0
#define STG_K2816 0
#endif
#ifndef MK_PER_PHASE
#define MK_PER_PHASE 0
#endif

#define LAS __attribute__((address_space(3)))
typedef unsigned short bf16_t;
typedef short bf16x8 __attribute__((ext_vector_type(8)));
typedef float f32x4 __attribute__((ext_vector_type(4)));
typedef float f32x2 __attribute__((ext_vector_type(2)));
typedef float f32x16 __attribute__((ext_vector_type(16)));
typedef unsigned u32x4 __attribute__((ext_vector_type(4)));
typedef unsigned u32x2 __attribute__((ext_vector_type(2)));

constexpr int D = 1024, NB = 32, SEQ = 2048, DEPTH = 4, LCTX = 256, GW = 64;
constexpr int TL = NB * SEQ, TC = NB * LCTX, T = TL + TC;
constexpr int NIN = 5120, FF = 2816, NMOD = 6144;
constexpr float EPS = 1e-6f;
constexpr float LOG2E = 1.4426950408889634f;
constexpr float QSCALE = 0.125f * LOG2E;
constexpr int NPH = 2 + 8 * DEPTH;

constexpr size_t WS_CTL = 0, CTL_BYTES = 65536;
constexpr size_t WS_ROPE = WS_CTL + CTL_BYTES;
constexpr size_t WS_MOD = WS_ROPE + 8192;
constexpr size_t WS_SC = WS_MOD + (size_t)DEPTH * 33 * NMOD * 4;
constexpr size_t WS_H = WS_SC + 256 * 1024 * 2;
constexpr size_t WS_WIN = WS_H + (size_t)TC * D * 4;
constexpr size_t WS_WBR = WS_WIN + (size_t)DEPTH * NIN * D * 2;
constexpr size_t WS_WOUT = WS_WBR + (size_t)DEPTH * D * D * 2;
constexpr size_t WS_W13 = WS_WOUT + (size_t)DEPTH * D * D * 2;
constexpr size_t WS_W2 = WS_W13 + (size_t)DEPTH * 2 * FF * D * 2;
constexpr size_t WS_U = WS_W2 + (size_t)DEPTH * D * FF * 2;
constexpr size_t WS_BIG = WS_U + (size_t)T * D * 2;
constexpr size_t WS_END = WS_BIG + (size_t)T * NIN * 2;
constexpr size_t WS_SLOTS = WS_END;
constexpr size_t WS_END2 = WS_SLOTS + (size_t)T * 4 * 4;
static_assert(WS_END2 <= (size_t)1073741824, "workspace map exceeds 1 GiB");
constexpr size_t CTL_PANEL = 32768;
constexpr size_t B_QA = 0, B_KA = B_QA + (size_t)T * 384, B_VAT = B_KA + (size_t)T * 384, B_QB = B_VAT + (size_t)T * 384, B_KB = B_QB + (size_t)T * 384,
                 B_VBT = B_KB + (size_t)T * 128, B_PC = B_VBT + (size_t)T * 128, B_G = B_PC + (size_t)T * 256;
static_assert(B_G == (size_t)T * 2048, "BIG layout");

constexpr int LDS_BYTES = 131072 + 1024 + 6144;
constexpr int LDS_XCH = 131072 + 1024;
constexpr int LDS_MISC = 131072;

__device__ __forceinline__ unsigned f2bf(float f) { unsigned u = __builtin_bit_cast(unsigned, f); return (u + 0x7fffu + ((u >> 16) & 1u)) >> 16; }
typedef __bf16 hwbf2 __attribute__((ext_vector_type(2)));
__device__ __forceinline__ unsigned pk2(float lo, float hi) { const f32x2 v = {lo, hi}; const hwbf2 b = __builtin_convertvector(v, hwbf2); return __builtin_bit_cast(unsigned, b); }
__device__ __forceinline__ float bf2f(unsigned short h) { return __builtin_bit_cast(float, (unsigned)h << 16); }
__device__ __forceinline__ float bflo(unsigned w) { return __builtin_bit_cast(float, w << 16); }
__device__ __forceinline__ float bfhi(unsigned w) { return __builtin_bit_cast(float, w & 0xffff0000u); }
__device__ __forceinline__ float wave_sum(float v) {
#pragma unroll
    for (int o = 1; o < 64; o <<= 1) v += __shfl_xor(v, o);
    return v;
}
__device__ __forceinline__ float fast_exp2(float x) { return __builtin_amdgcn_exp2f(x); }
__device__ __forceinline__ float fast_rcp(float x) { return __builtin_amdgcn_rcpf(x); }
__device__ __forceinline__ float sigmoidf_(float x) { return fast_rcp(1.0f + fast_exp2(x * -LOG2E)); }

namespace pg8 {
constexpr int BM = 256, BK = 64, HALF = 128, HTB = HALF * BK * 2, NXCD = 8, WGM = 8;
__host__ __device__ __forceinline__ int lds_byte(int r, int c) { const int st = (r >> 4) * 2 + (c >> 5), rr = r & 15, cc = c & 31, ob = rr * 64 + cc * 2; return st * 1024 + (ob ^ (((ob >> 9) & 1) << 5)); }
__host__ __device__ __forceinline__ void stage_rc(int b, int& R, int& C) { const int st = b / 1024, sb = b % 1024, swz = sb ^ (((sb >> 9) & 1) << 5); R = (st >> 1) * 16 + swz / 64; C = (st & 1) * 32 + (swz % 64) / 2; }

struct Unit { int pm, pn, second; };
struct Gemm { const bf16_t* A; const bf16_t* Bt; int M, N, K; };

struct StaticOrder {
    int nM, nN, nwg, G, c, dbl;
    __device__ void init(int M, int N, int G_, int c_) { nM = M / BM; nN = N / BM; nwg = nM * nN; G = G_; c = c_; dbl = GEMM_DOUBLE; }
    __device__ bool next(int i, Unit& u) const {
        const long L = (long)(dbl ? (i >> 1) : i) * G + c; if (L >= nwg) return false; u.second = dbl ? (i & 1) : 1;
        int wgid = (int)L; { const int q = nwg / NXCD, r = nwg % NXCD, xcd = wgid % NXCD, off = wgid / NXCD; wgid = (xcd < r ? xcd * (q + 1) : r * (q + 1) + (xcd - r) * q) + off; }
        const int nig = WGM * nN, gid = wgid / nig, fm = gid * WGM, gsz = (nM - fm) < WGM ? (nM - fm) : WGM;
        u.pm = fm + ((wgid % nig) % gsz); u.pn = (wgid % nig) / gsz; return true;
    }
};

struct PanelOrder {
    int nM, G, c, dbl;
    __device__ void init(int M, int G_, int c_) { nM = M / BM; G = G_; c = c_; dbl = 0; }
    __device__ bool next(int i, Unit& u) const {
        if (G < 256 || c >= 256) { if (G >= 256) return false; const long L = (long)i * (G & ~3) + c; if (c >= (G & ~3) || L >= (long)nM * 4) return false; u.pm = (int)(L >> 2); u.pn = (int)(L & 3); u.second = 1; return true; }
        const int pm = i * 64 + (c & 7) * 8 + (c >> 5); if (pm >= nM) return false;
        u.pm = pm; u.pn = (c >> 3) & 3; u.second = 1; return true;
    }
};

template <class Epi, class Sched, bool ALIGN_EPI = false, bool SP2 = false>
__device__ __forceinline__ void gemm_phase(LAS unsigned char* lds, const Gemm g, const Sched& S, const Epi& E, const int tid, const int stagger_ticks = 0) {
    const int wid = __builtin_amdgcn_readfirstlane(tid >> 6), lane = tid & 63, wr = wid >> 2, wc = wid & 3, fr = lane & 15, fq = lane >> 4;
    const int K = g.K, nt = K / BK;
    unsigned voffA[2], voffB[2];
#pragma unroll
    for (int i = 0; i < 2; ++i) { int R, C; stage_rc(tid * 16 + i * 8192, R, C); voffA[i] = (unsigned)(R * K + C) * 2u; voffB[i] = (unsigned)(R * K + C) * 2u; }
    const size_t kstep = (size_t)(BK * 2);
    const size_t hstep = (size_t)HALF * K * 2;
    const size_t tstep = 2 * hstep;
    const unsigned ldsw = (unsigned)wid * 1024u;
    const int aoff = lds_byte(wr * 64 + fr, fq * 8), boff = lds_byte(wc * 32 + fr, fq * 8);
#define PG8_SA(b, h) (((b) * 2 + (h)) * HTB)
#define PG8_SB(b, h) ((4 + (b) * 2 + (h)) * HTB)
#define PG8_STAGE(bufoff, gbase, voff) do { _Pragma("unroll") for (int _i = 0; _i < 2; ++_i) \
        __builtin_amdgcn_global_load_lds((const unsigned*)((const char*)(gbase) + (voff)[_i]), (LAS unsigned*)(lds + (bufoff) + ldsw + _i * 8192), 16, 0, 0); } while (0)
#define PG8_LDA(dst, b, h) do { _Pragma("unroll") for (int m = 0; m < 4; ++m) _Pragma("unroll") for (int k = 0; k < 2; ++k) dst[m][k] = *(const LAS bf16x8*)(lds + PG8_SA(b, h) + aoff + m * 2048 + k * 1024); } while (0)
#define PG8_LDB(dst, b, h) do { _Pragma("unroll") for (int n = 0; n < 2; ++n) _Pragma("unroll") for (int k = 0; k < 2; ++k) dst[n][k] = *(const LAS bf16x8*)(lds + PG8_SB(b, h) + boff + n * 2048 + k * 1024); } while (0)
#define PG8_MMA(ai, bj, At, Bt) do { __builtin_amdgcn_s_setprio(1); _Pragma("unroll") for (int m = 0; m < 4; ++m) _Pragma("unroll") for (int n = 0; n < 2; ++n) _Pragma("unroll") for (int k = 0; k < 2; ++k) \
        acc[ai][bj][m][n] = __builtin_amdgcn_mfma_f32_16x16x32_bf16(Bt[n][k], At[m][k], acc[ai][bj][m][n], 0, 0, 0); __builtin_amdgcn_s_setprio(0); } while (0)
#define PG8_WAIT_V(n) asm volatile("s_waitcnt vmcnt(" #n ")" ::: "memory")
#define PG8_WAIT_L(n) asm volatile("s_waitcnt lgkmcnt(" #n ")" ::: "memory")
#define PG8_BAR __builtin_amdgcn_s_barrier()
#define PG8_SCHED __builtin_amdgcn_sched_barrier(0)
    Unit cur, nxt; int ui = 0;
    if (!S.next(0, cur)) return;
    if (stagger_ticks > 0) {
        const unsigned long long t0 = __builtin_amdgcn_s_memrealtime();
        while ((long long)(__builtin_amdgcn_s_memrealtime() - t0) < (long long)stagger_ticks) __builtin_amdgcn_s_sleep(16);
    }
    f32x4 acc[2][2][4][2];
#pragma unroll
    for (int a = 0; a < 2; ++a)
#pragma unroll
        for (int b = 0; b < 2; ++b)
#pragma unroll
            for (int m = 0; m < 4; ++m)
#pragma unroll
                for (int n = 0; n < 2; ++n) acc[a][b][m][n] = (f32x4){0.f, 0.f, 0.f, 0.f};
    bf16x8 At[4][2], B0[2][2], B1[2][2];
    const char* cA = (const char*)g.A + (size_t)cur.pm * tstep; const char* cB = (const char*)g.Bt + (size_t)cur.pn * tstep;
    if constexpr (SP2) {
        PG8_STAGE(PG8_SB(0, 0), cB, voffB); PG8_STAGE(PG8_SB(0, 1), cB + hstep, voffB); PG8_STAGE(PG8_SA(0, 0), cA, voffA); PG8_STAGE(PG8_SA(0, 1), cA + hstep, voffA);
        if (wr == 1) PG8_BAR;
        PG8_WAIT_V(2); PG8_BAR;
        PG8_STAGE(PG8_SB(1, 0), cB + kstep, voffB); PG8_STAGE(PG8_SA(1, 0), cA + kstep, voffA); PG8_STAGE(PG8_SB(1, 1), cB + hstep + kstep, voffB);
        PG8_WAIT_V(6); PG8_BAR;
    } else {
        PG8_STAGE(PG8_SB(0, 0), cB, voffB); PG8_STAGE(PG8_SA(0, 0), cA, voffA); PG8_STAGE(PG8_SB(0, 1), cB + hstep, voffB); PG8_STAGE(PG8_SA(0, 1), cA + hstep, voffA);
        if (wr == 1) PG8_BAR;
        PG8_WAIT_V(4); PG8_BAR;
        PG8_STAGE(PG8_SB(1, 0), cB + kstep, voffB); PG8_STAGE(PG8_SA(1, 0), cA + kstep, voffA); PG8_STAGE(PG8_SB(1, 1), cB + hstep + kstep, voffB);
        PG8_WAIT_V(6); PG8_BAR;
    }
    for (;;) {
        const bool has_next = S.next(ui + 1, nxt);
        const char* nA = has_next ? (const char*)g.A + (size_t)nxt.pm * tstep : cA; const char* nB = has_next ? (const char*)g.Bt + (size_t)nxt.pn * tstep : cB;
        for (int t = 0; t < nt; t += 2) {
            if constexpr (Epi::MID) { if (t == 6 || t == 12) E.mid(acc, cur, t == 6 ? 0 : 1, wr, wc, fr, fq); }
            const bool last = (t == nt - 2);
            const char* a1 = cA + (size_t)(t + 1) * kstep;
            const char* a2 = last ? nA : cA + (size_t)(t + 2) * kstep; const char* b2 = last ? nB : cB + (size_t)(t + 2) * kstep;
            const char* a3 = a2 + kstep; const char* b3 = b2 + kstep;
            if constexpr (SP2) {
            PG8_LDB(B0, 0, 0); PG8_LDB(B1, 0, 1); PG8_SCHED; PG8_LDA(At, 0, 0); PG8_STAGE(PG8_SA(1, 1), a1 + hstep, voffA);
            PG8_WAIT_V(8); PG8_WAIT_L(0); PG8_BAR; PG8_MMA(0, 0, At, B0); PG8_MMA(0, 1, At, B1); PG8_BAR; PG8_SCHED;
            PG8_LDA(At, 0, 1); PG8_STAGE(PG8_SB(0, 0), b2, voffB); PG8_STAGE(PG8_SB(0, 1), b2 + hstep, voffB); PG8_STAGE(PG8_SA(0, 0), a2, voffA);
            PG8_WAIT_V(8); PG8_WAIT_L(0); PG8_BAR; PG8_MMA(1, 0, At, B0); PG8_MMA(1, 1, At, B1); PG8_BAR; PG8_SCHED;
            PG8_LDB(B0, 1, 0); PG8_LDB(B1, 1, 1); PG8_SCHED; PG8_LDA(At, 1, 0); PG8_STAGE(PG8_SA(0, 1), a2 + hstep, voffA);
            PG8_WAIT_V(8); PG8_WAIT_L(0); PG8_BAR; PG8_MMA(0, 0, At, B0); PG8_MMA(0, 1, At, B1); PG8_BAR; PG8_SCHED;
            PG8_LDA(At, 1, 1); PG8_STAGE(PG8_SB(1, 0), b3, voffB); PG8_STAGE(PG8_SB(1, 1), b3 + hstep, voffB); PG8_STAGE(PG8_SA(1, 0), a3, voffA);
            PG8_WAIT_V(8); PG8_WAIT_L(0); PG8_BAR; PG8_MMA(1, 0, At, B0); PG8_MMA(1, 1, At, B1); PG8_BAR; PG8_SCHED;
            } else {
            PG8_LDB(B0, 0, 0); PG8_SCHED; PG8_LDA(At, 0, 0); PG8_STAGE(PG8_SA(1, 1), a1 + hstep, voffA);
            PG8_WAIT_L(8); PG8_BAR; PG8_WAIT_L(0); PG8_MMA(0, 0, At, B0); PG8_BAR; PG8_SCHED;
            PG8_LDB(B1, 0, 1); PG8_STAGE(PG8_SB(0, 0), b2, voffB);
            PG8_BAR; PG8_WAIT_L(0); PG8_MMA(0, 1, At, B1); PG8_BAR;
            PG8_LDA(At, 0, 1); PG8_STAGE(PG8_SA(0, 0), a2, voffA);
            PG8_BAR; PG8_WAIT_L(0); PG8_MMA(1, 0, At, B0); PG8_BAR; PG8_SCHED;
            PG8_STAGE(PG8_SB(0, 1), b2 + hstep, voffB);
            PG8_WAIT_V(6); PG8_BAR; PG8_MMA(1, 1, At, B1); PG8_BAR;
            PG8_LDB(B0, 1, 0); PG8_SCHED; PG8_LDA(At, 1, 0); PG8_STAGE(PG8_SA(0, 1), a2 + hstep, voffA);
            PG8_WAIT_L(8); PG8_BAR; PG8_WAIT_L(0); PG8_MMA(0, 0, At, B0); PG8_BAR; PG8_SCHED;
            PG8_LDB(B1, 1, 1); PG8_STAGE(PG8_SB(1, 0), b3, voffB);
            PG8_BAR; PG8_WAIT_L(0); PG8_MMA(0, 1, At, B1); PG8_BAR;
            PG8_LDA(At, 1, 1); PG8_STAGE(PG8_SA(1, 0), a3, voffA);
            PG8_BAR; PG8_WAIT_L(0); PG8_MMA(1, 0, At, B0); PG8_BAR; PG8_SCHED;
            PG8_STAGE(PG8_SB(1, 1), b3 + hstep, voffB);
            PG8_WAIT_V(6); PG8_BAR; PG8_MMA(1, 1, At, B1); PG8_BAR;
            }
        }
        if constexpr (ALIGN_EPI) { if (wr == 0) PG8_BAR; }
        if (cur.second) {
        if (S.dbl) {
#pragma unroll
        for (int a = 0; a < 2; ++a)
#pragma unroll
            for (int b = 0; b < 2; ++b)
#pragma unroll
                for (int m = 0; m < 4; ++m)
#pragma unroll
                    for (int n = 0; n < 2; ++n) acc[a][b][m][n] = acc[a][b][m][n] * 0.5f;
        }
        E(acc, cur, wr, wc, fr, fq);
        if constexpr (Epi::IDEM) { if (EPI_DOUBLE) { asm volatile("" ::: "memory"); E(acc, cur, wr, wc, fr, fq); } }
        }
        if (!has_next) break;
        if (cur.second) {
#pragma unroll
        for (int a = 0; a < 2; ++a)
#pragma unroll
            for (int b = 0; b < 2; ++b)
#pragma unroll
                for (int m = 0; m < 4; ++m)
#pragma unroll
                    for (int n = 0; n < 2; ++n) acc[a][b][m][n] = (f32x4){0.f, 0.f, 0.f, 0.f};
        }
        cur = nxt; cA = nA; cB = nB; ++ui;
        if constexpr (ALIGN_EPI) { if (wr == 1) PG8_BAR; }
    }
    PG8_WAIT_V(0);
    if constexpr (!ALIGN_EPI) { if (wr == 0) PG8_BAR; }
    PG8_BAR;
#undef PG8_SA
#undef PG8_SB
#undef PG8_STAGE
#undef PG8_LDA
#undef PG8_LDB
#undef PG8_MMA
#undef PG8_WAIT_V
#undef PG8_WAIT_L
#undef PG8_BAR
#undef PG8_SCHED
}
}
using pg8::Unit;

struct EpiIn {
    static constexpr bool IDEM = true;
    static constexpr bool MID = false;
    bf16_t* big; const float* qn_a; const float* kn_a; const float* qn_b; const float* kn_b; const f32x2* rope;
    __device__ __forceinline__ void operator()(const f32x4 (&acc)[2][2][4][2], const Unit& u, int wr, int wc, int fr, int fq) const {
        const int hg = u.pn * 4 + wc;
        int kind; bf16_t* dst; int pitch, hcol; const float* gain = nullptr;
        if (hg < 6)       { kind = 1 | 256; dst = big + B_QA; pitch = 384; hcol = hg * 64; gain = qn_a; }
        else if (hg < 12) { kind = 1;       dst = big + B_KA; pitch = 384; hcol = (hg - 6) * 64; gain = kn_a; }
        else if (hg < 18) { kind = 3;       dst = big + B_VAT; pitch = T; hcol = (hg - 12) * 64; }
        else if (hg < 24) { kind = 2 | 256; dst = big + B_QB; pitch = 384; hcol = (hg - 18) * 64; gain = qn_b; }
        else if (hg < 26) { kind = 2;       dst = big + B_KB; pitch = 128; hcol = (hg - 24) * 64; gain = kn_b; }
        else if (hg < 28) { kind = 3;       dst = big + B_VBT; pitch = T; hcol = (hg - 26) * 64; }
        else if (hg < 32) { kind = 0;       dst = big + B_PC; pitch = 256; hcol = (hg - 28) * 64; }
        else              { kind = 4;       dst = big + B_G; pitch = 3072; hcol = (hg - 32) * 64; }
        const int k = kind & 255; const float qs = (kind & 256) ? QSCALE : 1.0f;
        f32x4 gv[2][2];
        if (k == 1 || k == 2) {
#pragma unroll
            for (int bj = 0; bj < 2; ++bj)
#pragma unroll
                for (int n = 0; n < 2; ++n) gv[bj][n] = *(const f32x4*)(gain + 32 * bj + 16 * n + 4 * fq) * qs;
        }
        f32x4 ropeR[2][2], ropeC[4][2];
        const bool do_rope = (k == 2 && u.pm * 256 < TL);
        if (do_rope) {
#pragma unroll
            for (int m = 0; m < 4; ++m) { const int pos = m * 16 + fr; const f32x4* rp = (const f32x4*)(rope + pos * 16 + 4 * fq); ropeC[m][0] = rp[0]; ropeC[m][1] = rp[1]; }
            __builtin_amdgcn_sched_barrier(0);
        }
#pragma unroll
        for (int ai = 0; ai < 2; ++ai) {
            if (do_rope) { const int pos = ((u.pm * 256 + ai * 128 + wr * 64) & (SEQ - 1)) >> 6; const f32x4* rp = (const f32x4*)(rope + pos * 16 + 4 * fq); ropeR[ai][0] = rp[0]; ropeR[ai][1] = rp[1]; }
#pragma unroll
            for (int m = 0; m < 4; ++m) {
                const int row = u.pm * 256 + ai * 128 + wr * 64 + m * 16 + fr;
                f32x4 v[2][2];
#pragma unroll
                for (int bj = 0; bj < 2; ++bj)
#pragma unroll
                    for (int n = 0; n < 2; ++n) v[bj][n] = acc[ai][bj][m][n];
                if (k == 1 || k == 2) {
                    float ss = 0.f;
#pragma unroll
                    for (int bj = 0; bj < 2; ++bj)
#pragma unroll
                        for (int n = 0; n < 2; ++n) { const f32x4 x = v[bj][n]; ss += (x[0] * x[0] + x[1] * x[1]) + (x[2] * x[2] + x[3] * x[3]); }
                    ss += __shfl_xor(ss, 16); ss += __shfl_xor(ss, 32);
                    const float rinv = __builtin_amdgcn_rsqf(ss * (1.0f / 64.0f) + EPS);
#pragma unroll
                    for (int bj = 0; bj < 2; ++bj)
#pragma unroll
                        for (int n = 0; n < 2; ++n) v[bj][n] = v[bj][n] * rinv * gv[bj][n];
                    if (k == 2 && row < TL) {
#pragma unroll
                        for (int bj = 0; bj < 2; ++bj) {
                            const f32x4 q0 = bj ? ropeC[m][0] : ropeR[ai][0], q1 = bj ? ropeC[m][1] : ropeR[ai][1];
                            const float cs[4] = {q0[0], q0[2], q1[0], q1[2]}, sn[4] = {q0[1], q0[3], q1[1], q1[3]};
#pragma unroll
                            for (int j = 0; j < 4; ++j) { const float x1 = v[bj][0][j], x2 = v[bj][1][j];
                                v[bj][0][j] = x1 * cs[j] - x2 * sn[j]; v[bj][1][j] = x2 * cs[j] + x1 * sn[j]; }
                        }
                    }
                } else if (k == 4) {
#pragma unroll
                    for (int bj = 0; bj < 2; ++bj)
#pragma unroll
                        for (int n = 0; n < 2; ++n)
#pragma unroll
                            for (int j = 0; j < 4; ++j) v[bj][n][j] = sigmoidf_(v[bj][n][j]);
                }
                if (k == 3) {
#pragma unroll
                    for (int bj = 0; bj < 2; ++bj)
#pragma unroll
                        for (int n = 0; n < 2; ++n)
#pragma unroll
                            for (int j = 0; j < 4; ++j) dst[(size_t)(hcol + 32 * bj + 16 * n + 4 * fq + j) * T + row] = (bf16_t)f2bf(v[bj][n][j]);
                } else {
                    bf16_t* rp = dst + (size_t)row * pitch + hcol + 4 * fq;
#pragma unroll
                    for (int bj = 0; bj < 2; ++bj)
#pragma unroll
                        for (int n = 0; n < 2; ++n) { u32x2 w; w.x = pk2(v[bj][n][0], v[bj][n][1]); w.y = pk2(v[bj][n][2], v[bj][n][3]); *(u32x2*)(rp + 32 * bj + 16 * n) = w; }
                }
            }
        }
    }
};

struct EpiMerge {
    static constexpr bool IDEM = false;
    static constexpr bool MID = true;
    const bf16_t* G; bf16_t* Mo;
    __device__ __forceinline__ void mid(f32x4 (&acc)[2][2][4][2], const Unit& u, int which, int wr, int wc, int fr, int fq) const {
        const bf16_t* g0 = G + (size_t)(u.pm * 256 + wr * 64 + fr) * 3072 + which * 1024 + u.pn * 256 + 32 * wc + 8 * fq;
#pragma unroll
        for (int ai = 0; ai < 2; ++ai) {
            u32x4 ga[4][2], gb[4][2];
#pragma unroll
            for (int m = 0; m < 4; ++m)
#pragma unroll
                for (int bj = 0; bj < 2; ++bj) { const bf16_t* gp = g0 + (size_t)(ai * 128 + m * 16) * 3072 + 128 * bj; ga[m][bj] = *(const u32x4*)gp; gb[m][bj] = *(const u32x4*)(gp + 1024); }
            __builtin_amdgcn_sched_barrier(0);
#pragma unroll
            for (int m = 0; m < 4; ++m)
#pragma unroll
                for (int bj = 0; bj < 2; ++bj) {
                    const u32x4 a = ga[m][bj], b = gb[m][bj];
#pragma unroll
                    for (int n = 0; n < 2; ++n) {
                        const unsigned a0 = n ? a.z : a.x, a1 = n ? a.w : a.y, b0 = n ? b.z : b.x, b1 = n ? b.w : b.y;
                        acc[ai][bj][m][n][0] *= bflo(a0) * fast_rcp(bflo(b0)); acc[ai][bj][m][n][1] *= bfhi(a0) * fast_rcp(bfhi(b0));
                        acc[ai][bj][m][n][2] *= bflo(a1) * fast_rcp(bflo(b1)); acc[ai][bj][m][n][3] *= bfhi(a1) * fast_rcp(bfhi(b1));
                    }
                }
            __builtin_amdgcn_sched_barrier(0);
        }
    }
    __device__ __forceinline__ void operator()(const f32x4 (&acc)[2][2][4][2], const Unit& u, int wr, int wc, int fr, int fq) const {
        const size_t r0 = (size_t)(u.pm * 256 + wr * 64 + fr); const int c0 = u.pn * 256 + 32 * wc + 8 * fq;
        u32x4 gc[2][4][2];
#pragma unroll
        for (int ai = 0; ai < 2; ++ai)
#pragma unroll
            for (int m = 0; m < 4; ++m)
#pragma unroll
                for (int bj = 0; bj < 2; ++bj) gc[ai][m][bj] = *(const u32x4*)(G + (r0 + ai * 128 + m * 16) * 3072 + 2048 + c0 + 128 * bj);
        __builtin_amdgcn_sched_barrier(0);
#pragma unroll
        for (int ai = 0; ai < 2; ++ai)
#pragma unroll
            for (int m = 0; m < 4; ++m)
#pragma unroll
                for (int bj = 0; bj < 2; ++bj) {
                    const u32x4 c = gc[ai][m][bj];
                    const f32x4 x0 = acc[ai][bj][m][0], x1 = acc[ai][bj][m][1];
                    u32x4 w;
                    w.x = pk2(x0[0] * bflo(c.x), x0[1] * bfhi(c.x)); w.y = pk2(x0[2] * bflo(c.y), x0[3] * bfhi(c.y));
                    w.z = pk2(x1[0] * bflo(c.z), x1[1] * bfhi(c.z)); w.w = pk2(x1[2] * bflo(c.w), x1[3] * bfhi(c.w));
                    *(u32x4*)(Mo + (r0 + ai * 128 + m * 16) * D + c0 + 128 * bj) = w;
                }
    }
};

struct EpiRes {
    static constexpr bool IDEM = false;
    static constexpr bool MID = false;
    const float* xs; float* xd; const float* hs; float* hd; const float* modl; int goff;
    __device__ __forceinline__ void operator()(const f32x4 (&acc)[2][2][4][2], const Unit& u, int wr, int wc, int fr, int fq) const {
        const int row0 = u.pm * 256; const bool lat = row0 < TL;
        const int b = lat ? (row0 >> 11) : 32;
        const float* src = (lat ? xs + (size_t)row0 * D : hs + (size_t)(row0 - TL) * D) + (size_t)(wr * 64 + fr) * D + u.pn * 256 + 32 * wc + 8 * fq;
        float* dst = (lat ? xd + (size_t)row0 * D : hd + (size_t)(row0 - TL) * D) + (size_t)(wr * 64 + fr) * D + u.pn * 256 + 32 * wc + 8 * fq;
        const float* gp = modl + (size_t)b * NMOD + goff + u.pn * 256 + 32 * wc + 8 * fq;
        f32x4 g[2][2];
#pragma unroll
        for (int bj = 0; bj < 2; ++bj) { g[bj][0] = *(const f32x4*)(gp + 128 * bj); g[bj][1] = *(const f32x4*)(gp + 128 * bj + 4); }
        f32x4 s[2][4][2];
#define ER_LOAD(k) do { const int bj_ = (k) >> 1, ai_ = (k) & 1; _Pragma("unroll") for (int m = 0; m < 4; ++m) { const size_t o = (size_t)(ai_ * 128 + m * 16) * D + 128 * bj_; \
            s[(k) & 1][m][0] = *(const f32x4*)(src + o); s[(k) & 1][m][1] = *(const f32x4*)(src + o + 4); } } while (0)
#define ER_STORE(k) do { const int bj_ = (k) >> 1, ai_ = (k) & 1; _Pragma("unroll") for (int m = 0; m < 4; ++m) { const size_t o = (size_t)(ai_ * 128 + m * 16) * D + 128 * bj_; \
            *(f32x4*)(dst + o) = s[(k) & 1][m][0] + g[bj_][0] * acc[ai_][bj_][m][0]; *(f32x4*)(dst + o + 4) = s[(k) & 1][m][1] + g[bj_][1] * acc[ai_][bj_][m][1]; } } while (0)
        ER_LOAD(0); __builtin_amdgcn_sched_barrier(0);
        ER_LOAD(1); __builtin_amdgcn_sched_barrier(0);
        ER_STORE(0); __builtin_amdgcn_sched_barrier(0);
        ER_LOAD(2); __builtin_amdgcn_sched_barrier(0);
        ER_STORE(1); __builtin_amdgcn_sched_barrier(0);
        ER_LOAD(3); __builtin_amdgcn_sched_barrier(0);
        ER_STORE(2); __builtin_amdgcn_sched_barrier(0);
        ER_STORE(3);
#undef ER_LOAD
#undef ER_STORE
    }
};

struct EpiResNorm {
    static constexpr bool IDEM = false;
    static constexpr bool MID = false;
    const float* xs; float* xd; const float* hs; float* hd; const float* modl; int goff;
    const float* ngain; const float* nmod; int nshift; bf16_t* U; float* slots; unsigned* cnt; LAS unsigned char* xl;
    __device__ __forceinline__ void operator()(f32x4 (&acc)[2][2][4][2], const Unit& u, int wr, int wc, int fr, int fq) const {
        const int row0 = u.pm * 256; const bool lat = row0 < TL;
        const int b = lat ? (row0 >> 11) : 32;
        const float* src = (lat ? xs + (size_t)row0 * D : hs + (size_t)(row0 - TL) * D) + (size_t)(wr * 64 + fr) * D + u.pn * 256 + 32 * wc + 8 * fq;
        float* dst = (lat ? xd + (size_t)row0 * D : hd + (size_t)(row0 - TL) * D) + (size_t)(wr * 64 + fr) * D + u.pn * 256 + 32 * wc + 8 * fq;
        const float* gp = modl + (size_t)b * NMOD + goff + u.pn * 256 + 32 * wc + 8 * fq;
        {
        f32x4 g[2][2];
#pragma unroll
        for (int bj = 0; bj < 2; ++bj) { g[bj][0] = *(const f32x4*)(gp + 128 * bj); g[bj][1] = *(const f32x4*)(gp + 128 * bj + 4); }
        f32x4 s[4][2];
#define ER_LOAD(k) do { const int bj_ = (k) >> 1, ai_ = (k) & 1; _Pragma("unroll") for (int m = 0; m < 4; ++m) { const size_t o = (size_t)(ai_ * 128 + m * 16) * D + 128 * bj_; \
            s[m][0] = *(const f32x4*)(src + o); s[m][1] = *(const f32x4*)(src + o + 4); } } while (0)
#define ER_STORE(k) do { const int bj_ = (k) >> 1, ai_ = (k) & 1; _Pragma("unroll") for (int m = 0; m < 4; ++m) { const size_t o = (size_t)(ai_ * 128 + m * 16) * D + 128 * bj_; \
            acc[ai_][bj_][m][0] = s[m][0] + g[bj_][0] * acc[ai_][bj_][m][0]; acc[ai_][bj_][m][1] = s[m][1] + g[bj_][1] * acc[ai_][bj_][m][1]; \
            *(f32x4*)(dst + o) = acc[ai_][bj_][m][0]; *(f32x4*)(dst + o + 4) = acc[ai_][bj_][m][1]; } } while (0)
        ER_LOAD(0); __builtin_amdgcn_sched_barrier(0); ER_STORE(0); __builtin_amdgcn_sched_barrier(0);
        ER_LOAD(1); __builtin_amdgcn_sched_barrier(0); ER_STORE(1); __builtin_amdgcn_sched_barrier(0);
        ER_LOAD(2); __builtin_amdgcn_sched_barrier(0); ER_STORE(2); __builtin_amdgcn_sched_barrier(0);
        ER_LOAD(3); __builtin_amdgcn_sched_barrier(0); ER_STORE(3); __builtin_amdgcn_sched_barrier(0);
#undef ER_LOAD
#undef ER_STORE
        }
        LAS float* P = (LAS float*)xl; LAS float* S = P + 1024;
        const int tid = (wr * 4 + wc) * 64 + fq * 16 + fr;
#pragma unroll
        for (int ai = 0; ai < 2; ++ai)
#pragma unroll
            for (int m = 0; m < 4; ++m) {
                float ss = 0.f;
#pragma unroll
                for (int bj = 0; bj < 2; ++bj)
#pragma unroll
                    for (int n = 0; n < 2; ++n) { const f32x4 x = acc[ai][bj][m][n]; ss += (x[0] * x[0] + x[1] * x[1]) + (x[2] * x[2] + x[3] * x[3]); }
                ss += __shfl_xor(ss, 16); ss += __shfl_xor(ss, 32);
                if (fq == 0) P[(ai * 128 + wr * 64 + m * 16 + fr) * 4 + wc] = ss;
            }
        asm volatile("s_waitcnt lgkmcnt(0)" ::: "memory"); __builtin_amdgcn_s_barrier(); asm volatile("" ::: "memory");
        if (tid < 256) {
            const float tot = (P[tid * 4 + 0] + P[tid * 4 + 1]) + (P[tid * 4 + 2] + P[tid * 4 + 3]);
            __hip_atomic_store(slots + (size_t)(row0 + tid) * 4 + u.pn, tot, __ATOMIC_RELAXED, __HIP_MEMORY_SCOPE_AGENT);
        }
        asm volatile("s_waitcnt vmcnt(0)" ::: "memory");
        if (tid < 256 && (tid & 63) == 0) __hip_atomic_fetch_add(cnt + u.pm, 1u, __ATOMIC_RELAXED, __HIP_MEMORY_SCOPE_AGENT);
        if (tid < 64) {
            unsigned sp = 0;
            while (__hip_atomic_load(cnt + u.pm, __ATOMIC_RELAXED, __HIP_MEMORY_SCOPE_AGENT) < 16u) { __builtin_amdgcn_s_sleep(2); if (++sp > (1u << 22)) break; }
            __builtin_amdgcn_fence(__ATOMIC_ACQUIRE, "agent");
        }
        asm volatile("s_waitcnt vmcnt(0) lgkmcnt(0)" ::: "memory"); __builtin_amdgcn_s_barrier(); asm volatile("" ::: "memory");
        if (tid < 256) {
            const float* sl = slots + (size_t)(row0 + tid) * 4;
            const float t4 = (__hip_atomic_load(sl + 0, __ATOMIC_RELAXED, __HIP_MEMORY_SCOPE_AGENT) + __hip_atomic_load(sl + 1, __ATOMIC_RELAXED, __HIP_MEMORY_SCOPE_AGENT))
                           + (__hip_atomic_load(sl + 2, __ATOMIC_RELAXED, __HIP_MEMORY_SCOPE_AGENT) + __hip_atomic_load(sl + 3, __ATOMIC_RELAXED, __HIP_MEMORY_SCOPE_AGENT));
            S[tid] = __builtin_amdgcn_rsqf(t4 * (1.0f / D) + EPS);
        }
        asm volatile("s_waitcnt lgkmcnt(0)" ::: "memory"); __builtin_amdgcn_s_barrier(); asm volatile("" ::: "memory");
        const float* mp = nmod + (size_t)b * NMOD + nshift + u.pn * 256 + 32 * wc + 8 * fq;
        const float* ng = ngain + u.pn * 256 + 32 * wc + 8 * fq;
        bf16_t* up = U + (size_t)(row0 + wr * 64 + fr) * D + u.pn * 256 + 32 * wc + 8 * fq;
#pragma unroll
        for (int bj = 0; bj < 2; ++bj) {
            const f32x4 sh0 = *(const f32x4*)(mp + 128 * bj), sh1 = *(const f32x4*)(mp + 128 * bj + 4);
            const f32x4 gs0 = *(const f32x4*)(ng + 128 * bj) * (*(const f32x4*)(mp + D + 128 * bj) + 1.0f), gs1 = *(const f32x4*)(ng + 128 * bj + 4) * (*(const f32x4*)(mp + D + 128 * bj + 4) + 1.0f);
#pragma unroll
            for (int ai = 0; ai < 2; ++ai)
#pragma unroll
                for (int m = 0; m < 4; ++m) {
                    const float rstd = S[ai * 128 + wr * 64 + m * 16 + fr];
                    const f32x4 y0 = acc[ai][bj][m][0] * rstd * gs0 + sh0, y1 = acc[ai][bj][m][1] * rstd * gs1 + sh1;
                    u32x4 w; w.x = pk2(y0[0], y0[1]); w.y = pk2(y0[2], y0[3]); w.z = pk2(y1[0], y1[1]); w.w = pk2(y1[2], y1[3]);
                    *(u32x4*)(up + (size_t)(ai * 128 + m * 16) * D + 128 * bj) = w;
                }
        }
    }
};

struct EpiFF1 {
    static constexpr bool IDEM = true;
    static constexpr bool MID = false;
    bf16_t* H1;
    __device__ __forceinline__ void operator()(const f32x4 (&acc)[2][2][4][2], const Unit& u, int wr, int wc, int fr, int fq) const {
        const int col = u.pn * 128 + 32 * wc + 8 * fq;
#pragma unroll
        for (int ai = 0; ai < 2; ++ai)
#pragma unroll
            for (int m = 0; m < 4; ++m) {
                const int row = u.pm * 256 + ai * 128 + wr * 64 + m * 16 + fr;
                float r[8];
#pragma unroll
                for (int n = 0; n < 2; ++n)
#pragma unroll
                    for (int j = 0; j < 4; ++j) { const float a = acc[ai][0][m][n][j], b = acc[ai][1][m][n][j]; r[4 * n + j] = a * sigmoidf_(a) * b; }
                u32x4 w; w.x = pk2(r[0], r[1]); w.y = pk2(r[2], r[3]); w.z = pk2(r[4], r[5]); w.w = pk2(r[6], r[7]);
                *(u32x4*)(H1 + (size_t)row * FF + col) = w;
            }
    }
};

struct EpiMod {
    static constexpr bool IDEM = false;
    static constexpr bool MID = false;
    float* mod; const float* bmod;
    __device__ __forceinline__ void operator()(const f32x4 (&acc)[2][2][4][2], const Unit& u, int wr, int wc, int fr, int fq) const {
        if (wr != 0) return;
#pragma unroll
        for (int m = 0; m < 3; ++m) {
            const int row = m * 16 + fr; if (row >= 33) continue;
#pragma unroll
            for (int bj = 0; bj < 2; ++bj)
#pragma unroll
                for (int n = 0; n < 2; ++n) {
                    const int nn = u.pn * 256 + 128 * bj + 32 * wc + 16 * n + 4 * fq;
                    const int l = nn / NMOD, c = nn - l * NMOD;
                    const f32x4 bv = *(const f32x4*)(bmod + nn);
                    *(f32x4*)(mod + ((size_t)l * 33 + row) * NMOD + c) = acc[0][bj][m][n] + bv;
                }
        }
    }
};

struct Args { const float* in[23]; float* out; unsigned char* ws; float freq[16]; int ph_lo, ph_hi; };
typedef const __attribute__((address_space(4))) Args* KArgsPtr;

__device__ __forceinline__ int p8map(int p) { return (p & 0xe0) | (((p >> 2) & 3) << 3) | (((p >> 4) & 1) << 2) | (p & 3); }
__device__ __forceinline__ void prep_item(KArgsPtr a, unsigned char* ws, int l, int mid, int item, LAS float* scr, int lane) {
    int K, N; if (mid == 0) { K = D; N = NIN; } else if (mid == 1 || mid == 2) { K = D; N = D; } else if (mid == 3) { K = D; N = 2 * FF; } else if (mid == 4) { K = FF; N = D; } else { K = D; N = NMOD; }
    const int nblk = N / 32, kb = item / nblk, nb = item % nblk, k0 = 64 * kb, n0 = 32 * nb;
    const int r = n0 + (lane & 31), tile = r >> 8, p = r & 255;
    const float* src; int ld, col, krow = k0; bf16_t* WT;
    if (mid == 0) { src = a->in[8] + (size_t)l * D * NIN; ld = NIN; col = tile * 256 + ((p >> 5) & 3) * 64 + (p >> 7) * 32 + (p & 31); WT = (bf16_t*)(ws + WS_WIN) + (size_t)l * NIN * D; }
    else if (mid == 1) { ld = D; col = tile * 256 + p8map(p); WT = (bf16_t*)(ws + WS_WBR) + (size_t)l * D * D;
        if (k0 < 384) { src = a->in[16] + (size_t)l * 384 * D; } else if (k0 < 768) { src = a->in[17] + (size_t)l * 384 * D; krow = k0 - 384; } else { src = a->in[18] + (size_t)l * 256 * D; krow = k0 - 768; } }
    else if (mid == 2) { src = a->in[19] + (size_t)l * D * D; ld = D; col = tile * 256 + p8map(p); WT = (bf16_t*)(ws + WS_WOUT) + (size_t)l * D * D; }
    else if (mid == 3) { src = ((p >> 7) ? a->in[21] : a->in[20]) + (size_t)l * D * FF; ld = FF; col = tile * 128 + (p8map(p) & 127); WT = (bf16_t*)(ws + WS_W13) + (size_t)l * 2 * FF * D; }
    else if (mid == 4) { src = a->in[22] + (size_t)l * FF * D; ld = D; col = tile * 256 + p8map(p); WT = (bf16_t*)(ws + WS_W2) + (size_t)l * D * FF; }
    else { src = a->in[4] + (size_t)l * D * NMOD; ld = NMOD; col = r; WT = (bf16_t*)(ws + WS_BIG) + (size_t)l * NMOD * D; }
#pragma unroll 8
    for (int i = 0; i < 32; ++i) { const int kk = 2 * i + (lane >> 5); scr[kk * 33 + (lane & 31)] = src[(size_t)(krow + kk) * ld + col]; }
    asm volatile("s_waitcnt lgkmcnt(0)" ::: "memory");
    const int c = lane & 7;
#pragma unroll
    for (int j = 0; j < 4; ++j) { const int n = (lane >> 3) + 8 * j; const LAS float* s = scr + (8 * c) * 33 + n;
        u32x4 o; o.x = pk2(s[0 * 33], s[1 * 33]); o.y = pk2(s[2 * 33], s[3 * 33]); o.z = pk2(s[4 * 33], s[5 * 33]); o.w = pk2(s[6 * 33], s[7 * 33]);
        *(u32x4*)(WT + (size_t)(n0 + n) * K + k0 + 8 * c) = o; }
    asm volatile("s_waitcnt lgkmcnt(0)" ::: "memory");
}

__device__ __forceinline__ void prep_phase(KArgsPtr a, LAS unsigned char* lds, int tid, int wid, int lane, int bid, int nblk_) {
    unsigned char* ws = a->ws;
    LAS float* scr = (LAS float*)(lds + wid * 8704);
    const int gw = bid * 8 + wid, NGW = nblk_ * 8;
    constexpr int I0 = 16 * 160, I1 = 16 * 32, I2 = 16 * 32, I3 = 16 * 176, I4 = 44 * 32, I5 = 16 * 192, IL = I0 + I1 + I2 + I3 + I4 + I5;
    for (int it = gw; it < IL * DEPTH; it += NGW) {
        const int l = it / IL; int r = it - l * IL; int mid;
        if (r < I0) mid = 0; else if ((r -= I0) < I1) mid = 1; else if ((r -= I1) < I2) mid = 2; else if ((r -= I2) < I3) mid = 3; else if ((r -= I3) < I4) mid = 4; else { r -= I4; mid = 5; }
        prep_item(a, ws, l, mid, r, scr, lane);
    }
    bf16_t* SC = (bf16_t*)(ws + WS_SC);
    for (int i = bid * 512 + tid; i < 256 * 1024; i += nblk_ * 512) {
        const int row = i >> 10, k = i & 1023; float v = 0.f;
        if (row < 32) v = a->in[1][row * D + k]; else if (row == 32) v = a->in[3][k];
        SC[i] = (bf16_t)f2bf(row <= 32 ? v * sigmoidf_(v) : 0.f);
    }
    f32x2* rope = (f32x2*)(ws + WS_ROPE);
    for (int i = bid * 512 + tid; i < 64 * 16; i += nblk_ * 512) {
        const int pos = i >> 4, fi = i & 15;
        const float ang = (float)pos * a->freq[fi];
        float rev = ang * 0.15915494309189535f; rev = rev - floorf(rev);
        rope[i] = (f32x2){__builtin_amdgcn_cosf(rev), __builtin_amdgcn_sinf(rev)};
    }
}

__device__ __forceinline__ void norm_phase(const float* xl, const float* xc, const float* gain, const float* modl, int shift_off, int nrows, bf16_t* U, int wid, int lane, int bid, int nblk_) {
    const int gw = bid * 8 + wid, NGW = nblk_ * 8;
    f32x4 gv[4];
#pragma unroll
    for (int j = 0; j < 4; ++j) gv[j] = *(const f32x4*)(gain + 4 * (lane + 64 * j));
    for (int row0 = gw; row0 < nrows; row0 += 4 * NGW) {
        f32x4 v[4][4]; float ss[4];
#pragma unroll
        for (int r = 0; r < 4; ++r) {
            const int row = row0 + r * NGW; ss[r] = 0.f;
            if (row < nrows) {
                const float* src = row < TL ? xl + (size_t)row * D : xc + (size_t)(row - TL) * D;
#pragma unroll
                for (int j = 0; j < 4; ++j) v[r][j] = *(const f32x4*)(src + 4 * (lane + 64 * j));
            } else {
#pragma unroll
                for (int j = 0; j < 4; ++j) v[r][j] = (f32x4){0.f, 0.f, 0.f, 0.f};
            }
        }
#pragma unroll
        for (int r = 0; r < 4; ++r) {
            const int row = row0 + r * NGW;
            if (row >= nrows) continue;
#pragma unroll
            for (int j = 0; j < 4; ++j) ss[r] += (v[r][j][0] * v[r][j][0] + v[r][j][1] * v[r][j][1]) + (v[r][j][2] * v[r][j][2] + v[r][j][3] * v[r][j][3]);
            const float rstd = __builtin_amdgcn_rsqf(wave_sum(ss[r]) * (1.0f / D) + EPS);
            const int b = row < TL ? (row >> 11) : 32;
            const float* mp = modl + (size_t)b * NMOD + shift_off;
#pragma unroll
            for (int j = 0; j < 4; ++j) {
                const int c = 4 * (lane + 64 * j);
                const f32x4 sh = *(const f32x4*)(mp + c), sc = *(const f32x4*)(mp + D + c);
                const f32x4 y = v[r][j] * rstd * gv[j] * (sc + 1.0f) + sh;
                u32x2 w; w.x = pk2(y[0], y[1]); w.y = pk2(y[2], y[3]);
                *(u32x2*)(U + (size_t)row * D + c) = w;
            }
        }
    }
}

struct AttnJob {
    const bf16_t* Q; int qpitch;
    const bf16_t* K; int kpitch;
    const bf16_t* Vt;
    bf16_t* O;
    int ctx_row0, lat_row0, ntiles;
    int na, r0, rlo;
    int fast;
};
#define MFMA32(a, b, c) __builtin_amdgcn_mfma_f32_32x32x16_bf16((a), (b), (c), 0, 0, 0)

__device__ __forceinline__ void glds16(const void* gsrc, unsigned lds_dst) { unsigned keep;
    asm volatile("s_mov_b32 %0, m0\n\ts_mov_b32 m0, %2\n\ts_nop 0\n\tglobal_load_lds_dwordx4 %1, off\n\ts_mov_b32 m0, %0" : "=&s"(keep) : "v"(gsrc), "s"(lds_dst) : "memory"); }
template <bool FAST>
__device__ __forceinline__ void att_scores(const LAS unsigned char* kb_, const bf16x8 (&qf)[4], int pi, int kx, int hi, bool local, const LAS float* bp, unsigned vmask, bool first,
                                           float& mrun, f32x16& o0, f32x16& o1, float& lrun, bf16x8 (&pf)[2][2]) {
    constexpr float THR = 8.0f;
    f32x16 s0, s1;
    if constexpr (FAST) {
#pragma unroll
        for (int i = 0; i < 16; ++i) { s0[i] = 0.f; s1[i] = 0.f; }
    } else {
        const float nm = -mrun;
#pragma unroll
        for (int i = 0; i < 16; ++i) { s0[i] = nm; s1[i] = nm; }
    }
    {
        bf16x8 a0[4], a1[4];
#pragma unroll
        for (int ks = 0; ks < 4; ++ks) { a0[ks] = *(const LAS bf16x8*)(kb_ + pi * 128 + (((2 * ks + hi) ^ kx) << 4)); a1[ks] = *(const LAS bf16x8*)(kb_ + (32 + pi) * 128 + (((2 * ks + hi) ^ kx) << 4)); }
        __builtin_amdgcn_sched_barrier(0);
#pragma unroll
        for (int ks = 0; ks < 4; ++ks) s0 = MFMA32(a0[ks], qf[ks], s0);
#pragma unroll
        for (int ks = 0; ks < 4; ++ks) s1 = MFMA32(a1[ks], qf[ks], s1);
    }
    if (local) {
#pragma unroll
        for (int i = 0; i < 16; ++i) {
            const float b0 = bp[16 * (i >> 3) + (i & 7)], b1 = bp[32 + 16 * (i >> 3) + (i & 7)];
            const unsigned m0 = (unsigned)__builtin_amdgcn_sbfe((int)vmask, i, 1), m1 = (unsigned)__builtin_amdgcn_sbfe((int)vmask, 16 + i, 1);
            const unsigned v0 = __builtin_bit_cast(unsigned, s0[i] + b0), v1 = __builtin_bit_cast(unsigned, s1[i] + b1);
            s0[i] = __builtin_bit_cast(float, (v0 & m0) | (0xf149f2cau & ~m0));
            s1[i] = __builtin_bit_cast(float, (v1 & m1) | (0xf149f2cau & ~m1));
            if ((i & 3) == 3) __builtin_amdgcn_sched_barrier(0);
        }
    }
    if constexpr (!FAST) {
    float mt = fmaxf(s0[0], s1[0]);
#pragma unroll
    for (int i = 1; i < 16; ++i) mt = fmaxf(mt, fmaxf(s0[i], s1[i]));
    mt = fmaxf(mt, __shfl_xor(mt, 32));
    if (first || __any(mt > THR)) {
        const float delta = first ? mt : (mt > THR ? mt : 0.f);
        const float alpha = first ? 1.0f : fast_exp2(-delta);
        mrun += delta;
#pragma unroll
        for (int i = 0; i < 16; ++i) { s0[i] -= delta; s1[i] -= delta; o0[i] *= alpha; o1[i] *= alpha; }
        lrun *= alpha;
    }
    }
    float rs = 0.f;
#pragma unroll
    for (int i = 0; i < 16; ++i) { s0[i] = fast_exp2(s0[i]); s1[i] = fast_exp2(s1[i]); rs += s0[i] + s1[i]; }
    lrun += rs;
#pragma unroll
    for (int cc = 0; cc < 2; ++cc) {
        u32x4 w0, w1;
        w0.x = pk2(s0[8 * cc + 0], s0[8 * cc + 1]); w0.y = pk2(s0[8 * cc + 2], s0[8 * cc + 3]); w0.z = pk2(s0[8 * cc + 4], s0[8 * cc + 5]); w0.w = pk2(s0[8 * cc + 6], s0[8 * cc + 7]);
        w1.x = pk2(s1[8 * cc + 0], s1[8 * cc + 1]); w1.y = pk2(s1[8 * cc + 2], s1[8 * cc + 3]); w1.z = pk2(s1[8 * cc + 4], s1[8 * cc + 5]); w1.w = pk2(s1[8 * cc + 6], s1[8 * cc + 7]);
        pf[0][cc] = __builtin_bit_cast(bf16x8, w0); pf[1][cc] = __builtin_bit_cast(bf16x8, w1);
    }
}
__device__ __forceinline__ void att_pv(const LAS unsigned char* vb_, int q, int vx, int hi, const bf16x8 (&pf)[2][2], f32x16& o0, f32x16& o1) {
#pragma unroll
    for (int kb = 0; kb < 2; ++kb) {
        bf16x8 v0[2], v1[2];
#pragma unroll
        for (int cc = 0; cc < 2; ++cc) { const int ch = 4 * kb + 2 * cc + hi;
            v0[cc] = *(const LAS bf16x8*)(vb_ + q * 128 + ((ch ^ vx) << 4)); v1[cc] = *(const LAS bf16x8*)(vb_ + (32 + q) * 128 + ((ch ^ vx) << 4)); }
        __builtin_amdgcn_sched_barrier(0);
#pragma unroll
        for (int cc = 0; cc < 2; ++cc) { o0 = MFMA32(v0[cc], pf[kb][cc], o0); o1 = MFMA32(v1[cc], pf[kb][cc], o1); }
        __builtin_amdgcn_sched_barrier(0);
    }
}

__device__ __forceinline__ void att_tile_fast(const LAS unsigned char* kb_, const LAS unsigned char* vb_, const bf16x8 (&qf)[4], int pi, int kx, int q, int vx, int hi,
                                              f32x16& o0, f32x16& o1, float& lrun) {
    bf16x8 a0[4], a1[4];
#pragma unroll
    for (int ks = 0; ks < 4; ++ks) { a0[ks] = *(const LAS bf16x8*)(kb_ + pi * 128 + (((2 * ks + hi) ^ kx) << 4)); a1[ks] = *(const LAS bf16x8*)(kb_ + (32 + pi) * 128 + (((2 * ks + hi) ^ kx) << 4)); }
    __builtin_amdgcn_sched_barrier(0);
    f32x16 s0, s1;
#pragma unroll
    for (int i = 0; i < 16; ++i) { s0[i] = 0.f; s1[i] = 0.f; }
#pragma unroll
    for (int ks = 0; ks < 4; ++ks) s0 = MFMA32(a0[ks], qf[ks], s0);
    __builtin_amdgcn_sched_barrier(0);
    float rs = 0.f;
#pragma unroll
    for (int ks = 0; ks < 4; ++ks) {
        s1 = MFMA32(a1[ks], qf[ks], s1);
#pragma unroll
        for (int i = 4 * ks; i < 4 * ks + 4; ++i) { s0[i] = fast_exp2(s0[i]); rs += s0[i]; }
        __builtin_amdgcn_sched_barrier(0);
    }
    bf16x8 p0[2];
#pragma unroll
    for (int cc = 0; cc < 2; ++cc) { u32x4 w; w.x = pk2(s0[8 * cc + 0], s0[8 * cc + 1]); w.y = pk2(s0[8 * cc + 2], s0[8 * cc + 3]); w.z = pk2(s0[8 * cc + 4], s0[8 * cc + 5]); w.w = pk2(s0[8 * cc + 6], s0[8 * cc + 7]); p0[cc] = __builtin_bit_cast(bf16x8, w); }
    bf16x8 va0[2], va1[2];
#pragma unroll
    for (int cc = 0; cc < 2; ++cc) { const int ch = 2 * cc + hi; va0[cc] = *(const LAS bf16x8*)(vb_ + q * 128 + ((ch ^ vx) << 4)); va1[cc] = *(const LAS bf16x8*)(vb_ + (32 + q) * 128 + ((ch ^ vx) << 4)); }
    __builtin_amdgcn_sched_barrier(0);
#pragma unroll
    for (int g = 0; g < 4; ++g) {
        if (g & 1) o1 = MFMA32(va1[g >> 1], p0[g >> 1], o1); else o0 = MFMA32(va0[g >> 1], p0[g >> 1], o0);
#pragma unroll
        for (int i = 4 * g; i < 4 * g + 4; ++i) { s1[i] = fast_exp2(s1[i]); rs += s1[i]; }
        __builtin_amdgcn_sched_barrier(0);
    }
    bf16x8 vb0[2], vb1[2];
#pragma unroll
    for (int cc = 0; cc < 2; ++cc) { const int ch = 4 + 2 * cc + hi; vb0[cc] = *(const LAS bf16x8*)(vb_ + q * 128 + ((ch ^ vx) << 4)); vb1[cc] = *(const LAS bf16x8*)(vb_ + (32 + q) * 128 + ((ch ^ vx) << 4)); }
    bf16x8 p1[2];
#pragma unroll
    for (int cc = 0; cc < 2; ++cc) { u32x4 w; w.x = pk2(s1[8 * cc + 0], s1[8 * cc + 1]); w.y = pk2(s1[8 * cc + 2], s1[8 * cc + 3]); w.z = pk2(s1[8 * cc + 4], s1[8 * cc + 5]); w.w = pk2(s1[8 * cc + 6], s1[8 * cc + 7]); p1[cc] = __builtin_bit_cast(bf16x8, w); }
#pragma unroll
    for (int cc = 0; cc < 2; ++cc) { o0 = MFMA32(vb0[cc], p1[cc], o0); o1 = MFMA32(vb1[cc], p1[cc], o1); }
    lrun += rs;
}

__device__ __forceinline__ void attn_unit(LAS unsigned char* lds, const AttnJob& J, const LAS float* biasL, int tid, int wid, int lane) {
    const int q = lane & 31, hi = lane >> 5;
    bf16x8 qf[4];
    f32x16 o0, o1; float lrun = 0.f;
#pragma unroll
    for (int i = 0; i < 16; ++i) { o0[i] = 0.f; o1[i] = 0.f; }
    float mrun = 0.f;
    bf16x8 pf[2][2];
#pragma unroll
    for (int a = 0; a < 2; ++a)
#pragma unroll
        for (int b = 0; b < 2; ++b) pf[a][b] = (bf16x8){0, 0, 0, 0, 0, 0, 0, 0};
    const int srow = tid >> 3;
    const int gch = (tid & 7) ^ ((srow >> 1) & 7);
    const int pi = (q & 0x13) | ((q & 4) << 1) | ((q & 8) >> 1);
    const int kx = (pi >> 1) & 7, vx = (q >> 1) & 7;
    const int rq = J.r0 + (wid >> 1), cq = (wid & 1) * 32 + q;
    const int rs_ = min(max(rq - 4, 0), 24), cs_ = min(max(cq - 8, 0), 48);
    unsigned vmask = 0u;
    if (J.na) {
#pragma unroll
        for (int i = 0; i < 32; ++i) { const int kc = 32 * (i >> 4) + 16 * ((i >> 3) & 1) + 8 * hi + (i & 7); vmask |= ((unsigned)(kc - cs_) < 16u ? 1u : 0u) << i; }
    }
    const int blane = 8 * hi - cq + 15 + 48;
    const bool fast = J.fast != 0;
    const bf16_t* kg = J.K + (size_t)srow * J.kpitch + gch * 8;
    const bf16_t* vg = J.Vt + (size_t)srow * T + gch * 8;
    const unsigned ldsw0 = (unsigned)(unsigned long long)lds + (unsigned)wid * 1024u;
#define ATT_ISSUE(tile, vslot) do { const int t_ = (tile); const int tk_ = t_ < 4 ? J.ctx_row0 + 64 * t_ : J.lat_row0 + 64 * (t_ - 4); \
        glds16(kg + (size_t)tk_ * J.kpitch, (unsigned)__builtin_amdgcn_readfirstlane((int)(ldsw0 + (t_ & 3) * 8192))); \
        glds16(vg + tk_, (unsigned)__builtin_amdgcn_readfirstlane((int)(ldsw0 + 32768 + (vslot) * 8192))); } while (0)
    ATT_ISSUE(0, 0); ATT_ISSUE(1, 1); ATT_ISSUE(2, 2);
    { const bf16_t* qrow = J.Q + (size_t)(wid * 32 + q) * J.qpitch + 8 * hi;
#pragma unroll
      for (int ks = 0; ks < 4; ++ks) qf[ks] = *(const bf16x8*)(qrow + 16 * ks); }
    asm volatile("s_waitcnt vmcnt(0) lgkmcnt(0)" :: "v"(qf[0]), "v"(qf[1]), "v"(qf[2]), "v"(qf[3]) : "memory");
    __builtin_amdgcn_s_barrier(); asm volatile("" ::: "memory");
    int vcur = 0, vprev = 4;
    for (int it = 0; it < J.ntiles; ++it) {
        const LAS unsigned char* kb_ = lds + (it & 3) * 8192;
        const int vnext = vcur == 4 ? 0 : vcur + 1;
        if (it + 3 < J.ntiles) { const int v3 = vcur + 3 >= 5 ? vcur - 2 : vcur + 3; ATT_ISSUE(it + 3, v3); }
        const int kr = J.rlo + it - 4;
        const bool local = J.na && it >= 4;
        const bool active = !local || (kr >= rs_ && kr < rs_ + 8);
        const LAS float* bp = biasL + (kr - rq + 7) * 128 + blane;
        if (active) {
            if (fast && !local) att_tile_fast(kb_, lds + 32768 + vcur * 8192, qf, pi, kx, q, vx, hi, o0, o1, lrun);
            else {
                if (fast) att_scores<true>(kb_, qf, pi, kx, hi, local, bp, vmask, it == 0, mrun, o0, o1, lrun, pf); else att_scores<false>(kb_, qf, pi, kx, hi, local, bp, vmask, it == 0, mrun, o0, o1, lrun, pf);
                att_pv(lds + 32768 + vcur * 8192, q, vx, hi, pf, o0, o1);
            }
        }
        const int ny = J.ntiles - (it + 2);
        if (ny >= 2) asm volatile("s_waitcnt vmcnt(4)" ::: "memory"); else if (ny == 1) asm volatile("s_waitcnt vmcnt(2)" ::: "memory"); else asm volatile("s_waitcnt vmcnt(0)" ::: "memory");
        __builtin_amdgcn_s_barrier(); asm volatile("" ::: "memory");
        vprev = vcur; vcur = vnext;
    }
#undef ATT_ISSUE
    const float inv = fast_rcp(lrun + __shfl_xor(lrun, 32));
    bf16_t* orow = J.O + (size_t)(wid * 32 + q) * D + 4 * hi;
#pragma unroll
    for (int c = 0; c < 4; ++c) {
        u32x2 w0, w1;
        w0.x = pk2(o0[4 * c] * inv, o0[4 * c + 1] * inv); w0.y = pk2(o0[4 * c + 2] * inv, o0[4 * c + 3] * inv);
        w1.x = pk2(o1[4 * c] * inv, o1[4 * c + 1] * inv); w1.y = pk2(o1[4 * c + 2] * inv, o1[4 * c + 3] * inv);
        *(u32x2*)(orow + 8 * c) = w0; *(u32x2*)(orow + 32 + 8 * c) = w1;
    }
}

__device__ __forceinline__ void pool_unit(LAS unsigned char* lds, const bf16_t* PC, const float* wpool, const float* pscale, bf16_t* Y, int unit, int tid) {
    const int row0 = unit * 64;
    const int seq0 = row0 < TL ? (row0 & ~(SEQ - 1)) : TL + ((row0 - TL) & ~(LCTX - 1));
    const int N = row0 < TL ? SEQ : LCTX;
    const int t0 = row0 - seq0;
    LAS unsigned short* vin = (LAS unsigned short*)lds;
    constexpr int PP = 264;
    LAS unsigned short* pooled = (LAS unsigned short*)(lds + 40960);
    for (int i = tid; i < 80 * 32; i += 512) {
        const int lr = i >> 5, ch8 = i & 31, t = t0 - 8 + lr;
        u32x4 v = (u32x4){0u, 0u, 0u, 0u};
        if (t >= 0 && t < N) v = *(const u32x4*)(PC + (size_t)(seq0 + t) * 256 + ch8 * 8);
        *(LAS u32x4*)(lds + (lr * 256 + ch8 * 8) * 2) = v;
    }
    __syncthreads();
    {
        const int ch = tid & 255, th = tid >> 8, g = ch >> 6, hw = 1 << g;
        const LAS unsigned short* vp = vin + (th * 32 + 8) * 256 + ch;
        float s = 0.f;
        for (int k = -hw; k < hw; ++k) s += bf2f(vp[k * 256]);
#pragma unroll 8
        for (int i = 0; i < 32; ++i) {
            const int tl = th * 32 + i, t = t0 + tl;
            const int lo = max(t - hw, 0), hi2 = min(t + hw, N);
            pooled[tl * PP + ch] = (unsigned short)f2bf(s * fast_rcp((float)(hi2 - lo)) - bf2f(vp[i * 256]));
            s += bf2f(vp[(i + hw) * 256]) - bf2f(vp[(i - hw) * 256]);
        }
    }
    __syncthreads();
    {
        const int lane = tid & 63, wid = tid >> 6, g = wid & 3, th = wid >> 2, q = lane & 31, hi = lane >> 5;
        const float* wg = wpool + (size_t)g * 64 * 64;
        bf16x8 af[4];
#pragma unroll
        for (int ks = 0; ks < 4; ++ks) af[ks] = *(const LAS bf16x8*)(pooled + (th * 32 + q) * PP + g * 64 + 16 * ks + 8 * hi);
#pragma unroll
        for (int db = 0; db < 2; ++db) {
            f32x16 dacc;
#pragma unroll
            for (int i = 0; i < 16; ++i) dacc[i] = 0.f;
#pragma unroll
            for (int ks = 0; ks < 4; ++ks) {
                const float* wp = wg + (size_t)(16 * ks + 8 * hi) * 64 + 32 * db + q;
                u32x4 w; w.x = pk2(wp[0], wp[64]); w.y = pk2(wp[128], wp[192]); w.z = pk2(wp[256], wp[320]); w.w = pk2(wp[384], wp[448]);
                dacc = MFMA32(af[ks], __builtin_bit_cast(bf16x8, w), dacc);
            }
            const int col = g * 64 + 32 * db + q;
            const float sc = pscale[col];
#pragma unroll
            for (int r = 0; r < 16; ++r) { const int tok = 8 * (r >> 2) + 4 * hi + (r & 3);
                Y[(size_t)(row0 + th * 32 + tok) * D + 768 + col] = (bf16_t)f2bf(dacc[r] * sc); }
        }
    }
    __syncthreads();
}

__device__ __forceinline__ void mixer_phase(KArgsPtr a, int l, bool lastl, LAS unsigned char* lds, unsigned* ctr, int tid_) {
    unsigned char* ws = a->ws;
    const bf16_t* big = (const bf16_t*)(ws + WS_BIG);
    bf16_t* Y = (bf16_t*)(ws + WS_U);
    constexpr int NG = NB * 6 * 8, NN = NB * 6 * 8, NCA = NB * 6, NCB = NB * 6;
    const int ncx = lastl ? 0 : NCA + NCB;
    const int npool = (lastl ? TL : T) / 64;
    const int total0 = NG + NN + ncx + npool;
    const int total = total0 + (MIX_DUP == 1 ? NG : MIX_DUP == 2 ? NN : MIX_DUP == 3 ? npool : 0);
    LAS int* shu = (LAS int*)(lds + LDS_MISC);
    LAS float* biasL = (LAS float*)(lds + 73728);
    int fastA, fastB, fastN;
    { const int ln = tid_ & 63;
      float qa = fabsf(a->in[9][l * 64 + ln]), ka = fabsf(a->in[10][l * 64 + ln]), qb = fabsf(a->in[11][l * 64 + ln]), kb = fabsf(a->in[12][l * 64 + ln]), bm = 0.f;
      for (int i = ln; i < 6 * 465; i += 64) bm = fmaxf(bm, fabsf(a->in[13][(size_t)l * 6 * 465 + i]));
#pragma unroll
      for (int o = 1; o < 64; o <<= 1) { qa = fmaxf(qa, __shfl_xor(qa, o)); ka = fmaxf(ka, __shfl_xor(ka, o)); qb = fmaxf(qb, __shfl_xor(qb, o)); kb = fmaxf(kb, __shfl_xor(kb, o)); bm = fmaxf(bm, __shfl_xor(bm, o)); }
      fastA = __builtin_amdgcn_readfirstlane((int)(11.5416f * qa * ka < 60.f));
      fastB = __builtin_amdgcn_readfirstlane((int)(11.5416f * qb * kb < 60.f));
      fastN = __builtin_amdgcn_readfirstlane((int)(11.5416f * qa * ka + bm * LOG2E < 60.f)); }
    if (tid_ == 0) shu[0] = (int)atomicAdd(ctr, 1u);
    __syncthreads();
    int u = __builtin_amdgcn_readfirstlane(shu[0]);
    for (int uit = 0;; ++uit) {
        int tid = tid_; asm volatile("" : "+v"(tid));
        const int lane = tid & 63, wid = __builtin_amdgcn_readfirstlane(tid >> 6);
        if (u >= total) break;
        if (u >= total0) u = u - total0 + (MIX_DUP == 2 ? NG : MIX_DUP == 3 ? NG + NN + ncx : 0);
        int nxt_ = 0; if (tid == 0) nxt_ = (int)atomicAdd(ctr, 1u);
        if (u < NG + NN + ncx) {
            AttnJob J;
            if (u < NG) {
                const int qb = u & 7, hq = (u >> 3) % 6, b = u / 48, hkv = hq / 3;
                J.Q = big + B_QB + (size_t)(b * SEQ + qb * 256) * 384 + hq * 64; J.qpitch = 384;
                J.K = big + B_KB + hkv * 64; J.kpitch = 128; J.Vt = big + B_VBT + (size_t)(hkv * 64) * T;
                J.O = Y + (size_t)(b * SEQ + qb * 256) * D + 384 + hq * 64;
                J.ctx_row0 = TL + b * LCTX; J.lat_row0 = b * SEQ; J.ntiles = 4 + 32; J.na = 0; J.r0 = 0; J.rlo = 0;
                J.fast = fastB;
            } else if ((u -= NG) < NN) {
                const int rg = u & 7, h = (u >> 3) % 6, b = u / 48, r0 = rg * 4;
                const int rlo = min(max(r0 - 4, 0), 24), rhi = min(max(r0 + 3 - 4, 0), 24) + 8;
                const float* rpb = a->in[13] + ((size_t)l * 6 + h) * 15 * 31;
                for (int i = tid; i < 15 * 128; i += 512) { const int dc = (i & 127) - 48; biasL[i] = (dc >= 0 && dc < 31) ? rpb[(i >> 7) * 31 + dc] * LOG2E : 0.f; }
                J.Q = big + B_QA + (size_t)(b * SEQ + r0 * 64) * 384 + h * 64; J.qpitch = 384;
                J.K = big + B_KA + h * 64; J.kpitch = 384; J.Vt = big + B_VAT + (size_t)(h * 64) * T;
                J.O = Y + (size_t)(b * SEQ + r0 * 64) * D + h * 64;
                J.ctx_row0 = TL + b * LCTX; J.lat_row0 = b * SEQ + rlo * 64; J.ntiles = 4 + (rhi - rlo); J.na = 1; J.r0 = r0; J.rlo = rlo;
                J.fast = fastN;
            } else {
                u -= NN;
                const bool second = u >= NCA; if (second) u -= NCA;
                const int h = u % 6, b = u / 6;
                if (!second) { J.Q = big + B_QA + (size_t)(TL + b * LCTX) * 384 + h * 64; J.K = big + B_KA + h * 64; J.kpitch = 384; J.Vt = big + B_VAT + (size_t)(h * 64) * T; J.O = Y + (size_t)(TL + b * LCTX) * D + h * 64; }
                else { const int hkv = h / 3; J.Q = big + B_QB + (size_t)(TL + b * LCTX) * 384 + h * 64; J.K = big + B_KB + hkv * 64; J.kpitch = 128; J.Vt = big + B_VBT + (size_t)(hkv * 64) * T; J.O = Y + (size_t)(TL + b * LCTX) * D + 384 + h * 64; }
                J.qpitch = 384; J.ctx_row0 = TL + b * LCTX; J.lat_row0 = 0; J.ntiles = 4; J.na = 0; J.r0 = 0; J.rlo = 0;
                J.fast = second ? fastB : fastA;
            }
            attn_unit(lds, J, biasL, tid, wid, lane);
        } else {
            u -= NG + NN + ncx;
            pool_unit(lds, big + B_PC, a->in[14] + (size_t)l * 4 * 64 * 64, a->in[15] + (size_t)l * 256, Y, u, tid);
        }
        if (tid == 0) shu[(uit + 1) & 1] = nxt_;
        __syncthreads();
        u = __builtin_amdgcn_readfirstlane(shu[(uit + 1) & 1]);
    }
}


#define XB_TMO      128
#define XB_XCNT(j)  (256  + 64 * (j))
#define XB_XSUB(j)  (1280 + 64 * (j))
#define XB_XGEN(j)  (2304 + 64 * (j))
#define XB_TOP      3328
#define XB_TOPGEN   3392
#define XB_SPIN_CAP (1u << 22)
constexpr int CW_BAR = 4096;
__device__ __forceinline__ unsigned xb_ld(unsigned* p)              { return __hip_atomic_load(p, __ATOMIC_RELAXED, __HIP_MEMORY_SCOPE_AGENT); }
__device__ __forceinline__ unsigned xb_add(unsigned* p, unsigned v) { return __hip_atomic_fetch_add(p, v, __ATOMIC_RELAXED, __HIP_MEMORY_SCOPE_AGENT); }
__device__ __forceinline__ unsigned xb_xcc_id() { return (unsigned)__builtin_amdgcn_s_getreg((3 << 11) | 20) & 0xFu; }
#define XB_SPIN(cond, bar) do { unsigned _sp = 0; while (cond) { __builtin_amdgcn_s_sleep(1); \
    if ((++_sp & 255u) == 0u) { if (xb_ld(&(bar)[XB_TMO])) break; if (_sp > XB_SPIN_CAP) { atomicAdd(&(bar)[XB_TMO], 1u); break; } } } } while (0)
__device__ __forceinline__ void xcd_barrier_complete(unsigned* bar, unsigned x, unsigned& nloc, unsigned& nx) {
    const unsigned G = gridDim.x * gridDim.y * gridDim.z;
    unsigned sum, cnt, mine, sp = 0u;
    for (;;) {
        sum = 0u; cnt = 0u; mine = 0u;
#pragma unroll
        for (unsigned j = 0; j < 16; ++j) { const unsigned c = xb_ld(&bar[XB_XCNT(j)]); sum += c; cnt += (c > 0u) ? 1u : 0u; mine = (j == x) ? c : mine; }
        if (sum == G) break;
        __builtin_amdgcn_s_sleep(1);
        if ((++sp & 255u) == 0u) { if (xb_ld(&bar[XB_TMO])) break; if (sp > XB_SPIN_CAP) { atomicAdd(&bar[XB_TMO], 1u); break; } }
    }
    nloc = mine > 0u ? mine : 1u; nx = cnt > 0u ? cnt : 1u;
}
__device__ __forceinline__ void xcd_barrier(unsigned* bar, volatile LAS unsigned* st) {
    asm volatile("s_waitcnt vmcnt(0)" ::: "memory");
    __syncthreads();
    if (threadIdx.x == 0) {
        const unsigned x = xb_xcc_id();
        __builtin_amdgcn_s_waitcnt(0);
        unsigned nloc = st[0], nx = st[1];
        if (nloc == 0u) { xcd_barrier_complete(bar, x, nloc, nx); st[0] = nloc; st[1] = nx; }
        const unsigned old = xb_add(&bar[XB_XSUB(x)], 1u);
        const unsigned gen = old / nloc;
        if (old + 1u == (gen + 1u) * nloc) {
            __builtin_amdgcn_fence(__ATOMIC_RELEASE, "agent");
            asm volatile("s_waitcnt vmcnt(0)" ::: "memory");
            const unsigned og = xb_add(&bar[XB_TOP], 1u);
            const unsigned tg = og / nx;
            if (og + 1u == (tg + 1u) * nx) xb_add(&bar[XB_TOPGEN], 1u);
            else XB_SPIN(xb_ld(&bar[XB_TOPGEN]) == tg, bar);
            __builtin_amdgcn_fence(__ATOMIC_ACQUIRE, "agent");
            xb_add(&bar[XB_XGEN(x)], 1u);
            asm volatile("s_waitcnt vmcnt(0)" ::: "memory");
        } else {
            XB_SPIN(xb_ld(&bar[XB_XGEN(x)]) == gen, bar);
            __builtin_amdgcn_fence(__ATOMIC_ACQUIRE, "agent");
            asm volatile("s_waitcnt vmcnt(0)" ::: "memory");
        }
    }
    __syncthreads();
}

__device__ __forceinline__ KArgsPtr fresh_args() {
    KArgsPtr p = (KArgsPtr)__builtin_amdgcn_kernarg_segment_ptr();
    asm volatile("" : "+s"(p) :: "memory");
    return p;
}
#define IN(k) (lo <= (k) && (k) < hi)
#define SEAM(k) do { if ((k) + 1 < hi) { if (lo < 0) { __threadfence(); cg::this_grid().sync(); } else xcd_barrier((unsigned*)(a_.ws + WS_CTL) + CW_BAR, (volatile LAS unsigned*)(lds + LDS_MISC + 16)); } } while (0)
#define PH_COMMON KArgsPtr a = fresh_args(); unsigned char* ws = a->ws; int tid = threadIdx.x; asm volatile("" : "+v"(tid)); const int lane = tid & 63, wid = __builtin_amdgcn_readfirstlane(tid >> 6); \
    int G = __builtin_amdgcn_readfirstlane((int)gridDim.x), c = __builtin_amdgcn_readfirstlane((int)blockIdx.x); \
    bf16_t* U = (bf16_t*)(ws + WS_U); bf16_t* BIG = (bf16_t*)(ws + WS_BIG); float* modall = (float*)(ws + WS_MOD); float* hbuf = (float*)(ws + WS_H); float* xout = a->out; \
    const bool lastl = (l == DEPTH - 1); const float* modl = modall + (size_t)l * 33 * NMOD; const float* xs = l == 0 ? a->in[0] : xout; const float* hs = l == 0 ? a->in[2] : hbuf; const int M = lastl ? TL : T; \
    (void)tid; (void)lane; (void)wid; (void)G; (void)c; (void)U; (void)BIG; (void)hbuf; (void)modl; (void)xs; (void)hs; (void)M; (void)lastl; (void)xout;
__global__ void __launch_bounds__(512, 2) mega_fwd(Args a_) {
    extern __shared__ __attribute__((aligned(16))) unsigned char lds_raw[];
    LAS unsigned char* lds = (LAS unsigned char*)lds_raw;
    const int lo = a_.ph_lo, hi = a_.ph_hi;
    if (threadIdx.x == 0) { ((volatile LAS unsigned*)(lds + LDS_MISC + 16))[0] = 0u; ((volatile LAS unsigned*)(lds + LDS_MISC + 16))[1] = 0u;
        (void)xb_add((unsigned*)(a_.ws + WS_CTL) + CW_BAR + XB_XCNT(xb_xcc_id()), 1u); }
    __syncthreads();
    if (IN(0)) { const int l = 0; PH_COMMON prep_phase(a, lds, tid, wid, lane, c, G);
#if PREP_DOUBLE
        xcd_barrier((unsigned*)(a_.ws + WS_CTL) + CW_BAR, (volatile LAS unsigned*)(lds + LDS_MISC + 16)); prep_phase(a, lds, tid, wid, lane, c, G);
#endif
        SEAM(0); }
    if (IN(1)) { const int l = 0; PH_COMMON
        pg8::Gemm g{(const bf16_t*)(ws + WS_SC), (const bf16_t*)(ws + WS_BIG), 256, DEPTH * NMOD, D};
        pg8::StaticOrder S; S.init(256, DEPTH * NMOD, G, c);
        EpiMod E{modall, a->in[5]};
        pg8::gemm_phase<EpiMod, pg8::StaticOrder, false, true>(lds, g, S, E, tid);
        SEAM(1);
    }
#pragma unroll 1
    for (int l = 0; l < DEPTH; ++l) {
        const int pb = 2 + 8 * l;
        if (IN(pb + 0) && l == 0) { for (int rep_ = 0; rep_ < ((REP_MASK >> 0) & 1) + 1; ++rep_) { if (rep_) { xcd_barrier((unsigned*)(a_.ws + WS_CTL) + CW_BAR, (volatile LAS unsigned*)(lds + LDS_MISC + 16)); } PH_COMMON norm_phase(xs, hs, a->in[6] + l * D, modl, 0, T, U, wid, lane, c, G); } SEAM(pb + 0); }
        if (IN(pb + 1)) { for (int rep_ = 0; rep_ < ((REP_MASK >> 1) & 1) + 1; ++rep_) { if (rep_) { xcd_barrier((unsigned*)(a_.ws + WS_CTL) + CW_BAR, (volatile LAS unsigned*)(lds + LDS_MISC + 16)); } PH_COMMON
            pg8::Gemm g{U, (const bf16_t*)(ws + WS_WIN) + (size_t)l * NIN * D, T, NIN, D};
            pg8::StaticOrder S; S.init(T, NIN, G, c);
            EpiIn E{BIG, a->in[9] + l * 64, a->in[10] + l * 64, a->in[11] + l * 64, a->in[12] + l * 64, (const f32x2*)(ws + WS_ROPE)};
            pg8::gemm_phase<EpiIn, pg8::StaticOrder, true, true>(lds, g, S, E, tid, ((c >> 3) & 3) * STG_K1024);
            } SEAM(pb + 1);
        }
        if (IN(pb + 2)) { for (int rep_ = 0; rep_ < ((REP_MASK >> 2) & 1) + 1; ++rep_) { if (rep_) { xcd_barrier((unsigned*)(a_.ws + WS_CTL) + CW_BAR, (volatile LAS unsigned*)(lds + LDS_MISC + 16)); } PH_COMMON mixer_phase(a, l, lastl, lds, (unsigned*)(ws + WS_CTL) + 64 * (1 + l + 8 * rep_), tid); } SEAM(pb + 2); }
        if (IN(pb + 3)) { for (int rep_ = 0; rep_ < ((REP_MASK >> 3) & 1) + 1; ++rep_) { if (rep_) { xcd_barrier((unsigned*)(a_.ws + WS_CTL) + CW_BAR, (volatile LAS unsigned*)(lds + LDS_MISC + 16)); } PH_COMMON
            pg8::Gemm g{U, (const bf16_t*)(ws + WS_WBR) + (size_t)l * D * D, M, D, D};
            pg8::PanelOrder S; S.init(M, G, c);
            EpiMerge E{BIG + B_G, BIG};
            pg8::gemm_phase<EpiMerge, pg8::PanelOrder, true, true>(lds, g, S, E, tid);
            } SEAM(pb + 3);
        }
        if (IN(pb + 4)) { PH_COMMON
            pg8::Gemm g{BIG, (const bf16_t*)(ws + WS_WOUT) + (size_t)l * D * D, M, D, D};
            pg8::PanelOrder S; S.init(M, G, c);
            EpiResNorm E{xs, xout, hs, hbuf, modl, 2 * D, a->in[7] + l * D, modl, 3 * D, U, (float*)(ws + WS_SLOTS), (unsigned*)(ws + WS_CTL + CTL_PANEL) + (l * 2 + 0) * 512, lds + LDS_XCH};
            pg8::gemm_phase<EpiResNorm, pg8::PanelOrder, true, true>(lds, g, S, E, tid);
            SEAM(pb + 4);
        }
        if (IN(pb + 6)) { for (int rep_ = 0; rep_ < ((REP_MASK >> 6) & 1) + 1; ++rep_) { if (rep_) { xcd_barrier((unsigned*)(a_.ws + WS_CTL) + CW_BAR, (volatile LAS unsigned*)(lds + LDS_MISC + 16)); } PH_COMMON
            pg8::Gemm g{U, (const bf16_t*)(ws + WS_W13) + (size_t)l * 2 * FF * D, M, 2 * FF, D};
            pg8::StaticOrder S; S.init(M, 2 * FF, G, c);
            EpiFF1 E{BIG};
            pg8::gemm_phase<EpiFF1, pg8::StaticOrder, true, true>(lds, g, S, E, tid, ((c >> 3) & 3) * STG_K1024);
            } SEAM(pb + 6);
        }
        if (IN(pb + 7)) { PH_COMMON
            pg8::Gemm g{BIG, (const bf16_t*)(ws + WS_W2) + (size_t)l * D * FF, M, D, FF};
            if (lastl) {
                pg8::StaticOrder S; S.init(M, D, G, c);
                EpiRes E{xout, xout, hbuf, hbuf, modl, 5 * D};
                pg8::gemm_phase<EpiRes, pg8::StaticOrder, true, true>(lds, g, S, E, tid, ((c >> 3) & 3) * STG_K2816);
            } else {
                pg8::PanelOrder S; S.init(M, G, c);
                EpiResNorm E{xout, xout, hbuf, hbuf, modl, 5 * D, a->in[6] + (l + 1) * D, modall + (size_t)(l + 1) * 33 * NMOD, 0, U, (float*)(ws + WS_SLOTS), (unsigned*)(ws + WS_CTL + CTL_PANEL) + (l * 2 + 1) * 512, lds + LDS_XCH};
                pg8::gemm_phase<EpiResNorm, pg8::PanelOrder, true, true>(lds, g, S, E, tid);
            }
            SEAM(pb + 7);
        }
    }
}
#undef IN
#undef SEAM

extern "C" void kernel_launch(void* const* d_in, const int* in_sizes, int n_in, void* d_out, int out_size, void* d_ws, size_t ws_size, hipStream_t stream) {
    static int grid = 0;
    if (grid == 0) {
        if (n_in != 23 || out_size != TL * D || ws_size < WS_END2) { fprintf(stderr, "kernel_launch: unexpected shapes (n_in %d out %d ws %zu need %zu)\n", n_in, out_size, ws_size, (size_t)WS_END2); grid = -1; return; }
        int dev = 0, cus = 0, per_cu = 0;
        hipGetDevice(&dev); hipDeviceGetAttribute(&cus, hipDeviceAttributeMultiprocessorCount, dev);
        if (hipFuncSetAttribute((const void*)mega_fwd, hipFuncAttributeMaxDynamicSharedMemorySize, LDS_BYTES) != hipSuccess) { fprintf(stderr, "kernel_launch: hipFuncSetAttribute failed\n"); grid = -1; return; }
        if (hipOccupancyMaxActiveBlocksPerMultiprocessor(&per_cu, (const void*)mega_fwd, 512, LDS_BYTES) != hipSuccess || per_cu < 1) { fprintf(stderr, "kernel_launch: occupancy query gave %d\n", per_cu); per_cu = 1; }
        (void)hipGetLastError();
        grid = cus;
        fprintf(stderr, "kernel_launch: cus %d per_cu %d grid %d ws %zu\n", cus, per_cu, grid, ws_size);
    }
    if (grid < 0) return;
    hipMemsetAsync((char*)d_ws + WS_CTL, 0, CTL_BYTES, stream);
    Args a{};
    for (int i = 0; i < 23; ++i) a.in[i] = (const float*)d_in[i];
    a.out = (float*)d_out; a.ws = (unsigned char*)d_ws;
    for (int i = 0; i < 16; ++i) a.freq[i] = (float)pow(10000.0, -(double)i / 16.0);
#if MK_PER_PHASE
    for (int ph = 0; ph < NPH; ++ph) { a.ph_lo = ph; a.ph_hi = ph + 1; hipLaunchKernelGGL(mega_fwd, dim3(grid), dim3(512), LDS_BYTES, stream, a); }
#else
    a.ph_lo = 0; a.ph_hi = NPH;
    void* args[] = {&a};
    hipError_t e = hipLaunchCooperativeKernel((const void*)mega_fwd, dim3(grid), dim3(512), args, LDS_BYTES, stream);
    if (e != hipSuccess) fprintf(stderr, "kernel_launch: cooperative launch failed: %s (grid %d)\n", hipGetErrorString(e), grid);
#endif
}
```

```cpp
#include <hip/hip_runtime.h>
#include <hip/hip_cooperative_groups.h>
#include <cstdio>
#include <cstdint>
#include <cmath>
namespace cg = cooperative_groups;

#ifndef REP_MASK
#define REP_MASK 0
#endif
#ifndef EPI_DOUBLE
#define EPI_DOUBLE 0
#endif
#ifndef PREP_DOUBLE
#define PREP_DOUBLE 0
#endif
#ifndef MIX_DUP
#define MIX_DUP 0
#endif
#ifndef GEMM_DOUBLE
#define GEMM_DOUBLE 0
#endif
#ifndef STG_K1024
#define STG_K1024 0
#define STG_K2816 0
#endif
#ifndef MK_PER_PHASE
#define MK_PER_PHASE 0
#endif

#define LAS __attribute__((address_space(3)))
typedef unsigned short bf16_t;
typedef short bf16x8 __attribute__((ext_vector_type(8)));
typedef float f32x4 __attribute__((ext_vector_type(4)));
typedef float f32x2 __attribute__((ext_vector_type(2)));
typedef float f32x16 __attribute__((ext_vector_type(16)));
typedef unsigned u32x4 __attribute__((ext_vector_type(4)));
typedef unsigned u32x2 __attribute__((ext_vector_type(2)));

constexpr int D = 1024, NB = 32, SEQ = 2048, DEPTH = 4, LCTX = 256, GW = 64;
constexpr int TL = NB * SEQ, TC = NB * LCTX, T = TL + TC;
constexpr int NIN = 5120, FF = 2816, NMOD = 6144;
constexpr float EPS = 1e-6f;
constexpr float LOG2E = 1.4426950408889634f;
constexpr float QSCALE = 0.125f * LOG2E;
constexpr int NPH = 2 + 8 * DEPTH;

constexpr size_t WS_CTL = 0, CTL_BYTES = 65536;
constexpr size_t WS_ROPE = WS_CTL + CTL_BYTES;
constexpr size_t WS_MOD = WS_ROPE + 8192;
constexpr size_t WS_SC = WS_MOD + (size_t)DEPTH * 33 * NMOD * 4;
constexpr size_t WS_H = WS_SC + 256 * 1024 * 2;
constexpr size_t WS_WIN = WS_H + (size_t)TC * D * 4;
constexpr size_t WS_WBR = WS_WIN + (size_t)DEPTH * NIN * D * 2;
constexpr size_t WS_WOUT = WS_WBR + (size_t)DEPTH * D * D * 2;
constexpr size_t WS_W13 = WS_WOUT + (size_t)DEPTH * D * D * 2;
constexpr size_t WS_W2 = WS_W13 + (size_t)DEPTH * 2 * FF * D * 2;
constexpr size_t WS_U = WS_W2 + (size_t)DEPTH * D * FF * 2;
constexpr size_t WS_BIG = WS_U + (size_t)T * D * 2;
constexpr size_t WS_END = WS_BIG + (size_t)T * NIN * 2;
constexpr size_t WS_SLOTS = WS_END;
constexpr size_t WS_END2 = WS_SLOTS + (size_t)T * 4 * 4;
static_assert(WS_END2 <= (size_t)1073741824, "workspace map exceeds 1 GiB");
constexpr size_t CTL_PANEL = 32768;
constexpr size_t B_QA = 0, B_KA = B_QA + (size_t)T * 384, B_VAT = B_KA + (size_t)T * 384, B_QB = B_VAT + (size_t)T * 384, B_KB = B_QB + (size_t)T * 384,
                 B_VBT = B_KB + (size_t)T * 128, B_PC = B_VBT + (size_t)T * 128, B_G = B_PC + (size_t)T * 256;
static_assert(B_G == (size_t)T * 2048, "BIG layout");

constexpr int LDS_BYTES = 131072 + 1024 + 6144;
constexpr int LDS_XCH = 131072 + 1024;
constexpr int LDS_MISC = 131072;

__device__ __forceinline__ unsigned f2bf(float f) { unsigned u = __builtin_bit_cast(unsigned, f); return (u + 0x7fffu + ((u >> 16) & 1u)) >> 16; }
typedef __bf16 hwbf2 __attribute__((ext_vector_type(2)));
__device__ __forceinline__ unsigned pk2(float lo, float hi) { const f32x2 v = {lo, hi}; const hwbf2 b = __builtin_convertvector(v, hwbf2); return __builtin_bit_cast(unsigned, b); }
__device__ __forceinline__ float bf2f(unsigned short h) { return __builtin_bit_cast(float, (unsigned)h << 16); }
__device__ __forceinline__ float bflo(unsigned w) { return __builtin_bit_cast(float, w << 16); }
__device__ __forceinline__ float bfhi(unsigned w) { return __builtin_bit_cast(float, w & 0xffff0000u); }
__device__ __forceinline__ float wave_sum(float v) {
#pragma unroll
    for (int o = 1; o < 64; o <<= 1) v += __shfl_xor(v, o);
    return v;
}
__device__ __forceinline__ float fast_exp2(float x) { return __builtin_amdgcn_exp2f(x); }
__device__ __forceinline__ float fast_rcp(float x) { return __builtin_amdgcn_rcpf(x); }
__device__ __forceinline__ float sigmoidf_(float x) { return fast_rcp(1.0f + fast_exp2(x * -LOG2E)); }

namespace pg8 {
constexpr int BM = 256, BK = 64, HALF = 128, HTB = HALF * BK * 2, NXCD = 8, WGM = 8;
__host__ __device__ __forceinline__ int lds_byte(int r, int c) { const int st = (r >> 4) * 2 + (c >> 5), rr = r & 15, cc = c & 31, ob = rr * 64 + cc * 2; return st * 1024 + (ob ^ (((ob >> 9) & 1) << 5)); }
__host__ __device__ __forceinline__ void stage_rc(int b, int& R, int& C) { const int st = b / 1024, sb = b % 1024, swz = sb ^ (((sb >> 9) & 1) << 5); R = (st >> 1) * 16 + swz / 64; C = (st & 1) * 32 + (swz % 64) / 2; }

struct Unit { int pm, pn, second; };
struct Gemm { const bf16_t* A; const bf16_t* Bt; int M, N, K; };

struct StaticOrder {
    int nM, nN, nwg, G, c, dbl;
    __device__ void init(int M, int N, int G_, int c_) { nM = M / BM; nN = N / BM; nwg = nM * nN; G = G_; c = c_; dbl = GEMM_DOUBLE; }
    __device__ bool next(int i, Unit& u) const {
        const long L = (long)(dbl ? (i >> 1) : i) * G + c; if (L >= nwg) return false; u.second = dbl ? (i & 1) : 1;
        int wgid = (int)L; { const int q = nwg / NXCD, r = nwg % NXCD, xcd = wgid % NXCD, off = wgid / NXCD; wgid = (xcd < r ? xcd * (q + 1) : r * (q + 1) + (xcd - r) * q) + off; }
        const int nig = WGM * nN, gid = wgid / nig, fm = gid * WGM, gsz = (nM - fm) < WGM ? (nM - fm) : WGM;
        u.pm = fm + ((wgid % nig) % gsz); u.pn = (wgid % nig) / gsz; return true;
    }
};

struct PanelOrder {
    int nM, G, c, dbl;
    __device__ void init(int M, int G_, int c_) { nM = M / BM; G = G_; c = c_; dbl = 0; }
    __device__ bool next(int i, Unit& u) const {
        if (G < 256 || c >= 256) { if (G >= 256) return false; const long L = (long)i * (G & ~3) + c; if (c >= (G & ~3) || L >= (long)nM * 4) return false; u.pm = (int)(L >> 2); u.pn = (int)(L & 3); u.second = 1; return true; }
        const int pm = i * 64 + (c & 7) * 8 + (c >> 5); if (pm >= nM) return false;
        u.pm = pm; u.pn = (c >> 3) & 3; u.second = 1; return true;
    }
};

template <class Epi, class Sched, bool ALIGN_EPI = false, bool SP2 = false>
__device__ __forceinline__ void gemm_phase(LAS unsigned char* lds, const Gemm g, const Sched& S, const Epi& E, const int tid, const int stagger_ticks = 0) {
    const int wid = __builtin_amdgcn_readfirstlane(tid >> 6), lane = tid & 63, wr = wid >> 2, wc = wid & 3, fr = lane & 15, fq = lane >> 4;
    const int K = g.K, nt = K / BK;
    unsigned voffA[2], voffB[2];
#pragma unroll
    for (int i = 0; i < 2; ++i) { int R, C; stage_rc(tid * 16 + i * 8192, R, C); voffA[i] = (unsigned)(R * K + C) * 2u; voffB[i] = (unsigned)(R * K + C) * 2u; }
    const size_t kstep = (size_t)(BK * 2);
    const size_t hstep = (size_t)HALF * K * 2;
    const size_t tstep = 2 * hstep;
    const unsigned ldsw = (unsigned)wid * 1024u;
    const int aoff = lds_byte(wr * 64 + fr, fq * 8), boff = lds_byte(wc * 32 + fr, fq * 8);
#define PG8_SA(b, h) (((b) * 2 + (h)) * HTB)
#define PG8_SB(b, h) ((4 + (b) * 2 + (h)) * HTB)
#define PG8_STAGE(bufoff, gbase, voff) do { _Pragma("unroll") for (int _i = 0; _i < 2; ++_i) \
        __builtin_amdgcn_global_load_lds((const unsigned*)((const char*)(gbase) + (voff)[_i]), (LAS unsigned*)(lds + (bufoff) + ldsw + _i * 8192), 16, 0, 0); } while (0)
#define PG8_LDA(dst, b, h) do { _Pragma("unroll") for (int m = 0; m < 4; ++m) _Pragma("unroll") for (int k = 0; k < 2; ++k) dst[m][k] = *(const LAS bf16x8*)(lds + PG8_SA(b, h) + aoff + m * 2048 + k * 1024); } while (0)
#define PG8_LDB(dst, b, h) do { _Pragma("unroll") for (int n = 0; n < 2; ++n) _Pragma("unroll") for (int k = 0; k < 2; ++k) dst[n][k] = *(const LAS bf16x8*)(lds + PG8_SB(b, h) + boff + n * 2048 + k * 1024); } while (0)
#define PG8_MMA(ai, bj, At, Bt) do { __builtin_amdgcn_s_setprio(1); _Pragma("unroll") for (int m = 0; m < 4; ++m) _Pragma("unroll") for (int n = 0; n < 2; ++n) _Pragma("unroll") for (int k = 0; k < 2; ++k) \
        acc[ai][bj][m][n] = __builtin_amdgcn_mfma_f32_16x16x32_bf16(Bt[n][k], At[m][k], acc[ai][bj][m][n], 0, 0, 0); __builtin_amdgcn_s_setprio(0); } while (0)
#define PG8_WAIT_V(n) asm volatile("s_waitcnt vmcnt(" #n ")" ::: "memory")
#define PG8_WAIT_L(n) asm volatile("s_waitcnt lgkmcnt(" #n ")" ::: "memory")
#define PG8_BAR __builtin_amdgcn_s_barrier()
#define PG8_SCHED __builtin_amdgcn_sched_barrier(0)
    Unit cur, nxt; int ui = 0;
    if (!S.next(0, cur)) return;
    if (stagger_ticks > 0) {
        const unsigned long long t0 = __builtin_amdgcn_s_memrealtime();
        while ((long long)(__builtin_amdgcn_s_memrealtime() - t0) < (long long)stagger_ticks) __builtin_amdgcn_s_sleep(16);
    }
    f32x4 acc[2][2][4][2];
#pragma unroll
    for (int a = 0; a < 2; ++a)
#pragma unroll
        for (int b = 0; b < 2; ++b)
#pragma unroll
            for (int m = 0; m < 4; ++m)
#pragma unroll
                for (int n = 0; n < 2; ++n) acc[a][b][m][n] = (f32x4){0.f, 0.f, 0.f, 0.f};
    bf16x8 At[4][2], B0[2][2], B1[2][2];
    const char* cA = (const char*)g.A + (size_t)cur.pm * tstep; const char* cB = (const char*)g.Bt + (size_t)cur.pn * tstep;
    if constexpr (SP2) {
        PG8_STAGE(PG8_SB(0, 0), cB, voffB); PG8_STAGE(PG8_SB(0, 1), cB + hstep, voffB); PG8_STAGE(PG8_SA(0, 0), cA, voffA); PG8_STAGE(PG8_SA(0, 1), cA + hstep, voffA);
        if (wr == 1) PG8_BAR;
        PG8_WAIT_V(2); PG8_BAR;
        PG8_STAGE(PG8_SB(1, 0), cB + kstep, voffB); PG8_STAGE(PG8_SA(1, 0), cA + kstep, voffA); PG8_STAGE(PG8_SB(1, 1), cB + hstep + kstep, voffB);
        PG8_WAIT_V(6); PG8_BAR;
    } else {
        PG8_STAGE(PG8_SB(0, 0), cB, voffB); PG8_STAGE(PG8_SA(0, 0), cA, voffA); PG8_STAGE(PG8_SB(0, 1), cB + hstep, voffB); PG8_STAGE(PG8_SA(0, 1), cA + hstep, voffA);
        if (wr == 1) PG8_BAR;
        PG8_WAIT_V(4); PG8_BAR;
        PG8_STAGE(PG8_SB(1, 0), cB + kstep, voffB); PG8_STAGE(PG8_SA(1, 0), cA + kstep, voffA); PG8_STAGE(PG8_SB(1, 1), cB + hstep + kstep, voffB);
        PG8_WAIT_V(6); PG8_BAR;
    }
    for (;;) {
        const bool has_next = S.next(ui + 1, nxt);
        const char* nA = has_next ? (const char*)g.A + (size_t)nxt.pm * tstep : cA; const char* nB = has_next ? (const char*)g.Bt + (size_t)nxt.pn * tstep : cB;
        for (int t = 0; t < nt; t += 2) {
            if constexpr (Epi::MID) { if (t == 6 || t == 12) E.mid(acc, cur, t == 6 ? 0 : 1, wr, wc, fr, fq); }
            const bool last = (t == nt - 2);
            const char* a1 = cA + (size_t)(t + 1) * kstep;
            const char* a2 = last ? nA : cA + (size_t)(t + 2) * kstep; const char* b2 = last ? nB : cB + (size_t)(t + 2) * kstep;
            const char* a3 = a2 + kstep; const char* b3 = b2 + kstep;
            if constexpr (SP2) {
            PG8_LDB(B0, 0, 0); PG8_LDB(B1, 0, 1); PG8_SCHED; PG8_LDA(At, 0, 0); PG8_STAGE(PG8_SA(1, 1), a1 + hstep, voffA);
            PG8_WAIT_V(8); PG8_WAIT_L(0); PG8_BAR; PG8_MMA(0, 0, At, B0); PG8_MMA(0, 1, At, B1); PG8_BAR; PG8_SCHED;
            PG8_LDA(At, 0, 1); PG8_STAGE(PG8_SB(0, 0), b2, voffB); PG8_STAGE(PG8_SB(0, 1), b2 + hstep, voffB); PG8_STAGE(PG8_SA(0, 0), a2, voffA);
            PG8_WAIT_V(8); PG8_WAIT_L(0); PG8_BAR; PG8_MMA(1, 0, At, B0); PG8_MMA(1, 1, At, B1); PG8_BAR; PG8_SCHED;
            PG8_LDB(B0, 1, 0); PG8_LDB(B1, 1, 1); PG8_SCHED; PG8_LDA(At, 1, 0); PG8_STAGE(PG8_SA(0, 1), a2 + hstep, voffA);
            PG8_WAIT_V(8); PG8_WAIT_L(0); PG8_BAR; PG8_MMA(0, 0, At, B0); PG8_MMA(0, 1, At, B1); PG8_BAR; PG8_SCHED;
            PG8_LDA(At, 1, 1); PG8_STAGE(PG8_SB(1, 0), b3, voffB); PG8_STAGE(PG8_SB(1, 1), b3 + hstep, voffB); PG8_STAGE(PG8_SA(1, 0), a3, voffA);
            PG8_WAIT_V(8); PG8_WAIT_L(0); PG8_BAR; PG8_MMA(1, 0, At, B0); PG8_MMA(1, 1, At, B1); PG8_BAR; PG8_SCHED;
            } else {
            PG8_LDB(B0, 0, 0); PG8_SCHED; PG8_LDA(At, 0, 0); PG8_STAGE(PG8_SA(1, 1), a1 + hstep, voffA);
            PG8_WAIT_L(8); PG8_BAR; PG8_WAIT_L(0); PG8_MMA(0, 0, At, B0); PG8_BAR; PG8_SCHED;
            PG8_LDB(B1, 0, 1); PG8_STAGE(PG8_SB(0, 0), b2, voffB);
            PG8_BAR; PG8_WAIT_L(0); PG8_MMA(0, 1, At, B1); PG8_BAR;
            PG8_LDA(At, 0, 1); PG8_STAGE(PG8_SA(0, 0), a2, voffA);
            PG8_BAR; PG8_WAIT_L(0); PG8_MMA(1, 0, At, B0); PG8_BAR; PG8_SCHED;
            PG8_STAGE(PG8_SB(0, 1), b2 + hstep, voffB);
            PG8_WAIT_V(6); PG8_BAR; PG8_MMA(1, 1, At, B1); PG8_BAR;
            PG8_LDB(B0, 1, 0); PG8_SCHED; PG8_LDA(At, 1, 0); PG8_STAGE(PG8_SA(0, 1), a2 + hstep, voffA);
            PG8_WAIT_L(8); PG8_BAR; PG8_WAIT_L(0); PG8_MMA(0, 0, At, B0); PG8_BAR; PG8_SCHED;
            PG8_LDB(B1, 1, 1); PG8_STAGE(PG8_SB(1, 0), b3, voffB);
            PG8_BAR; PG8_WAIT_L(0); PG8_MMA(0, 1, At, B1); PG8_BAR;
            PG8_LDA(At, 1, 1); PG8_STAGE(PG8_SA(1, 0), a3, voffA);
            PG8_BAR; PG8_WAIT_L(0); PG8_MMA(1, 0, At, B0); PG8_BAR; PG8_SCHED;
            PG8_STAGE(PG8_SB(1, 1), b3 + hstep, voffB);
            PG8_WAIT_V(6); PG8_BAR; PG8_MMA(1, 1, At, B1); PG8_BAR;
            }
        }
        if constexpr (ALIGN_EPI) { if (wr == 0) PG8_BAR; }
        if (cur.second) {
        if (S.dbl) {
#pragma unroll
        for (int a = 0; a < 2; ++a)
#pragma unroll
            for (int b = 0; b < 2; ++b)
#pragma unroll
                for (int m = 0; m < 4; ++m)
#pragma unroll
                    for (int n = 0; n < 2; ++n) acc[a][b][m][n] = acc[a][b][m][n] * 0.5f;
        }
        E(acc, cur, wr, wc, fr, fq);
        if constexpr (Epi::IDEM) { if (EPI_DOUBLE) { asm volatile("" ::: "memory"); E(acc, cur, wr, wc, fr, fq); } }
        }
        if (!has_next) break;
        if (cur.second) {
#pragma unroll
        for (int a = 0; a < 2; ++a)
#pragma unroll
            for (int b = 0; b < 2; ++b)
#pragma unroll
                for (int m = 0; m < 4; ++m)
#pragma unroll
                    for (int n = 0; n < 2; ++n) acc[a][b][m][n] = (f32x4){0.f, 0.f, 0.f, 0.f};
        }
        cur = nxt; cA = nA; cB = nB; ++ui;
        if constexpr (ALIGN_EPI) { if (wr == 1) PG8_BAR; }
    }
    PG8_WAIT_V(0);
    if constexpr (!ALIGN_EPI) { if (wr == 0) PG8_BAR; }
    PG8_BAR;
#undef PG8_SA
#undef PG8_SB
#undef PG8_STAGE
#undef PG8_LDA
#undef PG8_LDB
#undef PG8_MMA
#undef PG8_WAIT_V
#undef PG8_WAIT_L
#undef PG8_BAR
#undef PG8_SCHED
}
}
using pg8::Unit;

struct EpiIn {
    static constexpr bool IDEM = true;
    static constexpr bool MID = false;
    bf16_t* big; const float* qn_a; const float* kn_a; const float* qn_b; const float* kn_b; const f32x2* rope;
    __device__ __forceinline__ void operator()(const f32x4 (&acc)[2][2][4][2], const Unit& u, int wr, int wc, int fr, int fq) const {
        const int hg = u.pn * 4 + wc;
        int kind; bf16_t* dst; int pitch, hcol; const float* gain = nullptr;
        if (hg < 6)       { kind = 1 | 256; dst = big + B_QA; pitch = 384; hcol = hg * 64; gain = qn_a; }
        else if (hg < 12) { kind = 1;       dst = big + B_KA; pitch = 384; hcol = (hg - 6) * 64; gain = kn_a; }
        else if (hg < 18) { kind = 3;       dst = big + B_VAT; pitch = T; hcol = (hg - 12) * 64; }
        else if (hg < 24) { kind = 2 | 256; dst = big + B_QB; pitch = 384; hcol = (hg - 18) * 64; gain = qn_b; }
        else if (hg < 26) { kind = 2;       dst = big + B_KB; pitch = 128; hcol = (hg - 24) * 64; gain = kn_b; }
        else if (hg < 28) { kind = 3;       dst = big + B_VBT; pitch = T; hcol = (hg - 26) * 64; }
        else if (hg < 32) { kind = 0;       dst = big + B_PC; pitch = 256; hcol = (hg - 28) * 64; }
        else              { kind = 4;       dst = big + B_G; pitch = 3072; hcol = (hg - 32) * 64; }
        const int k = kind & 255; const float qs = (kind & 256) ? QSCALE : 1.0f;
        f32x4 gv[2][2];
        if (k == 1 || k == 2) {
#pragma unroll
            for (int bj = 0; bj < 2; ++bj)
#pragma unroll
                for (int n = 0; n < 2; ++n) gv[bj][n] = *(const f32x4*)(gain + 32 * bj + 16 * n + 4 * fq) * qs;
        }
        f32x4 ropeR[2][2], ropeC[4][2];
        const bool do_rope = (k == 2 && u.pm * 256 < TL);
        if (do_rope) {
#pragma unroll
            for (int m = 0; m < 4; ++m) { const int pos = m * 16 + fr; const f32x4* rp = (const f32x4*)(rope + pos * 16 + 4 * fq); ropeC[m][0] = rp[0]; ropeC[m][1] = rp[1]; }
            __builtin_amdgcn_sched_barrier(0);
        }
#pragma unroll
        for (int ai = 0; ai < 2; ++ai) {
            if (do_rope) { const int pos = ((u.pm * 256 + ai * 128 + wr * 64) & (SEQ - 1)) >> 6; const f32x4* rp = (const f32x4*)(rope + pos * 16 + 4 * fq); ropeR[ai][0] = rp[0]; ropeR[ai][1] = rp[1]; }
#pragma unroll
            for (int m = 0; m < 4; ++m) {
                const int row = u.pm * 256 + ai * 128 + wr * 64 + m * 16 + fr;
                f32x4 v[2][2];
#pragma unroll
                for (int bj = 0; bj < 2; ++bj)
#pragma unroll
                    for (int n = 0; n < 2; ++n) v[bj][n] = acc[ai][bj][m][n];
                if (k == 1 || k == 2) {
                    float ss = 0.f;
#pragma unroll
                    for (int bj = 0; bj < 2; ++bj)
#pragma unroll
                        for (int n = 0; n < 2; ++n) { const f32x4 x = v[bj][n]; ss += (x[0] * x[0] + x[1] * x[1]) + (x[2] * x[2] + x[3] * x[3]); }
                    ss += __shfl_xor(ss, 16); ss += __shfl_xor(ss, 32);
                    const float rinv = __builtin_amdgcn_rsqf(ss * (1.0f / 64.0f) + EPS);
#pragma unroll
                    for (int bj = 0; bj < 2; ++bj)
#pragma unroll
                        for (int n = 0; n < 2; ++n) v[bj][n] = v[bj][n] * rinv * gv[bj][n];
                    if (k == 2 && row < TL) {
#pragma unroll
                        for (int bj = 0; bj < 2; ++bj) {
                            const f32x4 q0 = bj ? ropeC[m][0] : ropeR[ai][0], q1 = bj ? ropeC[m][1] : ropeR[ai][1];
                            const float cs[4] = {q0[0], q0[2], q1[0], q1[2]}, sn[4] = {q0[1], q0[3], q1[1], q1[3]};
#pragma unroll
                            for (int j = 0; j < 4; ++j) { const float x1 = v[bj][0][j], x2 = v[bj][1][j];
                                v[bj][0][j] = x1 * cs[j] - x2 * sn[j]; v[bj][1][j] = x2 * cs[j] + x1 * sn[j]; }
                        }
                    }
                } else if (k == 4) {
#pragma unroll
                    for (int bj = 0; bj < 2; ++bj)
#pragma unroll
                        for (int n = 0; n < 2; ++n)
#pragma unroll
                            for (int j = 0; j < 4; ++j) v[bj][n][j] = sigmoidf_(v[bj][n][j]);
                }
                if (k == 3) {
#pragma unroll
                    for (int bj = 0; bj < 2; ++bj)
#pragma unroll
                        for (int n = 0; n < 2; ++n)
#pragma unroll
                            for (int j = 0; j < 4; ++j) dst[(size_t)(hcol + 32 * bj + 16 * n + 4 * fq + j) * T + row] = (bf16_t)f2bf(v[bj][n][j]);
                } else {
                    bf16_t* rp = dst + (size_t)row * pitch + hcol + 4 * fq;
#pragma unroll
                    for (int bj = 0; bj < 2; ++bj)
#pragma unroll
                        for (int n = 0; n < 2; ++n) { u32x2 w; w.x = pk2(v[bj][n][0], v[bj][n][1]); w.y = pk2(v[bj][n][2], v[bj][n][3]); *(u32x2*)(rp + 32 * bj + 16 * n) = w; }
                }
            }
        }
    }
};

struct EpiMerge {
    static constexpr bool IDEM = false;
    static constexpr bool MID = true;
    const bf16_t* G; bf16_t* Mo;
    __device__ __forceinline__ void mid(f32x4 (&acc)[2][2][4][2], const Unit& u, int which, int wr, int wc, int fr, int fq) const {
        const bf16_t* g0 = G + (size_t)(u.pm * 256 + wr * 64 + fr) * 3072 + which * 1024 + u.pn * 256 + 32 * wc + 8 * fq;
#pragma unroll
        for (int ai = 0; ai < 2; ++ai) {
            u32x4 ga[4][2], gb[4][2];
#pragma unroll
            for (int m = 0; m < 4; ++m)
#pragma unroll
                for (int bj = 0; bj < 2; ++bj) { const bf16_t* gp = g0 + (size_t)(ai * 128 + m * 16) * 3072 + 128 * bj; ga[m][bj] = *(const u32x4*)gp; gb[m][bj] = *(const u32x4*)(gp + 1024); }
            __builtin_amdgcn_sched_barrier(0);
#pragma unroll
            for (int m = 0; m < 4; ++m)
#pragma unroll
                for (int bj = 0; bj < 2; ++bj) {
                    const u32x4 a = ga[m][bj], b = gb[m][bj];
#pragma unroll
                    for (int n = 0; n < 2; ++n) {
                        const unsigned a0 = n ? a.z : a.x, a1 = n ? a.w : a.y, b0 = n ? b.z : b.x, b1 = n ? b.w : b.y;
                        acc[ai][bj][m][n][0] *= bflo(a0) * fast_rcp(bflo(b0)); acc[ai][bj][m][n][1] *= bfhi(a0) * fast_rcp(bfhi(b0));
                        acc[ai][bj][m][n][2] *= bflo(a1) * fast_rcp(bflo(b1)); acc[ai][bj][m][n][3] *= bfhi(a1) * fast_rcp(bfhi(b1));
                    }
                }
            __builtin_amdgcn_sched_barrier(0);
        }
    }
    __device__ __forceinline__ void operator()(const f32x4 (&acc)[2][2][4][2], const Unit& u, int wr, int wc, int fr, int fq) const {
        const size_t r0 = (size_t)(u.pm * 256 + wr * 64 + fr); const int c0 = u.pn * 256 + 32 * wc + 8 * fq;
        u32x4 gc[2][4][2];
#pragma unroll
        for (int ai = 0; ai < 2; ++ai)
#pragma unroll
            for (int m = 0; m < 4; ++m)
#pragma unroll
                for (int bj = 0; bj < 2; ++bj) gc[ai][m][bj] = *(const u32x4*)(G + (r0 + ai * 128 + m * 16) * 3072 + 2048 + c0 + 128 * bj);
        __builtin_amdgcn_sched_barrier(0);
#pragma unroll
        for (int ai = 0; ai < 2; ++ai)
#pragma unroll
            for (int m = 0; m < 4; ++m)
#pragma unroll
                for (int bj = 0; bj < 2; ++bj) {
                    const u32x4 c = gc[ai][m][bj];
                    const f32x4 x0 = acc[ai][bj][m][0], x1 = acc[ai][bj][m][1];
                    u32x4 w;
                    w.x = pk2(x0[0] * bflo(c.x), x0[1] * bfhi(c.x)); w.y = pk2(x0[2] * bflo(c.y), x0[3] * bfhi(c.y));
                    w.z = pk2(x1[0] * bflo(c.z), x1[1] * bfhi(c.z)); w.w = pk2(x1[2] * bflo(c.w), x1[3] * bfhi(c.w));
                    *(u32x4*)(Mo + (r0 + ai * 128 + m * 16) * D + c0 + 128 * bj) = w;
                }
    }
};

struct EpiRes {
    static constexpr bool IDEM = false;
    static constexpr bool MID = false;
    const float* xs; float* xd; const float* hs; float* hd; const float* modl; int goff;
    __device__ __forceinline__ void operator()(const f32x4 (&acc)[2][2][4][2], const Unit& u, int wr, int wc, int fr, int fq) const {
        const int row0 = u.pm * 256; const bool lat = row0 < TL;
        const int b = lat ? (row0 >> 11) : 32;
        const float* src = (lat ? xs + (size_t)row0 * D : hs + (size_t)(row0 - TL) * D) + (size_t)(wr * 64 + fr) * D + u.pn * 256 + 32 * wc + 8 * fq;
        float* dst = (lat ? xd + (size_t)row0 * D : hd + (size_t)(row0 - TL) * D) + (size_t)(wr * 64 + fr) * D + u.pn * 256 + 32 * wc + 8 * fq;
        const float* gp = modl + (size_t)b * NMOD + goff + u.pn * 256 + 32 * wc + 8 * fq;
        f32x4 g[2][2];
#pragma unroll
        for (int bj = 0; bj < 2; ++bj) { g[bj][0] = *(const f32x4*)(gp + 128 * bj); g[bj][1] = *(const f32x4*)(gp + 128 * bj + 4); }
        f32x4 s[2][4][2];
#define ER_LOAD(k) do { const int bj_ = (k) >> 1, ai_ = (k) & 1; _Pragma("unroll") for (int m = 0; m < 4; ++m) { const size_t o = (size_t)(ai_ * 128 + m * 16) * D + 128 * bj_; \
            s[(k) & 1][m][0] = *(const f32x4*)(src + o); s[(k) & 1][m][1] = *(const f32x4*)(src + o + 4); } } while (0)
#define ER_STORE(k) do { const int bj_ = (k) >> 1, ai_ = (k) & 1; _Pragma("unroll") for (int m = 0; m < 4; ++m) { const size_t o = (size_t)(ai_ * 128 + m * 16) * D + 128 * bj_; \
            *(f32x4*)(dst + o) = s[(k) & 1][m][0] + g[bj_][0] * acc[ai_][bj_][m][0]; *(f32x4*)(dst + o + 4) = s[(k) & 1][m][1] + g[bj_][1] * acc[ai_][bj_][m][1]; } } while (0)
        ER_LOAD(0); __builtin_amdgcn_sched_barrier(0);
        ER_LOAD(1); __builtin_amdgcn_sched_barrier(0);
        ER_STORE(0); __builtin_amdgcn_sched_barrier(0);
        ER_LOAD(2); __builtin_amdgcn_sched_barrier(0);
        ER_STORE(1); __builtin_amdgcn_sched_barrier(0);
        ER_LOAD(3); __builtin_amdgcn_sched_barrier(0);
        ER_STORE(2); __builtin_amdgcn_sched_barrier(0);
        ER_STORE(3);
#undef ER_LOAD
#undef ER_STORE
    }
};

struct EpiResNorm {
    static constexpr bool IDEM = false;
    static constexpr bool MID = false;
    const float* xs; float* xd; const float* hs; float* hd; const float* modl; int goff;
    const float* ngain; const float* nmod; int nshift; bf16_t* U; float* slots; unsigned* cnt; LAS unsigned char* xl;
    __device__ __forceinline__ void operator()(f32x4 (&acc)[2][2][4][2], const Unit& u, int wr, int wc, int fr, int fq) const {
        const int row0 = u.pm * 256; const bool lat = row0 < TL;
        const int b = lat ? (row0 >> 11) : 32;
        const float* src = (lat ? xs + (size_t)row0 * D : hs + (size_t)(row0 - TL) * D) + (size_t)(wr * 64 + fr) * D + u.pn * 256 + 32 * wc + 8 * fq;
        float* dst = (lat ? xd + (size_t)row0 * D : hd + (size_t)(row0 - TL) * D) + (size_t)(wr * 64 + fr) * D + u.pn * 256 + 32 * wc + 8 * fq;
        const float* gp = modl + (size_t)b * NMOD + goff + u.pn * 256 + 32 * wc + 8 * fq;
        {
        f32x4 g[2][2];
#pragma unroll
        for (int bj = 0; bj < 2; ++bj) { g[bj][0] = *(const f32x4*)(gp + 128 * bj); g[bj][1] = *(const f32x4*)(gp + 128 * bj + 4); }
        f32x4 s[4][2];
#define ER_LOAD(k) do { const int bj_ = (k) >> 1, ai_ = (k) & 1; _Pragma("unroll") for (int m = 0; m < 4; ++m) { const size_t o = (size_t)(ai_ * 128 + m * 16) * D + 128 * bj_; \
            s[m][0] = *(const f32x4*)(src + o); s[m][1] = *(const f32x4*)(src + o + 4); } } while (0)
#define ER_STORE(k) do { const int bj_ = (k) >> 1, ai_ = (k) & 1; _Pragma("unroll") for (int m = 0; m < 4; ++m) { const size_t o = (size_t)(ai_ * 128 + m * 16) * D + 128 * bj_; \
            acc[ai_][bj_][m][0] = s[m][0] + g[bj_][0] * acc[ai_][bj_][m][0]; acc[ai_][bj_][m][1] = s[m][1] + g[bj_][1] * acc[ai_][bj_][m][1]; \
            *(f32x4*)(dst + o) = acc[ai_][bj_][m][0]; *(f32x4*)(dst + o + 4) = acc[ai_][bj_][m][1]; } } while (0)
        ER_LOAD(0); __builtin_amdgcn_sched_barrier(0); ER_STORE(0); __builtin_amdgcn_sched_barrier(0);
        ER_LOAD(1); __builtin_amdgcn_sched_barrier(0); ER_STORE(1); __builtin_amdgcn_sched_barrier(0);
        ER_LOAD(2); __builtin_amdgcn_sched_barrier(0); ER_STORE(2); __builtin_amdgcn_sched_barrier(0);
        ER_LOAD(3); __builtin_amdgcn_sched_barrier(0); ER_STORE(3); __builtin_amdgcn_sched_barrier(0);
#undef ER_LOAD
#undef ER_STORE
        }
        LAS float* P = (LAS float*)xl; LAS float* S = P + 1024;
        const int tid = (wr * 4 + wc) * 64 + fq * 16 + fr;
#pragma unroll
        for (int ai = 0; ai < 2; ++ai)
#pragma unroll
            for (int m = 0; m < 4; ++m) {
                float ss = 0.f;
#pragma unroll
                for (int bj = 0; bj < 2; ++bj)
#pragma unroll
                    for (int n = 0; n < 2; ++n) { const f32x4 x = acc[ai][bj][m][n]; ss += (x[0] * x[0] + x[1] * x[1]) + (x[2] * x[2] + x[3] * x[3]); }
                ss += __shfl_xor(ss, 16); ss += __shfl_xor(ss, 32);
                if (fq == 0) P[(ai * 128 + wr * 64 + m * 16 + fr) * 4 + wc] = ss;
            }
        asm volatile("s_waitcnt lgkmcnt(0)" ::: "memory"); __builtin_amdgcn_s_barrier(); asm volatile("" ::: "memory");
        if (tid < 256) {
            const float tot = (P[tid * 4 + 0] + P[tid * 4 + 1]) + (P[tid * 4 + 2] + P[tid * 4 + 3]);
            __hip_atomic_store(slots + (size_t)(row0 + tid) * 4 + u.pn, tot, __ATOMIC_RELAXED, __HIP_MEMORY_SCOPE_AGENT);
        }
        asm volatile("s_waitcnt vmcnt(0)" ::: "memory");
        if (tid < 256 && (tid & 63) == 0) __hip_atomic_fetch_add(cnt + u.pm, 1u, __ATOMIC_RELAXED, __HIP_MEMORY_SCOPE_AGENT);
        if (tid < 64) {
            unsigned sp = 0;
            while (__hip_atomic_load(cnt + u.pm, __ATOMIC_RELAXED, __HIP_MEMORY_SCOPE_AGENT) < 16u) { __builtin_amdgcn_s_sleep(2); if (++sp > (1u << 22)) break; }
            __builtin_amdgcn_fence(__ATOMIC_ACQUIRE, "agent");
        }
        asm volatile("s_waitcnt vmcnt(0) lgkmcnt(0)" ::: "memory"); __builtin_amdgcn_s_barrier(); asm volatile("" ::: "memory");
        if (tid < 256) {
            const float* sl = slots + (size_t)(row0 + tid) * 4;
            const float t4 = (__hip_atomic_load(sl + 0, __ATOMIC_RELAXED, __HIP_MEMORY_SCOPE_AGENT) + __hip_atomic_load(sl + 1, __ATOMIC_RELAXED, __HIP_MEMORY_SCOPE_AGENT))
                           + (__hip_atomic_load(sl + 2, __ATOMIC_RELAXED, __HIP_MEMORY_SCOPE_AGENT) + __hip_atomic_load(sl + 3, __ATOMIC_RELAXED, __HIP_MEMORY_SCOPE_AGENT));
            S[tid] = __builtin_amdgcn_rsqf(t4 * (1.0f / D) + EPS);
        }
        asm volatile("s_waitcnt lgkmcnt(0)" ::: "memory"); __builtin_amdgcn_s_barrier(); asm volatile("" ::: "memory");
        const float* mp = nmod + (size_t)b * NMOD + nshift + u.pn * 256 + 32 * wc + 8 * fq;
        const float* ng = ngain + u.pn * 256 + 32 * wc + 8 * fq;
        bf16_t* up = U + (size_t)(row0 + wr * 64 + fr) * D + u.pn * 256 + 32 * wc + 8 * fq;
#pragma unroll
        for (int bj = 0; bj < 2; ++bj) {
            const f32x4 sh0 = *(const f32x4*)(mp + 128 * bj), sh1 = *(const f32x4*)(mp + 128 * bj + 4);
            const f32x4 gs0 = *(const f32x4*)(ng + 128 * bj) * (*(const f32x4*)(mp + D + 128 * bj) + 1.0f), gs1 = *(const f32x4*)(ng + 128 * bj + 4) * (*(const f32x4*)(mp + D + 128 * bj + 4) + 1.0f);
#pragma unroll
            for (int ai = 0; ai < 2; ++ai)
#pragma unroll
                for (int m = 0; m < 4; ++m) {
                    const float rstd = S[ai * 128 + wr * 64 + m * 16 + fr];
                    const f32x4 y0 = acc[ai][bj][m][0] * rstd * gs0 + sh0, y1 = acc[ai][bj][m][1] * rstd * gs1 + sh1;
                    u32x4 w; w.x = pk2(y0[0], y0[1]); w.y = pk2(y0[2], y0[3]); w.z = pk2(y1[0], y1[1]); w.w = pk2(y1[2], y1[3]);
                    *(u32x4*)(up + (size_t)(ai * 128 + m * 16) * D + 128 * bj) = w;
                }
        }
    }
};

struct EpiFF1 {
    static constexpr bool IDEM = true;
    static constexpr bool MID = false;
    bf16_t* H1;
    __device__ __forceinline__ void operator()(const f32x4 (&acc)[2][2][4][2], const Unit& u, int wr, int wc, int fr, int fq) const {
        const int col = u.pn * 128 + 32 * wc + 8 * fq;
#pragma unroll
        for (int ai = 0; ai < 2; ++ai)
#pragma unroll
            for (int m = 0; m < 4; ++m) {
                const int row = u.pm * 256 + ai * 128 + wr * 64 + m * 16 + fr;
                float r[8];
#pragma unroll
                for (int n = 0; n < 2; ++n)
#pragma unroll
                    for (int j = 0; j < 4; ++j) { const float a = acc[ai][0][m][n][j], b = acc[ai][1][m][n][j]; r[4 * n + j] = a * sigmoidf_(a) * b; }
                u32x4 w; w.x = pk2(r[0], r[1]); w.y = pk2(r[2], r[3]); w.z = pk2(r[4], r[5]); w.w = pk2(r[6], r[7]);
                *(u32x4*)(H1 + (size_t)row * FF + col) = w;
            }
    }
};

struct EpiMod {
    static constexpr bool IDEM = false;
    static constexpr bool MID = false;
    float* mod; const float* bmod;
    __device__ __forceinline__ void operator()(const f32x4 (&acc)[2][2][4][2], const Unit& u, int wr, int wc, int fr, int fq) const {
        if (wr != 0) return;
#pragma unroll
        for (int m = 0; m < 3; ++m) {
            const int row = m * 16 + fr; if (row >= 33) continue;
#pragma unroll
            for (int bj = 0; bj < 2; ++bj)
#pragma unroll
                for (int n = 0; n < 2; ++n) {
                    const int nn = u.pn * 256 + 128 * bj + 32 * wc + 16 * n + 4 * fq;
                    const int l = nn / NMOD, c = nn - l * NMOD;
                    const f32x4 bv = *(const f32x4*)(bmod + nn);
                    *(f32x4*)(mod + ((size_t)l * 33 + row) * NMOD + c) = acc[0][bj][m][n] + bv;
                }
        }
    }
};

struct Args { const float* in[23]; float* out; unsigned char* ws; float freq[16]; int ph_lo, ph_hi; };
typedef const __attribute__((address_space(4))) Args* KArgsPtr;

__device__ __forceinline__ int p8map(int p) { return (p & 0xe0) | (((p >> 2) & 3) << 3) | (((p >> 4) & 1) << 2) | (p & 3); }
__device__ __forceinline__ void prep_item(KArgsPtr a, unsigned char* ws, int l, int mid, int item, LAS float* scr, int lane) {
    int K, N; if (mid == 0) { K = D; N = NIN; } else if (mid == 1 || mid == 2) { K = D; N = D; } else if (mid == 3) { K = D; N = 2 * FF; } else if (mid == 4) { K = FF; N = D; } else { K = D; N = NMOD; }
    const int nblk = N / 32, kb = item / nblk, nb = item % nblk, k0 = 64 * kb, n0 = 32 * nb;
    const int r = n0 + (lane & 31), tile = r >> 8, p = r & 255;
    const float* src; int ld, col, krow = k0; bf16_t* WT;
    if (mid == 0) { src = a->in[8] + (size_t)l * D * NIN; ld = NIN; col = tile * 256 + ((p >> 5) & 3) * 64 + (p >> 7) * 32 + (p & 31); WT = (bf16_t*)(ws + WS_WIN) + (size_t)l * NIN * D; }
    else if (mid == 1) { ld = D; col = tile * 256 + p8map(p); WT = (bf16_t*)(ws + WS_WBR) + (size_t)l * D * D;
        if (k0 < 384) { src = a->in[16] + (size_t)l * 384 * D; } else if (k0 < 768) { src = a->in[17] + (size_t)l * 384 * D; krow = k0 - 384; } else { src = a->in[18] + (size_t)l * 256 * D; krow = k0 - 768; } }
    else if (mid == 2) { src = a->in[19] + (size_t)l * D * D; ld = D; col = tile * 256 + p8map(p); WT = (bf16_t*)(ws + WS_WOUT) + (size_t)l * D * D; }
    else if (mid == 3) { src = ((p >> 7) ? a->in[21] : a->in[20]) + (size_t)l * D * FF; ld = FF; col = tile * 128 + (p8map(p) & 127); WT = (bf16_t*)(ws + WS_W13) + (size_t)l * 2 * FF * D; }
    else if (mid == 4) { src = a->in[22] + (size_t)l * FF * D; ld = D; col = tile * 256 + p8map(p); WT = (bf16_t*)(ws + WS_W2) + (size_t)l * D * FF; }
    else { src = a->in[4] + (size_t)l * D * NMOD; ld = NMOD; col = r; WT = (bf16_t*)(ws + WS_BIG) + (size_t)l * NMOD * D; }
#pragma unroll 8
    for (int i = 0; i < 32; ++i) { const int kk = 2 * i + (lane >> 5); scr[kk * 33 + (lane & 31)] = src[(size_t)(krow + kk) * ld + col]; }
    asm volatile("s_waitcnt lgkmcnt(0)" ::: "memory");
    const int c = lane & 7;
#pragma unroll
    for (int j = 0; j < 4; ++j) { const int n = (lane >> 3) + 8 * j; const LAS float* s = scr + (8 * c) * 33 + n;
        u32x4 o; o.x = pk2(s[0 * 33], s[1 * 33]); o.y = pk2(s[2 * 33], s[3 * 33]); o.z = pk2(s[4 * 33], s[5 * 33]); o.w = pk2(s[6 * 33], s[7 * 33]);
        *(u32x4*)(WT + (size_t)(n0 + n) * K + k0 + 8 * c) = o; }
    asm volatile("s_waitcnt lgkmcnt(0)" ::: "memory");
}

__device__ __forceinline__ void prep_phase(KArgsPtr a, LAS unsigned char* lds, int tid, int wid, int lane, int bid, int nblk_) {
    unsigned char* ws = a->ws;
    LAS float* scr = (LAS float*)(lds + wid * 8704);
    const int gw = bid * 8 + wid, NGW = nblk_ * 8;
    constexpr int I0 = 16 * 160, I1 = 16 * 32, I2 = 16 * 32, I3 = 16 * 176, I4 = 44 * 32, I5 = 16 * 192, IL = I0 + I1 + I2 + I3 + I4 + I5;
    for (int it = gw; it < IL * DEPTH; it += NGW) {
        const int l = it / IL; int r = it - l * IL; int mid;
        if (r < I0) mid = 0; else if ((r -= I0) < I1) mid = 1; else if ((r -= I1) < I2) mid = 2; else if ((r -= I2) < I3) mid = 3; else if ((r -= I3) < I4) mid = 4; else { r -= I4; mid = 5; }
        prep_item(a, ws, l, mid, r, scr, lane);
    }
    bf16_t* SC = (bf16_t*)(ws + WS_SC);
    for (int i = bid * 512 + tid; i < 256 * 1024; i += nblk_ * 512) {
        const int row = i >> 10, k = i & 1023; float v = 0.f;
        if (row < 32) v = a->in[1][row * D + k]; else if (row == 32) v = a->in[3][k];
        SC[i] = (bf16_t)f2bf(row <= 32 ? v * sigmoidf_(v) : 0.f);
    }
    f32x2* rope = (f32x2*)(ws + WS_ROPE);
    for (int i = bid * 512 + tid; i < 64 * 16; i += nblk_ * 512) {
        const int pos = i >> 4, fi = i & 15;
        const float ang = (float)pos * a->freq[fi];
        float rev = ang * 0.15915494309189535f; rev = rev - floorf(rev);
        rope[i] = (f32x2){__builtin_amdgcn_cosf(rev), __builtin_amdgcn_sinf(rev)};
    }
}

__device__ __forceinline__ void norm_phase(const float* xl, const float* xc, const float* gain, const float* modl, int shift_off, int nrows, bf16_t* U, int wid, int lane, int bid, int nblk_) {
    const int gw = bid * 8 + wid, NGW = nblk_ * 8;
    f32x4 gv[4];
#pragma unroll
    for (int j = 0; j < 4; ++j) gv[j] = *(const f32x4*)(gain + 4 * (lane + 64 * j));
    for (int row0 = gw; row0 < nrows; row0 += 4 * NGW) {
        f32x4 v[4][4]; float ss[4];
#pragma unroll
        for (int r = 0; r < 4; ++r) {
            const int row = row0 + r * NGW; ss[r] = 0.f;
            if (row < nrows) {
                const float* src = row < TL ? xl + (size_t)row * D : xc + (size_t)(row - TL) * D;
#pragma unroll
                for (int j = 0; j < 4; ++j) v[r][j] = *(const f32x4*)(src + 4 * (lane + 64 * j));
            } else {
#pragma unroll
                for (int j = 0; j < 4; ++j) v[r][j] = (f32x4){0.f, 0.f, 0.f, 0.f};
            }
        }
#pragma unroll
        for (int r = 0; r < 4; ++r) {
            const int row = row0 + r * NGW;
            if (row >= nrows) continue;
#pragma unroll
            for (int j = 0; j < 4; ++j) ss[r] += (v[r][j][0] * v[r][j][0] + v[r][j][1] * v[r][j][1]) + (v[r][j][2] * v[r][j][2] + v[r][j][3] * v[r][j][3]);
            const float rstd = __builtin_amdgcn_rsqf(wave_sum(ss[r]) * (1.0f / D) + EPS);
            const int b = row < TL ? (row >> 11) : 32;
            const float* mp = modl + (size_t)b * NMOD + shift_off;
#pragma unroll
            for (int j = 0; j < 4; ++j) {
                const int c = 4 * (lane + 64 * j);
                const f32x4 sh = *(const f32x4*)(mp + c), sc = *(const f32x4*)(mp + D + c);
                const f32x4 y = v[r][j] * rstd * gv[j] * (sc + 1.0f) + sh;
                u32x2 w; w.x = pk2(y[0], y[1]); w.y = pk2(y[2], y[3]);
                *(u32x2*)(U + (size_t)row * D + c) = w;
            }
        }
    }
}

struct AttnJob {
    const bf16_t* Q; int qpitch;
    const bf16_t* K; int kpitch;
    const bf16_t* Vt;
    bf16_t* O;
    int ctx_row0, lat_row0, ntiles;
    int na, r0, rlo;
    int fast;
};
#define MFMA32(a, b, c) __builtin_amdgcn_mfma_f32_32x32x16_bf16((a), (b), (c), 0, 0, 0)

__device__ __forceinline__ void glds16(const void* gsrc, unsigned lds_dst) { unsigned keep;
    asm volatile("s_mov_b32 %0, m0\n\ts_mov_b32 m0, %2\n\ts_nop 0\n\tglobal_load_lds_dwordx4 %1, off\n\ts_mov_b32 m0, %0" : "=&s"(keep) : "v"(gsrc), "s"(lds_dst) : "memory"); }
template <bool FAST>
__device__ __forceinline__ void att_scores(const LAS unsigned char* kb_, const bf16x8 (&qf)[4], int pi, int kx, int hi, bool local, const LAS float* bp, unsigned vmask, bool first,
                                           float& mrun, f32x16& o0, f32x16& o1, float& lrun, bf16x8 (&pf)[2][2]) {
    constexpr float THR = 8.0f;
    f32x16 s0, s1;
    if constexpr (FAST) {
#pragma unroll
        for (int i = 0; i < 16; ++i) { s0[i] = 0.f; s1[i] = 0.f; }
    } else {
        const float nm = -mrun;
#pragma unroll
        for (int i = 0; i < 16; ++i) { s0[i] = nm; s1[i] = nm; }
    }
    {
        bf16x8 a0[4], a1[4];
#pragma unroll
        for (int ks = 0; ks < 4; ++ks) { a0[ks] = *(const LAS bf16x8*)(kb_ + pi * 128 + (((2 * ks + hi) ^ kx) << 4)); a1[ks] = *(const LAS bf16x8*)(kb_ + (32 + pi) * 128 + (((2 * ks + hi) ^ kx) << 4)); }
        __builtin_amdgcn_sched_barrier(0);
#pragma unroll
        for (int ks = 0; ks < 4; ++ks) s0 = MFMA32(a0[ks], qf[ks], s0);
#pragma unroll
        for (int ks = 0; ks < 4; ++ks) s1 = MFMA32(a1[ks], qf[ks], s1);
    }
    if (local) {
#pragma unroll
        for (int i = 0; i < 16; ++i) {
            const float b0 = bp[16 * (i >> 3) + (i & 7)], b1 = bp[32 + 16 * (i >> 3) + (i & 7)];
            const unsigned m0 = (unsigned)__builtin_amdgcn_sbfe((int)vmask, i, 1), m1 = (unsigned)__builtin_amdgcn_sbfe((int)vmask, 16 + i, 1);
            const unsigned v0 = __builtin_bit_cast(unsigned, s0[i] + b0), v1 = __builtin_bit_cast(unsigned, s1[i] + b1);
            s0[i] = __builtin_bit_cast(float, (v0 & m0) | (0xf149f2cau & ~m0));
            s1[i] = __builtin_bit_cast(float, (v1 & m1) | (0xf149f2cau & ~m1));
            if ((i & 3) == 3) __builtin_amdgcn_sched_barrier(0);
        }
    }
    if constexpr (!FAST) {
    float mt = fmaxf(s0[0], s1[0]);
#pragma unroll
    for (int i = 1; i < 16; ++i) mt = fmaxf(mt, fmaxf(s0[i], s1[i]));
    mt = fmaxf(mt, __shfl_xor(mt, 32));
    if (first || __any(mt > THR)) {
        const float delta = first ? mt : (mt > THR ? mt : 0.f);
        const float alpha = first ? 1.0f : fast_exp2(-delta);
        mrun += delta;
#pragma unroll
        for (int i = 0; i < 16; ++i) { s0[i] -= delta; s1[i] -= delta; o0[i] *= alpha; o1[i] *= alpha; }
        lrun *= alpha;
    }
    }
    float rs = 0.f;
#pragma unroll
    for (int i = 0; i < 16; ++i) { s0[i] = fast_exp2(s0[i]); s1[i] = fast_exp2(s1[i]); rs += s0[i] + s1[i]; }
    lrun += rs;
#pragma unroll
    for (int cc = 0; cc < 2; ++cc) {
        u32x4 w0, w1;
        w0.x = pk2(s0[8 * cc + 0], s0[8 * cc + 1]); w0.y = pk2(s0[8 * cc + 2], s0[8 * cc + 3]); w0.z = pk2(s0[8 * cc + 4], s0[8 * cc + 5]); w0.w = pk2(s0[8 * cc + 6], s0[8 * cc + 7]);
        w1.x = pk2(s1[8 * cc + 0], s1[8 * cc + 1]); w1.y = pk2(s1[8 * cc + 2], s1[8 * cc + 3]); w1.z = pk2(s1[8 * cc + 4], s1[8 * cc + 5]); w1.w = pk2(s1[8 * cc + 6], s1[8 * cc + 7]);
        pf[0][cc] = __builtin_bit_cast(bf16x8, w0); pf[1][cc] = __builtin_bit_cast(bf16x8, w1);
    }
}
__device__ __forceinline__ void att_pv(const LAS unsigned char* vb_, int q, int vx, int hi, const bf16x8 (&pf)[2][2], f32x16& o0, f32x16& o1) {
#pragma unroll
    for (int kb = 0; kb < 2; ++kb) {
        bf16x8 v0[2], v1[2];
#pragma unroll
        for (int cc = 0; cc < 2; ++cc) { const int ch = 4 * kb + 2 * cc + hi;
            v0[cc] = *(const LAS bf16x8*)(vb_ + q * 128 + ((ch ^ vx) << 4)); v1[cc] = *(const LAS bf16x8*)(vb_ + (32 + q) * 128 + ((ch ^ vx) << 4)); }
        __builtin_amdgcn_sched_barrier(0);
#pragma unroll
        for (int cc = 0; cc < 2; ++cc) { o0 = MFMA32(v0[cc], pf[kb][cc], o0); o1 = MFMA32(v1[cc], pf[kb][cc], o1); }
        __builtin_amdgcn_sched_barrier(0);
    }
}

__device__ __forceinline__ void att_tile_fast(const LAS unsigned char* kb_, const LAS unsigned char* vb_, const bf16x8 (&qf)[4], int pi, int kx, int q, int vx, int hi,
                                              f32x16& o0, f32x16& o1, float& lrun) {
    bf16x8 a0[4], a1[4];
#pragma unroll
    for (int ks = 0; ks < 4; ++ks) { a0[ks] = *(const LAS bf16x8*)(kb_ + pi * 128 + (((2 * ks + hi) ^ kx) << 4)); a1[ks] = *(const LAS bf16x8*)(kb_ + (32 + pi) * 128 + (((2 * ks + hi) ^ kx) << 4)); }
    __builtin_amdgcn_sched_barrier(0);
    f32x16 s0, s1;
#pragma unroll
    for (int i = 0; i < 16; ++i) { s0[i] = 0.f; s1[i] = 0.f; }
#pragma unroll
    for (int ks = 0; ks < 4; ++ks) s0 = MFMA32(a0[ks], qf[ks], s0);
    __builtin_amdgcn_sched_barrier(0);
    float rs = 0.f;
#pragma unroll
    for (int ks = 0; ks < 4; ++ks) {
        s1 = MFMA32(a1[ks], qf[ks], s1);
#pragma unroll
        for (int i = 4 * ks; i < 4 * ks + 4; ++i) { s0[i] = fast_exp2(s0[i]); rs += s0[i]; }
        __builtin_amdgcn_sched_barrier(0);
    }
    bf16x8 p0[2];
#pragma unroll
    for (int cc = 0; cc < 2; ++cc) { u32x4 w; w.x = pk2(s0[8 * cc + 0], s0[8 * cc + 1]); w.y = pk2(s0[8 * cc + 2], s0[8 * cc + 3]); w.z = pk2(s0[8 * cc + 4], s0[8 * cc + 5]); w.w = pk2(s0[8 * cc + 6], s0[8 * cc + 7]); p0[cc] = __builtin_bit_cast(bf16x8, w); }
    bf16x8 va0[2], va1[2];
#pragma unroll
    for (int cc = 0; cc < 2; ++cc) { const int ch = 2 * cc + hi; va0[cc] = *(const LAS bf16x8*)(vb_ + q * 128 + ((ch ^ vx) << 4)); va1[cc] = *(const LAS bf16x8*)(vb_ + (32 + q) * 128 + ((ch ^ vx) << 4)); }
    __builtin_amdgcn_sched_barrier(0);
#pragma unroll
    for (int g = 0; g < 4; ++g) {
        if (g & 1) o1 = MFMA32(va1[g >> 1], p0[g >> 1], o1); else o0 = MFMA32(va0[g >> 1], p0[g >> 1], o0);
#pragma unroll
        for (int i = 4 * g; i < 4 * g + 4; ++i) { s1[i] = fast_exp2(s1[i]); rs += s1[i]; }
        __builtin_amdgcn_sched_barrier(0);
    }
    bf16x8 vb0[2], vb1[2];
#pragma unroll
    for (int cc = 0; cc < 2; ++cc) { const int ch = 4 + 2 * cc + hi; vb0[cc] = *(const LAS bf16x8*)(vb_ + q * 128 + ((ch ^ vx) << 4)); vb1[cc] = *(const LAS bf16x8*)(vb_ + (32 + q) * 128 + ((ch ^ vx) << 4)); }
    bf16x8 p1[2];
#pragma unroll
    for (int cc = 0; cc < 2; ++cc) { u32x4 w; w.x = pk2(s1[8 * cc + 0], s1[8 * cc + 1]); w.y = pk2(s1[8 * cc + 2], s1[8 * cc + 3]); w.z = pk2(s1[8 * cc + 4], s1[8 * cc + 5]); w.w = pk2(s1[8 * cc + 6], s1[8 * cc + 7]); p1[cc] = __builtin_bit_cast(bf16x8, w); }
#pragma unroll
    for (int cc = 0; cc < 2; ++cc) { o0 = MFMA32(vb0[cc], p1[cc], o0); o1 = MFMA32(vb1[cc], p1[cc], o1); }
    lrun += rs;
}

__device__ __forceinline__ void attn_unit(LAS unsigned char* lds, const AttnJob& J, const LAS float* biasL, int tid, int wid, int lane) {
    const int q = lane & 31, hi = lane >> 5;
    bf16x8 qf[4];
    f32x16 o0, o1; float lrun = 0.f;
#pragma unroll
    for (int i = 0; i < 16; ++i) { o0[i] = 0.f; o1[i] = 0.f; }
    float mrun = 0.f;
    bf16x8 pf[2][2];
#pragma unroll
    for (int a = 0; a < 2; ++a)
#pragma unroll
        for (int b = 0; b < 2; ++b) pf[a][b] = (bf16x8){0, 0, 0, 0, 0, 0, 0, 0};
    const int srow = tid >> 3;
    const int gch = (tid & 7) ^ ((srow >> 1) & 7);
    const int pi = (q & 0x13) | ((q & 4) << 1) | ((q & 8) >> 1);
    const int kx = (pi >> 1) & 7, vx = (q >> 1) & 7;
    const int rq = J.r0 + (wid >> 1), cq = (wid & 1) * 32 + q;
    const int rs_ = min(max(rq - 4, 0), 24), cs_ = min(max(cq - 8, 0), 48);
    unsigned vmask = 0u;
    if (J.na) {
#pragma unroll
        for (int i = 0; i < 32; ++i) { const int kc = 32 * (i >> 4) + 16 * ((i >> 3) & 1) + 8 * hi + (i & 7); vmask |= ((unsigned)(kc - cs_) < 16u ? 1u : 0u) << i; }
    }
    const int blane = 8 * hi - cq + 15 + 48;
    const bool fast = J.fast != 0;
    const bf16_t* kg = J.K + (size_t)srow * J.kpitch + gch * 8;
    const bf16_t* vg = J.Vt + (size_t)srow * T + gch * 8;
    const unsigned ldsw0 = (unsigned)(unsigned long long)lds + (unsigned)wid * 1024u;
#define ATT_ISSUE(tile, vslot) do { const int t_ = (tile); const int tk_ = t_ < 4 ? J.ctx_row0 + 64 * t_ : J.lat_row0 + 64 * (t_ - 4); \
        glds16(kg + (size_t)tk_ * J.kpitch, (unsigned)__builtin_amdgcn_readfirstlane((int)(ldsw0 + (t_ & 3) * 8192))); \
        glds16(vg + tk_, (unsigned)__builtin_amdgcn_readfirstlane((int)(ldsw0 + 32768 + (vslot) * 8192))); } while (0)
    ATT_ISSUE(0, 0); ATT_ISSUE(1, 1); ATT_ISSUE(2, 2);
    { const bf16_t* qrow = J.Q + (size_t)(wid * 32 + q) * J.qpitch + 8 * hi;
#pragma unroll
      for (int ks = 0; ks < 4; ++ks) qf[ks] = *(const bf16x8*)(qrow + 16 * ks); }
    asm volatile("s_waitcnt vmcnt(0) lgkmcnt(0)" :: "v"(qf[0]), "v"(qf[1]), "v"(qf[2]), "v"(qf[3]) : "memory");
    __builtin_amdgcn_s_barrier(); asm volatile("" ::: "memory");
    int vcur = 0, vprev = 4;
    for (int it = 0; it < J.ntiles; ++it) {
        const LAS unsigned char* kb_ = lds + (it & 3) * 8192;
        const int vnext = vcur == 4 ? 0 : vcur + 1;
        if (it + 3 < J.ntiles) { const int v3 = vcur + 3 >= 5 ? vcur - 2 : vcur + 3; ATT_ISSUE(it + 3, v3); }
        const int kr = J.rlo + it - 4;
        const bool local = J.na && it >= 4;
        const bool active = !local || (kr >= rs_ && kr < rs_ + 8);
        const LAS float* bp = biasL + (kr - rq + 7) * 128 + blane;
        if (active) {
            if (fast && !local) att_tile_fast(kb_, lds + 32768 + vcur * 8192, qf, pi, kx, q, vx, hi, o0, o1, lrun);
            else {
                if (fast) att_scores<true>(kb_, qf, pi, kx, hi, local, bp, vmask, it == 0, mrun, o0, o1, lrun, pf); else att_scores<false>(kb_, qf, pi, kx, hi, local, bp, vmask, it == 0, mrun, o0, o1, lrun, pf);
                att_pv(lds + 32768 + vcur * 8192, q, vx, hi, pf, o0, o1);
            }
        }
        const int ny = J.ntiles - (it + 2);
        if (ny >= 2) asm volatile("s_waitcnt vmcnt(4)" ::: "memory"); else if (ny == 1) asm volatile("s_waitcnt vmcnt(2)" ::: "memory"); else asm volatile("s_waitcnt vmcnt(0)" ::: "memory");
        __builtin_amdgcn_s_barrier(); asm volatile("" ::: "memory");
        vprev = vcur; vcur = vnext;
    }
#undef ATT_ISSUE
    const float inv = fast_rcp(lrun + __shfl_xor(lrun, 32));
    bf16_t* orow = J.O + (size_t)(wid * 32 + q) * D + 4 * hi;
#pragma unroll
    for (int c = 0; c < 4; ++c) {
        u32x2 w0, w1;
        w0.x = pk2(o0[4 * c] * inv, o0[4 * c + 1] * inv); w0.y = pk2(o0[4 * c + 2] * inv, o0[4 * c + 3] * inv);
        w1.x = pk2(o1[4 * c] * inv, o1[4 * c + 1] * inv); w1.y = pk2(o1[4 * c + 2] * inv, o1[4 * c + 3] * inv);
        *(u32x2*)(orow + 8 * c) = w0; *(u32x2*)(orow + 32 + 8 * c) = w1;
    }
}

__device__ __forceinline__ void pool_unit(LAS unsigned char* lds, const bf16_t* PC, const float* wpool, const float* pscale, bf16_t* Y, int unit, int tid) {
    const int row0 = unit * 64;
    const int seq0 = row0 < TL ? (row0 & ~(SEQ - 1)) : TL + ((row0 - TL) & ~(LCTX - 1));
    const int N = row0 < TL ? SEQ : LCTX;
    const int t0 = row0 - seq0;
    LAS unsigned short* vin = (LAS unsigned short*)lds;
    constexpr int PP = 264;
    LAS unsigned short* pooled = (LAS unsigned short*)(lds + 40960);
    for (int i = tid; i < 80 * 32; i += 512) {
        const int lr = i >> 5, ch8 = i & 31, t = t0 - 8 + lr;
        u32x4 v = (u32x4){0u, 0u, 0u, 0u};
        if (t >= 0 && t < N) v = *(const u32x4*)(PC + (size_t)(seq0 + t) * 256 + ch8 * 8);
        *(LAS u32x4*)(lds + (lr * 256 + ch8 * 8) * 2) = v;
    }
    __syncthreads();
    {
        const int ch = tid & 255, th = tid >> 8, g = ch >> 6, hw = 1 << g;
        const LAS unsigned short* vp = vin + (th * 32 + 8) * 256 + ch;
        float s = 0.f;
        for (int k = -hw; k < hw; ++k) s += bf2f(vp[k * 256]);
#pragma unroll 8
        for (int i = 0; i < 32; ++i) {
            const int tl = th * 32 + i, t = t0 + tl;
            const int lo = max(t - hw, 0), hi2 = min(t + hw, N);
            pooled[tl * PP + ch] = (unsigned short)f2bf(s * fast_rcp((float)(hi2 - lo)) - bf2f(vp[i * 256]));
            s += bf2f(vp[(i + hw) * 256]) - bf2f(vp[(i - hw) * 256]);
        }
    }
    __syncthreads();
    {
        const int lane = tid & 63, wid = tid >> 6, g = wid & 3, th = wid >> 2, q = lane & 31, hi = lane >> 5;
        const float* wg = wpool + (size_t)g * 64 * 64;
        bf16x8 af[4];
#pragma unroll
        for (int ks = 0; ks < 4; ++ks) af[ks] = *(const LAS bf16x8*)(pooled + (th * 32 + q) * PP + g * 64 + 16 * ks + 8 * hi);
#pragma unroll
        for (int db = 0; db < 2; ++db) {
            f32x16 dacc;
#pragma unroll
            for (int i = 0; i < 16; ++i) dacc[i] = 0.f;
#pragma unroll
            for (int ks = 0; ks < 4; ++ks) {
                const float* wp = wg + (size_t)(16 * ks + 8 * hi) * 64 + 32 * db + q;
                u32x4 w; w.x = pk2(wp[0], wp[64]); w.y = pk2(wp[128], wp[192]); w.z = pk2(wp[256], wp[320]); w.w = pk2(wp[384], wp[448]);
                dacc = MFMA32(af[ks], __builtin_bit_cast(bf16x8, w), dacc);
            }
            const int col = g * 64 + 32 * db + q;
            const float sc = pscale[col];
#pragma unroll
            for (int r = 0; r < 16; ++r) { const int tok = 8 * (r >> 2) + 4 * hi + (r & 3);
                Y[(size_t)(row0 + th * 32 + tok) * D + 768 + col] = (bf16_t)f2bf(dacc[r] * sc); }
        }
    }
    __syncthreads();
}

__device__ __forceinline__ void mixer_phase(KArgsPtr a, int l, bool lastl, LAS unsigned char* lds, unsigned* ctr, int tid_) {
    unsigned char* ws = a->ws;
    const bf16_t* big = (const bf16_t*)(ws + WS_BIG);
    bf16_t* Y = (bf16_t*)(ws + WS_U);
    constexpr int NG = NB * 6 * 8, NN = NB * 6 * 8, NCA = NB * 6, NCB = NB * 6;
    const int ncx = lastl ? 0 : NCA + NCB;
    const int npool = (lastl ? TL : T) / 64;
    const int total0 = NG + NN + ncx + npool;
    const int total = total0 + (MIX_DUP == 1 ? NG : MIX_DUP == 2 ? NN : MIX_DUP == 3 ? npool : 0);
    LAS int* shu = (LAS int*)(lds + LDS_MISC);
    LAS float* biasL = (LAS float*)(lds + 73728);
    int fastA, fastB, fastN;
    { const int ln = tid_ & 63;
      float qa = fabsf(a->in[9][l * 64 + ln]), ka = fabsf(a->in[10][l * 64 + ln]), qb = fabsf(a->in[11][l * 64 + ln]), kb = fabsf(a->in[12][l * 64 + ln]), bm = 0.f;
      for (int i = ln; i < 6 * 465; i += 64) bm = fmaxf(bm, fabsf(a->in[13][(size_t)l * 6 * 465 + i]));
#pragma unroll
      for (int o = 1; o < 64; o <<= 1) { qa = fmaxf(qa, __shfl_xor(qa, o)); ka = fmaxf(ka, __shfl_xor(ka, o)); qb = fmaxf(qb, __shfl_xor(qb, o)); kb = fmaxf(kb, __shfl_xor(kb, o)); bm = fmaxf(bm, __shfl_xor(bm, o)); }
      fastA = __builtin_amdgcn_readfirstlane((int)(11.5416f * qa * ka < 60.f));
      fastB = __builtin_amdgcn_readfirstlane((int)(11.5416f * qb * kb < 60.f));
      fastN = __builtin_amdgcn_readfirstlane((int)(11.5416f * qa * ka + bm * LOG2E < 60.f)); }
    if (tid_ == 0) shu[0] = (int)atomicAdd(ctr, 1u);
    __syncthreads();
    int u = __builtin_amdgcn_readfirstlane(shu[0]);
    for (int uit = 0;; ++uit) {
        int tid = tid_; asm volatile("" : "+v"(tid));
        const int lane = tid & 63, wid = __builtin_amdgcn_readfirstlane(tid >> 6);
        if (u >= total) break;
        if (u >= total0) u = u - total0 + (MIX_DUP == 2 ? NG : MIX_DUP == 3 ? NG + NN + ncx : 0);
        int nxt_ = 0; if (tid == 0) nxt_ = (int)atomicAdd(ctr, 1u);
        if (u < NG + NN + ncx) {
            AttnJob J;
            if (u < NG) {
                const int qb = u & 7, hq = (u >> 3) % 6, b = u / 48, hkv = hq / 3;
                J.Q = big + B_QB + (size_t)(b * SEQ + qb * 256) * 384 + hq * 64; J.qpitch = 384;
                J.K = big + B_KB + hkv * 64; J.kpitch = 128; J.Vt = big + B_VBT + (size_t)(hkv * 64) * T;
                J.O = Y + (size_t)(b * SEQ + qb * 256) * D + 384 + hq * 64;
                J.ctx_row0 = TL + b * LCTX; J.lat_row0 = b * SEQ; J.ntiles = 4 + 32; J.na = 0; J.r0 = 0; J.rlo = 0;
                J.fast = fastB;
            } else if ((u -= NG) < NN) {
                const int rg = u & 7, h = (u >> 3) % 6, b = u / 48, r0 = rg * 4;
                const int rlo = min(max(r0 - 4, 0), 24), rhi = min(max(r0 + 3 - 4, 0), 24) + 8;
                const float* rpb = a->in[13] + ((size_t)l * 6 + h) * 15 * 31;
                for (int i = tid; i < 15 * 128; i += 512) { const int dc = (i & 127) - 48; biasL[i] = (dc >= 0 && dc < 31) ? rpb[(i >> 7) * 31 + dc] * LOG2E : 0.f; }
                J.Q = big + B_QA + (size_t)(b * SEQ + r0 * 64) * 384 + h * 64; J.qpitch = 384;
                J.K = big + B_KA + h * 64; J.kpitch = 384; J.Vt = big + B_VAT + (size_t)(h * 64) * T;
                J.O = Y + (size_t)(b * SEQ + r0 * 64) * D + h * 64;
                J.ctx_row0 = TL + b * LCTX; J.lat_row0 = b * SEQ + rlo * 64; J.ntiles = 4 + (rhi - rlo); J.na = 1; J.r0 = r0; J.rlo = rlo;
                J.fast = fastN;
            } else {
                u -= NN;
                const bool second = u >= NCA; if (second) u -= NCA;
                const int h = u % 6, b = u / 6;
                if (!second) { J.Q = big + B_QA + (size_t)(TL + b * LCTX) * 384 + h * 64; J.K = big + B_KA + h * 64; J.kpitch = 384; J.Vt = big + B_VAT + (size_t)(h * 64) * T; J.O = Y + (size_t)(TL + b * LCTX) * D + h * 64; }
                else { const int hkv = h / 3; J.Q = big + B_QB + (size_t)(TL + b * LCTX) * 384 + h * 64; J.K = big + B_KB + hkv * 64; J.kpitch = 128; J.Vt = big + B_VBT + (size_t)(hkv * 64) * T; J.O = Y + (size_t)(TL + b * LCTX) * D + 384 + h * 64; }
                J.qpitch = 384; J.ctx_row0 = TL + b * LCTX; J.lat_row0 = 0; J.ntiles = 4; J.na = 0; J.r0 = 0; J.rlo = 0;
                J.fast = second ? fastB : fastA;
            }
            attn_unit(lds, J, biasL, tid, wid, lane);
        } else {
            u -= NG + NN + ncx;
            pool_unit(lds, big + B_PC, a->in[14] + (size_t)l * 4 * 64 * 64, a->in[15] + (size_t)l * 256, Y, u, tid);
        }
        if (tid == 0) shu[(uit + 1) & 1] = nxt_;
        __syncthreads();
        u = __builtin_amdgcn_readfirstlane(shu[(uit + 1) & 1]);
    }
}


#define XB_TMO      128
#define XB_XCNT(j)  (256  + 64 * (j))
#define XB_XSUB(j)  (1280 + 64 * (j))
#define XB_XGEN(j)  (2304 + 64 * (j))
#define XB_TOP      3328
#define XB_TOPGEN   3392
#define XB_SPIN_CAP (1u << 22)
constexpr int CW_BAR = 4096;
__device__ __forceinline__ unsigned xb_ld(unsigned* p)              { return __hip_atomic_load(p, __ATOMIC_RELAXED, __HIP_MEMORY_SCOPE_AGENT); }
__device__ __forceinline__ unsigned xb_add(unsigned* p, unsigned v) { return __hip_atomic_fetch_add(p, v, __ATOMIC_RELAXED, __HIP_MEMORY_SCOPE_AGENT); }
__device__ __forceinline__ unsigned xb_xcc_id() { return (unsigned)__builtin_amdgcn_s_getreg((3 << 11) | 20) & 0xFu; }
#define XB_SPIN(cond, bar) do { unsigned _sp = 0; while (cond) { __builtin_amdgcn_s_sleep(1); \
    if ((++_sp & 255u) == 0u) { if (xb_ld(&(bar)[XB_TMO])) break; if (_sp > XB_SPIN_CAP) { atomicAdd(&(bar)[XB_TMO], 1u); break; } } } } while (0)
__device__ __forceinline__ void xcd_barrier_complete(unsigned* bar, unsigned x, unsigned& nloc, unsigned& nx) {
    const unsigned G = gridDim.x * gridDim.y * gridDim.z;
    unsigned sum, cnt, mine, sp = 0u;
    for (;;) {
        sum = 0u; cnt = 0u; mine = 0u;
#pragma unroll
        for (unsigned j = 0; j < 16; ++j) { const unsigned c = xb_ld(&bar[XB_XCNT(j)]); sum += c; cnt += (c > 0u) ? 1u : 0u; mine = (j == x) ? c : mine; }
        if (sum == G) break;
        __builtin_amdgcn_s_sleep(1);
        if ((++sp & 255u) == 0u) { if (xb_ld(&bar[XB_TMO])) break; if (sp > XB_SPIN_CAP) { atomicAdd(&bar[XB_TMO], 1u); break; } }
    }
    nloc = mine > 0u ? mine : 1u; nx = cnt > 0u ? cnt : 1u;
}
__device__ __forceinline__ void xcd_barrier(unsigned* bar, volatile LAS unsigned* st) {
    asm volatile("s_waitcnt vmcnt(0)" ::: "memory");
    __syncthreads();
    if (threadIdx.x == 0) {
        const unsigned x = xb_xcc_id();
        __builtin_amdgcn_s_waitcnt(0);
        unsigned nloc = st[0], nx = st[1];
        if (nloc == 0u) { xcd_barrier_complete(bar, x, nloc, nx); st[0] = nloc; st[1] = nx; }
        const unsigned old = xb_add(&bar[XB_XSUB(x)], 1u);
        const unsigned gen = old / nloc;
        if (old + 1u == (gen + 1u) * nloc) {
            __builtin_amdgcn_fence(__ATOMIC_RELEASE, "agent");
            asm volatile("s_waitcnt vmcnt(0)" ::: "memory");
            const unsigned og = xb_add(&bar[XB_TOP], 1u);
            const unsigned tg = og / nx;
            if (og + 1u == (tg + 1u) * nx) xb_add(&bar[XB_TOPGEN], 1u);
            else XB_SPIN(xb_ld(&bar[XB_TOPGEN]) == tg, bar);
            __builtin_amdgcn_fence(__ATOMIC_ACQUIRE, "agent");
            xb_add(&bar[XB_XGEN(x)], 1u);
            asm volatile("s_waitcnt vmcnt(0)" ::: "memory");
        } else {
            XB_SPIN(xb_ld(&bar[XB_XGEN(x)]) == gen, bar);
            __builtin_amdgcn_fence(__ATOMIC_ACQUIRE, "agent");
            asm volatile("s_waitcnt vmcnt(0)" ::: "memory");
        }
    }
    __syncthreads();
}

__device__ __forceinline__ KArgsPtr fresh_args() {
    KArgsPtr p = (KArgsPtr)__builtin_amdgcn_kernarg_segment_ptr();
    asm volatile("" : "+s"(p) :: "memory");
    return p;
}
#define IN(k) (lo <= (k) && (k) < hi)
#define SEAM(k) do { if ((k) + 1 < hi) { if (lo < 0) { __threadfence(); cg::this_grid().sync(); } else xcd_barrier((unsigned*)(a_.ws + WS_CTL) + CW_BAR, (volatile LAS unsigned*)(lds + LDS_MISC + 16)); } } while (0)
#define PH_COMMON KArgsPtr a = fresh_args(); unsigned char* ws = a->ws; int tid = threadIdx.x; asm volatile("" : "+v"(tid)); const int lane = tid & 63, wid = __builtin_amdgcn_readfirstlane(tid >> 6); \
    int G = __builtin_amdgcn_readfirstlane((int)gridDim.x), c = __builtin_amdgcn_readfirstlane((int)blockIdx.x); \
    bf16_t* U = (bf16_t*)(ws + WS_U); bf16_t* BIG = (bf16_t*)(ws + WS_BIG); float* modall = (float*)(ws + WS_MOD); float* hbuf = (float*)(ws + WS_H); float* xout = a->out; \
    const bool lastl = (l == DEPTH - 1); const float* modl = modall + (size_t)l * 33 * NMOD; const float* xs = l == 0 ? a->in[0] : xout; const float* hs = l == 0 ? a->in[2] : hbuf; const int M = lastl ? TL : T; \
    (void)tid; (void)lane; (void)wid; (void)G; (void)c; (void)U; (void)BIG; (void)hbuf; (void)modl; (void)xs; (void)hs; (void)M; (void)lastl; (void)xout;
__global__ void __launch_bounds__(512, 2) mega_fwd(Args a_) {
    extern __shared__ __attribute__((aligned(16))) unsigned char lds_raw[];
    LAS unsigned char* lds = (LAS unsigned char*)lds_raw;
    const int lo = a_.ph_lo, hi = a_.ph_hi;
    if (threadIdx.x == 0) { ((volatile LAS unsigned*)(lds + LDS_MISC + 16))[0] = 0u; ((volatile LAS unsigned*)(lds + LDS_MISC + 16))[1] = 0u;
        (void)xb_add((unsigned*)(a_.ws + WS_CTL) + CW_BAR + XB_XCNT(xb_xcc_id()), 1u); }
    __syncthreads();
    if (IN(0)) { const int l = 0; PH_COMMON prep_phase(a, lds, tid, wid, lane, c, G);
#if PREP_DOUBLE
        xcd_barrier((unsigned*)(a_.ws + WS_CTL) + CW_BAR, (volatile LAS unsigned*)(lds + LDS_MISC + 16)); prep_phase(a, lds, tid, wid, lane, c, G);
#endif
        SEAM(0); }
    if (IN(1)) { const int l = 0; PH_COMMON
        pg8::Gemm g{(const bf16_t*)(ws + WS_SC), (const bf16_t*)(ws + WS_BIG), 256, DEPTH * NMOD, D};
        pg8::StaticOrder S; S.init(256, DEPTH * NMOD, G, c);
        EpiMod E{modall, a->in[5]};
        pg8::gemm_phase<EpiMod, pg8::StaticOrder, false, true>(lds, g, S, E, tid);
        SEAM(1);
    }
#pragma unroll 1
    for (int l = 0; l < DEPTH; ++l) {
        const int pb = 2 + 8 * l;
        if (IN(pb + 0) && l == 0) { for (int rep_ = 0; rep_ < ((REP_MASK >> 0) & 1) + 1; ++rep_) { if (rep_) { xcd_barrier((unsigned*)(a_.ws + WS_CTL) + CW_BAR, (volatile LAS unsigned*)(lds + LDS_MISC + 16)); } PH_COMMON norm_phase(xs, hs, a->in[6] + l * D, modl, 0, T, U, wid, lane, c, G); } SEAM(pb + 0); }
        if (IN(pb + 1)) { for (int rep_ = 0; rep_ < ((REP_MASK >> 1) & 1) + 1; ++rep_) { if (rep_) { xcd_barrier((unsigned*)(a_.ws + WS_CTL) + CW_BAR, (volatile LAS unsigned*)(lds + LDS_MISC + 16)); } PH_COMMON
            pg8::Gemm g{U, (const bf16_t*)(ws + WS_WIN) + (size_t)l * NIN * D, T, NIN, D};
            pg8::StaticOrder S; S.init(T, NIN, G, c);
            EpiIn E{BIG, a->in[9] + l * 64, a->in[10] + l * 64, a->in[11] + l * 64, a->in[12] + l * 64, (const f32x2*)(ws + WS_ROPE)};
            pg8::gemm_phase<EpiIn, pg8::StaticOrder, true, true>(lds, g, S, E, tid, ((c >> 3) & 3) * STG_K1024);
            } SEAM(pb + 1);
        }
        if (IN(pb + 2)) { for (int rep_ = 0; rep_ < ((REP_MASK >> 2) & 1) + 1; ++rep_) { if (rep_) { xcd_barrier((unsigned*)(a_.ws + WS_CTL) + CW_BAR, (volatile LAS unsigned*)(lds + LDS_MISC + 16)); } PH_COMMON mixer_phase(a, l, lastl, lds, (unsigned*)(ws + WS_CTL) + 64 * (1 + l + 8 * rep_), tid); } SEAM(pb + 2); }
        if (IN(pb + 3)) { for (int rep_ = 0; rep_ < ((REP_MASK >> 3) & 1) + 1; ++rep_) { if (rep_) { xcd_barrier((unsigned*)(a_.ws + WS_CTL) + CW_BAR, (volatile LAS unsigned*)(lds + LDS_MISC + 16)); } PH_COMMON
            pg8::Gemm g{U, (const bf16_t*)(ws + WS_WBR) + (size_t)l * D * D, M, D, D};
            pg8::StaticOrder S; S.init(M, D, G, c);
            S.dbl = 0; EpiMerge E{BIG + B_G, BIG};
            pg8::gemm_phase<EpiMerge, pg8::StaticOrder, true, true>(lds, g, S, E, tid, ((c >> 3) & 3) * STG_K1024);
            } SEAM(pb + 3);
        }
        if (IN(pb + 4)) { PH_COMMON
            pg8::Gemm g{BIG, (const bf16_t*)(ws + WS_WOUT) + (size_t)l * D * D, M, D, D};
            pg8::PanelOrder S; S.init(M, G, c);
            EpiResNorm E{xs, xout, hs, hbuf, modl, 2 * D, a->in[7] + l * D, modl, 3 * D, U, (float*)(ws + WS_SLOTS), (unsigned*)(ws + WS_CTL + CTL_PANEL) + (l * 2 + 0) * 512, lds + LDS_XCH};
            pg8::gemm_phase<EpiResNorm, pg8::PanelOrder, true, true>(lds, g, S, E, tid);
            SEAM(pb + 4);
        }
        if (IN(pb + 6)) { for (int rep_ = 0; rep_ < ((REP_MASK >> 6) & 1) + 1; ++rep_) { if (rep_) { xcd_barrier((unsigned*)(a_.ws + WS_CTL) + CW_BAR, (volatile LAS unsigned*)(lds + LDS_MISC + 16)); } PH_COMMON
            pg8::Gemm g{U, (const bf16_t*)(ws + WS_W13) + (size_t)l * 2 * FF * D, M, 2 * FF, D};
            pg8::StaticOrder S; S.init(M, 2 * FF, G, c);
            EpiFF1 E{BIG};
            pg8::gemm_phase<EpiFF1, pg8::StaticOrder, true, true>(lds, g, S, E, tid, ((c >> 3) & 3) * STG_K1024);
            } SEAM(pb + 6);
        }
        if (IN(pb + 7)) { PH_COMMON
            pg8::Gemm g{BIG, (const bf16_t*)(ws + WS_W2) + (size_t)l * D * FF, M, D, FF};
            if (lastl) {
                pg8::StaticOrder S; S.init(M, D, G, c);
                EpiRes E{xout, xout, hbuf, hbuf, modl, 5 * D};
                pg8::gemm_phase<EpiRes, pg8::StaticOrder, true, true>(lds, g, S, E, tid, ((c >> 3) & 3) * STG_K2816);
            } else {
                pg8::PanelOrder S; S.init(M, G, c);
                EpiResNorm E{xout, xout, hbuf, hbuf, modl, 5 * D, a->in[6] + (l + 1) * D, modall + (size_t)(l + 1) * 33 * NMOD, 0, U, (float*)(ws + WS_SLOTS), (unsigned*)(ws + WS_CTL + CTL_PANEL) + (l * 2 + 1) * 512, lds + LDS_XCH};
                pg8::gemm_phase<EpiResNorm, pg8::PanelOrder, true, true>(lds, g, S, E, tid);
            }
            SEAM(pb + 7);
        }
    }
}
#undef IN
#undef SEAM

extern "C" void kernel_launch(void* const* d_in, const int* in_sizes, int n_in, void* d_out, int out_size, void* d_ws, size_t ws_size, hipStream_t stream) {
    static int grid = 0;
    if (grid == 0) {
        if (n_in != 23 || out_size != TL * D || ws_size < WS_END2) { fprintf(stderr, "kernel_launch: unexpected shapes (n_in %d out %d ws %zu need %zu)\n", n_in, out_size, ws_size, (size_t)WS_END2); grid = -1; return; }
        int dev = 0, cus = 0, per_cu = 0;
        hipGetDevice(&dev); hipDeviceGetAttribute(&cus, hipDeviceAttributeMultiprocessorCount, dev);
        if (hipFuncSetAttribute((const void*)mega_fwd, hipFuncAttributeMaxDynamicSharedMemorySize, LDS_BYTES) != hipSuccess) { fprintf(stderr, "kernel_launch: hipFuncSetAttribute failed\n"); grid = -1; return; }
        if (hipOccupancyMaxActiveBlocksPerMultiprocessor(&per_cu, (const void*)mega_fwd, 512, LDS_BYTES) != hipSuccess || per_cu < 1) { fprintf(stderr, "kernel_launch: occupancy query gave %d\n", per_cu); per_cu = 1; }
        (void)hipGetLastError();
        grid = cus;
        fprintf(stderr, "kernel_launch: cus %d per_cu %d grid %d ws %zu\n", cus, per_cu, grid, ws_size);
    }
    if (grid < 0) return;
    hipMemsetAsync((char*)d_ws + WS_CTL, 0, CTL_BYTES, stream);
    Args a{};
    for (int i = 0; i < 23; ++i) a.in[i] = (const float*)d_in[i];
    a.out = (float*)d_out; a.ws = (unsigned char*)d_ws;
    for (int i = 0; i < 16; ++i) a.freq[i] = (float)pow(10000.0, -(double)i / 16.0);
#if MK_PER_PHASE
    for (int ph = 0; ph < NPH; ++ph) { a.ph_lo = ph; a.ph_hi = ph + 1; hipLaunchKernelGGL(mega_fwd, dim3(grid), dim3(512), LDS_BYTES, stream, a); }
#else
    a.ph_lo = 0; a.ph_hi = NPH;
    void* args[] = {&a};
    hipError_t e = hipLaunchCooperativeKernel((const void*)mega_fwd, dim3(grid), dim3(512), args, LDS_BYTES, stream);
    if (e != hipSuccess) fprintf(stderr, "kernel_launch: cooperative launch failed: %s (grid %d)\n", hipGetErrorString(e), grid);
#endif
}
```

```cpp
#include <hip/hip_runtime.h>
#include <hip/hip_cooperative_groups.h>
#include <cstdio>
#include <cstdint>
#include <cmath>
namespace cg = cooperative_groups;

#ifndef REP_MASK
#define REP_MASK 0
#endif
#ifndef EPI_DOUBLE
#define EPI_DOUBLE 0
#endif
#ifndef PREP_DOUBLE
#define PREP_DOUBLE 0
#endif
#ifndef MIX_DUP
#define MIX_DUP 0
#endif
#ifndef GEMM_DOUBLE
#define GEMM_DOUBLE 0
#endif
#ifndef STG_K1024
#define STG_K1024 0
#define STG_K2816 0
#endif
#ifndef MK_PER_PHASE
#define MK_PER_PHASE 0
#endif

#define LAS __attribute__((address_space(3)))
typedef unsigned short bf16_t;
typedef short bf16x8 __attribute__((ext_vector_type(8)));
typedef float f32x4 __attribute__((ext_vector_type(4)));
typedef float f32x2 __attribute__((ext_vector_type(2)));
typedef float f32x16 __attribute__((ext_vector_type(16)));
typedef unsigned u32x4 __attribute__((ext_vector_type(4)));
typedef unsigned u32x2 __attribute__((ext_vector_type(2)));

constexpr int D = 1024, NB = 32, SEQ = 2048, DEPTH = 4, LCTX = 256, GW = 64;
constexpr int TL = NB * SEQ, TC = NB * LCTX, T = TL + TC;
constexpr int NIN = 5120, FF = 2816, NMOD = 6144;
constexpr float EPS = 1e-6f;
constexpr float LOG2E = 1.4426950408889634f;
constexpr float QSCALE = 0.125f * LOG2E;
constexpr int NPH = 2 + 8 * DEPTH;

constexpr size_t WS_CTL = 0, CTL_BYTES = 65536;
constexpr size_t WS_ROPE = WS_CTL + CTL_BYTES;
constexpr size_t WS_MOD = WS_ROPE + 8192;
constexpr size_t WS_SC = WS_MOD + (size_t)DEPTH * 33 * NMOD * 4;
constexpr size_t WS_H = WS_SC + 256 * 1024 * 2;
constexpr size_t WS_WIN = WS_H + (size_t)TC * D * 4;
constexpr size_t WS_WBR = WS_WIN + (size_t)DEPTH * NIN * D * 2;
constexpr size_t WS_WOUT = WS_WBR + (size_t)DEPTH * D * D * 2;
constexpr size_t WS_W13 = WS_WOUT + (size_t)DEPTH * D * D * 2;
constexpr size_t WS_W2 = WS_W13 + (size_t)DEPTH * 2 * FF * D * 2;
constexpr size_t WS_U = WS_W2 + (size_t)DEPTH * D * FF * 2;
constexpr size_t WS_BIG = WS_U + (size_t)T * D * 2;
constexpr size_t WS_END = WS_BIG + (size_t)T * NIN * 2;
constexpr size_t WS_SLOTS = WS_END;
constexpr size_t WS_END2 = WS_SLOTS + (size_t)T * 4 * 4;
static_assert(WS_END2 <= (size_t)1073741824, "workspace map exceeds 1 GiB");
constexpr size_t CTL_PANEL = 32768;
constexpr size_t B_QA = 0, B_KA = B_QA + (size_t)T * 384, B_VAT = B_KA + (size_t)T * 384, B_QB = B_VAT + (size_t)T * 384, B_KB = B_QB + (size_t)T * 384,
                 B_VBT = B_KB + (size_t)T * 128, B_PC = B_VBT + (size_t)T * 128, B_G = B_PC + (size_t)T * 256;
static_assert(B_G == (size_t)T * 2048, "BIG layout");

constexpr int LDS_BYTES = 131072 + 1024 + 6144;
constexpr int LDS_XCH = 131072 + 1024;
constexpr int LDS_MISC = 131072;

__device__ __forceinline__ unsigned f2bf(float f) { unsigned u = __builtin_bit_cast(unsigned, f); return (u + 0x7fffu + ((u >> 16) & 1u)) >> 16; }
typedef __bf16 hwbf2 __attribute__((ext_vector_type(2)));
__device__ __forceinline__ unsigned pk2(float lo, float hi) { const f32x2 v = {lo, hi}; const hwbf2 b = __builtin_convertvector(v, hwbf2); return __builtin_bit_cast(unsigned, b); }
__device__ __forceinline__ float bf2f(unsigned short h) { return __builtin_bit_cast(float, (unsigned)h << 16); }
__device__ __forceinline__ float bflo(unsigned w) { return __builtin_bit_cast(float, w << 16); }
__device__ __forceinline__ float bfhi(unsigned w) { return __builtin_bit_cast(float, w & 0xffff0000u); }
__device__ __forceinline__ float wave_sum(float v) {
#pragma unroll
    for (int o = 1; o < 64; o <<= 1) v += __shfl_xor(v, o);
    return v;
}
__device__ __forceinline__ float fast_exp2(float x) { return __builtin_amdgcn_exp2f(x); }
__device__ __forceinline__ float fast_rcp(float x) { return __builtin_amdgcn_rcpf(x); }
__device__ __forceinline__ float sigmoidf_(float x) { return fast_rcp(1.0f + fast_exp2(x * -LOG2E)); }

namespace pg8 {
constexpr int BM = 256, BK = 64, HALF = 128, HTB = HALF * BK * 2, NXCD = 8, WGM = 8;
__host__ __device__ __forceinline__ int lds_byte(int r, int c) { const int st = (r >> 4) * 2 + (c >> 5), rr = r & 15, cc = c & 31, ob = rr * 64 + cc * 2; return st * 1024 + (ob ^ (((ob >> 9) & 1) << 5)); }
__host__ __device__ __forceinline__ void stage_rc(int b, int& R, int& C) { const int st = b / 1024, sb = b % 1024, swz = sb ^ (((sb >> 9) & 1) << 5); R = (st >> 1) * 16 + swz / 64; C = (st & 1) * 32 + (swz % 64) / 2; }

struct Unit { int pm, pn, second; };
struct Gemm { const bf16_t* A; const bf16_t* Bt; int M, N, K; };

struct StaticOrder {
    int nM, nN, nwg, G, c, dbl, xtra;
    __device__ void init(int M, int N, int G_, int c_) { nM = M / BM; nN = N / BM; nwg = nM * nN; G = G_; c = c_; dbl = GEMM_DOUBLE; xtra = 0; }
    __device__ bool next(int i, Unit& u) const {
        const long L = (long)(dbl ? (i >> 1) : i) * G + c; u.second = dbl ? (i & 1) : 1;
        if (L >= nwg) { const int k = (int)(L - nwg); if (k >= xtra) return false; const int t = k % 5; u.pm = nM + k / 5; u.pn = t < 4 ? t + 1 : 6; return true; }
        int wgid = (int)L; { const int q = nwg / NXCD, r = nwg % NXCD, xcd = wgid % NXCD, off = wgid / NXCD; wgid = (xcd < r ? xcd * (q + 1) : r * (q + 1) + (xcd - r) * q) + off; }
        const int nig = WGM * nN, gid = wgid / nig, fm = gid * WGM, gsz = (nM - fm) < WGM ? (nM - fm) : WGM;
        u.pm = fm + ((wgid % nig) % gsz); u.pn = (wgid % nig) / gsz; return true;
    }
};

struct PanelOrder {
    int nM, G, c, dbl;
    __device__ void init(int M, int G_, int c_) { nM = M / BM; G = G_; c = c_; dbl = 0; }
    __device__ bool next(int i, Unit& u) const {
        if (G < 256 || c >= 256) { if (G >= 256) return false; const long L = (long)i * (G & ~3) + c; if (c >= (G & ~3) || L >= (long)nM * 4) return false; u.pm = (int)(L >> 2); u.pn = (int)(L & 3); u.second = 1; return true; }
        const int pm = i * 64 + (c & 7) * 8 + (c >> 5); if (pm >= nM) return false;
        u.pm = pm; u.pn = (c >> 3) & 3; u.second = 1; return true;
    }
};

template <class Epi, class Sched, bool ALIGN_EPI = false, bool SP2 = false>
__device__ __forceinline__ void gemm_phase(LAS unsigned char* lds, const Gemm g, const Sched& S, const Epi& E, const int tid, const int stagger_ticks = 0) {
    const int wid = __builtin_amdgcn_readfirstlane(tid >> 6), lane = tid & 63, wr = wid >> 2, wc = wid & 3, fr = lane & 15, fq = lane >> 4;
    const int K = g.K, nt = K / BK;
    unsigned voffA[2], voffB[2];
#pragma unroll
    for (int i = 0; i < 2; ++i) { int R, C; stage_rc(tid * 16 + i * 8192, R, C); voffA[i] = (unsigned)(R * K + C) * 2u; voffB[i] = (unsigned)(R * K + C) * 2u; }
    const size_t kstep = (size_t)(BK * 2);
    const size_t hstep = (size_t)HALF * K * 2;
    const size_t tstep = 2 * hstep;
    const unsigned ldsw = (unsigned)wid * 1024u;
    const int aoff = lds_byte(wr * 64 + fr, fq * 8), boff = lds_byte(wc * 32 + fr, fq * 8);
#define PG8_SA(b, h) (((b) * 2 + (h)) * HTB)
#define PG8_SB(b, h) ((4 + (b) * 2 + (h)) * HTB)
#define PG8_STAGE(bufoff, gbase, voff) do { _Pragma("unroll") for (int _i = 0; _i < 2; ++_i) \
        __builtin_amdgcn_global_load_lds((const unsigned*)((const char*)(gbase) + (voff)[_i]), (LAS unsigned*)(lds + (bufoff) + ldsw + _i * 8192), 16, 0, 0); } while (0)
#define PG8_LDA(dst, b, h) do { _Pragma("unroll") for (int m = 0; m < 4; ++m) _Pragma("unroll") for (int k = 0; k < 2; ++k) dst[m][k] = *(const LAS bf16x8*)(lds + PG8_SA(b, h) + aoff + m * 2048 + k * 1024); } while (0)
#define PG8_LDB(dst, b, h) do { _Pragma("unroll") for (int n = 0; n < 2; ++n) _Pragma("unroll") for (int k = 0; k < 2; ++k) dst[n][k] = *(const LAS bf16x8*)(lds + PG8_SB(b, h) + boff + n * 2048 + k * 1024); } while (0)
#define PG8_MMA(ai, bj, At, Bt) do { __builtin_amdgcn_s_setprio(1); _Pragma("unroll") for (int m = 0; m < 4; ++m) _Pragma("unroll") for (int n = 0; n < 2; ++n) _Pragma("unroll") for (int k = 0; k < 2; ++k) \
        acc[ai][bj][m][n] = __builtin_amdgcn_mfma_f32_16x16x32_bf16(Bt[n][k], At[m][k], acc[ai][bj][m][n], 0, 0, 0); __builtin_amdgcn_s_setprio(0); } while (0)
#define PG8_WAIT_V(n) asm volatile("s_waitcnt vmcnt(" #n ")" ::: "memory")
#define PG8_WAIT_L(n) asm volatile("s_waitcnt lgkmcnt(" #n ")" ::: "memory")
#define PG8_BAR __builtin_amdgcn_s_barrier()
#define PG8_SCHED __builtin_amdgcn_sched_barrier(0)
    Unit cur, nxt; int ui = 0;
    if (!S.next(0, cur)) return;
    if (stagger_ticks > 0) {
        const unsigned long long t0 = __builtin_amdgcn_s_memrealtime();
        while ((long long)(__builtin_amdgcn_s_memrealtime() - t0) < (long long)stagger_ticks) __builtin_amdgcn_s_sleep(16);
    }
    f32x4 acc[2][2][4][2];
#pragma unroll
    for (int a = 0; a < 2; ++a)
#pragma unroll
        for (int b = 0; b < 2; ++b)
#pragma unroll
            for (int m = 0; m < 4; ++m)
#pragma unroll
                for (int n = 0; n < 2; ++n) acc[a][b][m][n] = (f32x4){0.f, 0.f, 0.f, 0.f};
    bf16x8 At[4][2], B0[2][2], B1[2][2];
    const char* cA = (const char*)g.A + (size_t)cur.pm * tstep; const char* cB = (const char*)g.Bt + (size_t)cur.pn * tstep;
    if constexpr (SP2) {
        PG8_STAGE(PG8_SB(0, 0), cB, voffB); PG8_STAGE(PG8_SB(0, 1), cB + hstep, voffB); PG8_STAGE(PG8_SA(0, 0), cA, voffA); PG8_STAGE(PG8_SA(0, 1), cA + hstep, voffA);
        if (wr == 1) PG8_BAR;
        PG8_WAIT_V(2); PG8_BAR;
        PG8_STAGE(PG8_SB(1, 0), cB + kstep, voffB); PG8_STAGE(PG8_SA(1, 0), cA + kstep, voffA); PG8_STAGE(PG8_SB(1, 1), cB + hstep + kstep, voffB);
        PG8_WAIT_V(6); PG8_BAR;
    } else {
        PG8_STAGE(PG8_SB(0, 0), cB, voffB); PG8_STAGE(PG8_SA(0, 0), cA, voffA); PG8_STAGE(PG8_SB(0, 1), cB + hstep, voffB); PG8_STAGE(PG8_SA(0, 1), cA + hstep, voffA);
        if (wr == 1) PG8_BAR;
        PG8_WAIT_V(4); PG8_BAR;
        PG8_STAGE(PG8_SB(1, 0), cB + kstep, voffB); PG8_STAGE(PG8_SA(1, 0), cA + kstep, voffA); PG8_STAGE(PG8_SB(1, 1), cB + hstep + kstep, voffB);
        PG8_WAIT_V(6); PG8_BAR;
    }
    for (;;) {
        const bool has_next = S.next(ui + 1, nxt);
        const char* nA = has_next ? (const char*)g.A + (size_t)nxt.pm * tstep : cA; const char* nB = has_next ? (const char*)g.Bt + (size_t)nxt.pn * tstep : cB;
        for (int t = 0; t < nt; t += 2) {
            if constexpr (Epi::MID) { if (t == 6 || t == 12) E.mid(acc, cur, t == 6 ? 0 : 1, wr, wc, fr, fq); }
            const bool last = (t == nt - 2);
            const char* a1 = cA + (size_t)(t + 1) * kstep;
            const char* a2 = last ? nA : cA + (size_t)(t + 2) * kstep; const char* b2 = last ? nB : cB + (size_t)(t + 2) * kstep;
            const char* a3 = a2 + kstep; const char* b3 = b2 + kstep;
            if constexpr (SP2) {
            PG8_LDB(B0, 0, 0); PG8_LDB(B1, 0, 1); PG8_SCHED; PG8_LDA(At, 0, 0); PG8_STAGE(PG8_SA(1, 1), a1 + hstep, voffA);
            PG8_WAIT_V(8); PG8_WAIT_L(0); PG8_BAR; PG8_MMA(0, 0, At, B0); PG8_MMA(0, 1, At, B1); PG8_BAR; PG8_SCHED;
            PG8_LDA(At, 0, 1); PG8_STAGE(PG8_SB(0, 0), b2, voffB); PG8_STAGE(PG8_SB(0, 1), b2 + hstep, voffB); PG8_STAGE(PG8_SA(0, 0), a2, voffA);
            PG8_WAIT_V(8); PG8_WAIT_L(0); PG8_BAR; PG8_MMA(1, 0, At, B0); PG8_MMA(1, 1, At, B1); PG8_BAR; PG8_SCHED;
            PG8_LDB(B0, 1, 0); PG8_LDB(B1, 1, 1); PG8_SCHED; PG8_LDA(At, 1, 0); PG8_STAGE(PG8_SA(0, 1), a2 + hstep, voffA);
            PG8_WAIT_V(8); PG8_WAIT_L(0); PG8_BAR; PG8_MMA(0, 0, At, B0); PG8_MMA(0, 1, At, B1); PG8_BAR; PG8_SCHED;
            PG8_LDA(At, 1, 1); PG8_STAGE(PG8_SB(1, 0), b3, voffB); PG8_STAGE(PG8_SB(1, 1), b3 + hstep, voffB); PG8_STAGE(PG8_SA(1, 0), a3, voffA);
            PG8_WAIT_V(8); PG8_WAIT_L(0); PG8_BAR; PG8_MMA(1, 0, At, B0); PG8_MMA(1, 1, At, B1); PG8_BAR; PG8_SCHED;
            } else {
            PG8_LDB(B0, 0, 0); PG8_SCHED; PG8_LDA(At, 0, 0); PG8_STAGE(PG8_SA(1, 1), a1 + hstep, voffA);
            PG8_WAIT_L(8); PG8_BAR; PG8_WAIT_L(0); PG8_MMA(0, 0, At, B0); PG8_BAR; PG8_SCHED;
            PG8_LDB(B1, 0, 1); PG8_STAGE(PG8_SB(0, 0), b2, voffB);
            PG8_BAR; PG8_WAIT_L(0); PG8_MMA(0, 1, At, B1); PG8_BAR;
            PG8_LDA(At, 0, 1); PG8_STAGE(PG8_SA(0, 0), a2, voffA);
            PG8_BAR; PG8_WAIT_L(0); PG8_MMA(1, 0, At, B0); PG8_BAR; PG8_SCHED;
            PG8_STAGE(PG8_SB(0, 1), b2 + hstep, voffB);
            PG8_WAIT_V(6); PG8_BAR; PG8_MMA(1, 1, At, B1); PG8_BAR;
            PG8_LDB(B0, 1, 0); PG8_SCHED; PG8_LDA(At, 1, 0); PG8_STAGE(PG8_SA(0, 1), a2 + hstep, voffA);
            PG8_WAIT_L(8); PG8_BAR; PG8_WAIT_L(0); PG8_MMA(0, 0, At, B0); PG8_BAR; PG8_SCHED;
            PG8_LDB(B1, 1, 1); PG8_STAGE(PG8_SB(1, 0), b3, voffB);
            PG8_BAR; PG8_WAIT_L(0); PG8_MMA(0, 1, At, B1); PG8_BAR;
            PG8_LDA(At, 1, 1); PG8_STAGE(PG8_SA(1, 0), a3, voffA);
            PG8_BAR; PG8_WAIT_L(0); PG8_MMA(1, 0, At, B0); PG8_BAR; PG8_SCHED;
            PG8_STAGE(PG8_SB(1, 1), b3 + hstep, voffB);
            PG8_WAIT_V(6); PG8_BAR; PG8_MMA(1, 1, At, B1); PG8_BAR;
            }
        }
        if constexpr (ALIGN_EPI) { if (wr == 0) PG8_BAR; }
        if (cur.second) {
        if (S.dbl) {
#pragma unroll
        for (int a = 0; a < 2; ++a)
#pragma unroll
            for (int b = 0; b < 2; ++b)
#pragma unroll
                for (int m = 0; m < 4; ++m)
#pragma unroll
                    for (int n = 0; n < 2; ++n) acc[a][b][m][n] = acc[a][b][m][n] * 0.5f;
        }
        E(acc, cur, wr, wc, fr, fq);
        if constexpr (Epi::IDEM) { if (EPI_DOUBLE) { asm volatile("" ::: "memory"); E(acc, cur, wr, wc, fr, fq); } }
        }
        if (!has_next) break;
        if (cur.second) {
#pragma unroll
        for (int a = 0; a < 2; ++a)
#pragma unroll
            for (int b = 0; b < 2; ++b)
#pragma unroll
                for (int m = 0; m < 4; ++m)
#pragma unroll
                    for (int n = 0; n < 2; ++n) acc[a][b][m][n] = (f32x4){0.f, 0.f, 0.f, 0.f};
        }
        cur = nxt; cA = nA; cB = nB; ++ui;
        if constexpr (ALIGN_EPI) { if (wr == 1) PG8_BAR; }
    }
    PG8_WAIT_V(0);
    if constexpr (!ALIGN_EPI) { if (wr == 0) PG8_BAR; }
    PG8_BAR;
#undef PG8_SA
#undef PG8_SB
#undef PG8_STAGE
#undef PG8_LDA
#undef PG8_LDB
#undef PG8_MMA
#undef PG8_WAIT_V
#undef PG8_WAIT_L
#undef PG8_BAR
#undef PG8_SCHED
}
}
using pg8::Unit;

struct EpiIn {
    static constexpr bool IDEM = true;
    static constexpr bool MID = false;
    bf16_t* big; const float* qn_a; const float* kn_a; const float* qn_b; const float* kn_b; const f32x2* rope;
    __device__ __forceinline__ void operator()(const f32x4 (&acc)[2][2][4][2], const Unit& u, int wr, int wc, int fr, int fq) const {
        const int hg = u.pn * 4 + wc;
        int kind; bf16_t* dst; int pitch, hcol; const float* gain = nullptr;
        if (hg < 6)       { kind = 1 | 256; dst = big + B_QA; pitch = 384; hcol = hg * 64; gain = qn_a; }
        else if (hg < 12) { kind = 1;       dst = big + B_KA; pitch = 384; hcol = (hg - 6) * 64; gain = kn_a; }
        else if (hg < 18) { kind = 3;       dst = big + B_VAT; pitch = T; hcol = (hg - 12) * 64; }
        else if (hg < 24) { kind = 2 | 256; dst = big + B_QB; pitch = 384; hcol = (hg - 18) * 64; gain = qn_b; }
        else if (hg < 26) { kind = 2;       dst = big + B_KB; pitch = 128; hcol = (hg - 24) * 64; gain = kn_b; }
        else if (hg < 28) { kind = 3;       dst = big + B_VBT; pitch = T; hcol = (hg - 26) * 64; }
        else if (hg < 32) { kind = 0;       dst = big + B_PC; pitch = 256; hcol = (hg - 28) * 64; }
        else              { kind = 4;       dst = big + B_G; pitch = 3072; hcol = (hg - 32) * 64; }
        const int k = kind & 255; const float qs = (kind & 256) ? QSCALE : 1.0f;
        f32x4 gv[2][2];
        if (k == 1 || k == 2) {
#pragma unroll
            for (int bj = 0; bj < 2; ++bj)
#pragma unroll
                for (int n = 0; n < 2; ++n) gv[bj][n] = *(const f32x4*)(gain + 32 * bj + 16 * n + 4 * fq) * qs;
        }
        f32x4 ropeR[2][2], ropeC[4][2];
        const bool do_rope = (k == 2 && u.pm * 256 < TL);
        if (do_rope) {
#pragma unroll
            for (int m = 0; m < 4; ++m) { const int pos = m * 16 + fr; const f32x4* rp = (const f32x4*)(rope + pos * 16 + 4 * fq); ropeC[m][0] = rp[0]; ropeC[m][1] = rp[1]; }
            __builtin_amdgcn_sched_barrier(0);
        }
#pragma unroll
        for (int ai = 0; ai < 2; ++ai) {
            if (do_rope) { const int pos = ((u.pm * 256 + ai * 128 + wr * 64) & (SEQ - 1)) >> 6; const f32x4* rp = (const f32x4*)(rope + pos * 16 + 4 * fq); ropeR[ai][0] = rp[0]; ropeR[ai][1] = rp[1]; }
#pragma unroll
            for (int m = 0; m < 4; ++m) {
                const int row = u.pm * 256 + ai * 128 + wr * 64 + m * 16 + fr;
                f32x4 v[2][2];
#pragma unroll
                for (int bj = 0; bj < 2; ++bj)
#pragma unroll
                    for (int n = 0; n < 2; ++n) v[bj][n] = acc[ai][bj][m][n];
                if (k == 1 || k == 2) {
                    float ss = 0.f;
#pragma unroll
                    for (int bj = 0; bj < 2; ++bj)
#pragma unroll
                        for (int n = 0; n < 2; ++n) { const f32x4 x = v[bj][n]; ss += (x[0] * x[0] + x[1] * x[1]) + (x[2] * x[2] + x[3] * x[3]); }
                    ss += __shfl_xor(ss, 16); ss += __shfl_xor(ss, 32);
                    const float rinv = __builtin_amdgcn_rsqf(ss * (1.0f / 64.0f) + EPS);
#pragma unroll
                    for (int bj = 0; bj < 2; ++bj)
#pragma unroll
                        for (int n = 0; n < 2; ++n) v[bj][n] = v[bj][n] * rinv * gv[bj][n];
                    if (k == 2 && row < TL) {
#pragma unroll
                        for (int bj = 0; bj < 2; ++bj) {
                            const f32x4 q0 = bj ? ropeC[m][0] : ropeR[ai][0], q1 = bj ? ropeC[m][1] : ropeR[ai][1];
                            const float cs[4] = {q0[0], q0[2], q1[0], q1[2]}, sn[4] = {q0[1], q0[3], q1[1], q1[3]};
#pragma unroll
                            for (int j = 0; j < 4; ++j) { const float x1 = v[bj][0][j], x2 = v[bj][1][j];
                                v[bj][0][j] = x1 * cs[j] - x2 * sn[j]; v[bj][1][j] = x2 * cs[j] + x1 * sn[j]; }
                        }
                    }
                } else if (k == 4) {
#pragma unroll
                    for (int bj = 0; bj < 2; ++bj)
#pragma unroll
                        for (int n = 0; n < 2; ++n)
#pragma unroll
                            for (int j = 0; j < 4; ++j) v[bj][n][j] = sigmoidf_(v[bj][n][j]);
                }
                if (k == 3) {
#pragma unroll
                    for (int bj = 0; bj < 2; ++bj)
#pragma unroll
                        for (int n = 0; n < 2; ++n)
#pragma unroll
                            for (int j = 0; j < 4; ++j) dst[(size_t)(hcol + 32 * bj + 16 * n + 4 * fq + j) * T + row] = (bf16_t)f2bf(v[bj][n][j]);
                } else {
                    bf16_t* rp = dst + (size_t)row * pitch + hcol + 4 * fq;
#pragma unroll
                    for (int bj = 0; bj < 2; ++bj)
#pragma unroll
                        for (int n = 0; n < 2; ++n) { u32x2 w; w.x = pk2(v[bj][n][0], v[bj][n][1]); w.y = pk2(v[bj][n][2], v[bj][n][3]); *(u32x2*)(rp + 32 * bj + 16 * n) = w; }
                }
            }
        }
    }
};

struct EpiMerge {
    static constexpr bool IDEM = false;
    static constexpr bool MID = true;
    const bf16_t* G; bf16_t* Mo;
    __device__ __forceinline__ void mid(f32x4 (&acc)[2][2][4][2], const Unit& u, int which, int wr, int wc, int fr, int fq) const {
        const bf16_t* g0 = G + (size_t)(u.pm * 256 + wr * 64 + fr) * 3072 + which * 1024 + u.pn * 256 + 32 * wc + 8 * fq;
#pragma unroll
        for (int ai = 0; ai < 2; ++ai) {
            u32x4 ga[4][2], gb[4][2];
#pragma unroll
            for (int m = 0; m < 4; ++m)
#pragma unroll
                for (int bj = 0; bj < 2; ++bj) { const bf16_t* gp = g0 + (size_t)(ai * 128 + m * 16) * 3072 + 128 * bj; ga[m][bj] = *(const u32x4*)gp; gb[m][bj] = *(const u32x4*)(gp + 1024); }
            __builtin_amdgcn_sched_barrier(0);
#pragma unroll
            for (int m = 0; m < 4; ++m)
#pragma unroll
                for (int bj = 0; bj < 2; ++bj) {
                    const u32x4 a = ga[m][bj], b = gb[m][bj];
#pragma unroll
                    for (int n = 0; n < 2; ++n) {
                        const unsigned a0 = n ? a.z : a.x, a1 = n ? a.w : a.y, b0 = n ? b.z : b.x, b1 = n ? b.w : b.y;
                        acc[ai][bj][m][n][0] *= bflo(a0) * fast_rcp(bflo(b0)); acc[ai][bj][m][n][1] *= bfhi(a0) * fast_rcp(bfhi(b0));
                        acc[ai][bj][m][n][2] *= bflo(a1) * fast_rcp(bflo(b1)); acc[ai][bj][m][n][3] *= bfhi(a1) * fast_rcp(bfhi(b1));
                    }
                }
            __builtin_amdgcn_sched_barrier(0);
        }
    }
    __device__ __forceinline__ void operator()(const f32x4 (&acc)[2][2][4][2], const Unit& u, int wr, int wc, int fr, int fq) const {
        const size_t r0 = (size_t)(u.pm * 256 + wr * 64 + fr); const int c0 = u.pn * 256 + 32 * wc + 8 * fq;
        u32x4 gc[2][4][2];
#pragma unroll
        for (int ai = 0; ai < 2; ++ai)
#pragma unroll
            for (int m = 0; m < 4; ++m)
#pragma unroll
                for (int bj = 0; bj < 2; ++bj) gc[ai][m][bj] = *(const u32x4*)(G + (r0 + ai * 128 + m * 16) * 3072 + 2048 + c0 + 128 * bj);
        __builtin_amdgcn_sched_barrier(0);
#pragma unroll
        for (int ai = 0; ai < 2; ++ai)
#pragma unroll
            for (int m = 0; m < 4; ++m)
#pragma unroll
                for (int bj = 0; bj < 2; ++bj) {
                    const u32x4 c = gc[ai][m][bj];
                    const f32x4 x0 = acc[ai][bj][m][0], x1 = acc[ai][bj][m][1];
                    u32x4 w;
                    w.x = pk2(x0[0] * bflo(c.x), x0[1] * bfhi(c.x)); w.y = pk2(x0[2] * bflo(c.y), x0[3] * bfhi(c.y));
                    w.z = pk2(x1[0] * bflo(c.z), x1[1] * bfhi(c.z)); w.w = pk2(x1[2] * bflo(c.w), x1[3] * bfhi(c.w));
                    *(u32x4*)(Mo + (r0 + ai * 128 + m * 16) * D + c0 + 128 * bj) = w;
                }
    }
};

struct EpiRes {
    static constexpr bool IDEM = false;
    static constexpr bool MID = false;
    const float* xs; float* xd; const float* hs; float* hd; const float* modl; int goff;
    __device__ __forceinline__ void operator()(const f32x4 (&acc)[2][2][4][2], const Unit& u, int wr, int wc, int fr, int fq) const {
        const int row0 = u.pm * 256; const bool lat = row0 < TL;
        const int b = lat ? (row0 >> 11) : 32;
        const float* src = (lat ? xs + (size_t)row0 * D : hs + (size_t)(row0 - TL) * D) + (size_t)(wr * 64 + fr) * D + u.pn * 256 + 32 * wc + 8 * fq;
        float* dst = (lat ? xd + (size_t)row0 * D : hd + (size_t)(row0 - TL) * D) + (size_t)(wr * 64 + fr) * D + u.pn * 256 + 32 * wc + 8 * fq;
        const float* gp = modl + (size_t)b * NMOD + goff + u.pn * 256 + 32 * wc + 8 * fq;
        f32x4 g[2][2];
#pragma unroll
        for (int bj = 0; bj < 2; ++bj) { g[bj][0] = *(const f32x4*)(gp + 128 * bj); g[bj][1] = *(const f32x4*)(gp + 128 * bj + 4); }
        f32x4 s[2][4][2];
#define ER_LOAD(k) do { const int bj_ = (k) >> 1, ai_ = (k) & 1; _Pragma("unroll") for (int m = 0; m < 4; ++m) { const size_t o = (size_t)(ai_ * 128 + m * 16) * D + 128 * bj_; \
            s[(k) & 1][m][0] = *(const f32x4*)(src + o); s[(k) & 1][m][1] = *(const f32x4*)(src + o + 4); } } while (0)
#define ER_STORE(k) do { const int bj_ = (k) >> 1, ai_ = (k) & 1; _Pragma("unroll") for (int m = 0; m < 4; ++m) { const size_t o = (size_t)(ai_ * 128 + m * 16) * D + 128 * bj_; \
            *(f32x4*)(dst + o) = s[(k) & 1][m][0] + g[bj_][0] * acc[ai_][bj_][m][0]; *(f32x4*)(dst + o + 4) = s[(k) & 1][m][1] + g[bj_][1] * acc[ai_][bj_][m][1]; } } while (0)
        ER_LOAD(0); __builtin_amdgcn_sched_barrier(0);
        ER_LOAD(1); __builtin_amdgcn_sched_barrier(0);
        ER_STORE(0); __builtin_amdgcn_sched_barrier(0);
        ER_LOAD(2); __builtin_amdgcn_sched_barrier(0);
        ER_STORE(1); __builtin_amdgcn_sched_barrier(0);
        ER_LOAD(3); __builtin_amdgcn_sched_barrier(0);
        ER_STORE(2); __builtin_amdgcn_sched_barrier(0);
        ER_STORE(3);
#undef ER_LOAD
#undef ER_STORE
    }
};

struct EpiResNorm {
    static constexpr bool IDEM = false;
    static constexpr bool MID = false;
    const float* xs; float* xd; const float* hs; float* hd; const float* modl; int goff;
    const float* ngain; const float* nmod; int nshift; bf16_t* U; float* slots; unsigned* cnt; LAS unsigned char* xl;
    __device__ __forceinline__ void operator()(f32x4 (&acc)[2][2][4][2], const Unit& u, int wr, int wc, int fr, int fq) const {
        const int row0 = u.pm * 256; const bool lat = row0 < TL;
        const int b = lat ? (row0 >> 11) : 32;
        const float* src = (lat ? xs + (size_t)row0 * D : hs + (size_t)(row0 - TL) * D) + (size_t)(wr * 64 + fr) * D + u.pn * 256 + 32 * wc + 8 * fq;
        float* dst = (lat ? xd + (size_t)row0 * D : hd + (size_t)(row0 - TL) * D) + (size_t)(wr * 64 + fr) * D + u.pn * 256 + 32 * wc + 8 * fq;
        const float* gp = modl + (size_t)b * NMOD + goff + u.pn * 256 + 32 * wc + 8 * fq;
        {
        f32x4 g[2][2];
#pragma unroll
        for (int bj = 0; bj < 2; ++bj) { g[bj][0] = *(const f32x4*)(gp + 128 * bj); g[bj][1] = *(const f32x4*)(gp + 128 * bj + 4); }
        f32x4 s[4][2];
#define ER_LOAD(k) do { const int bj_ = (k) >> 1, ai_ = (k) & 1; _Pragma("unroll") for (int m = 0; m < 4; ++m) { const size_t o = (size_t)(ai_ * 128 + m * 16) * D + 128 * bj_; \
            s[m][0] = *(const f32x4*)(src + o); s[m][1] = *(const f32x4*)(src + o + 4); } } while (0)
#define ER_STORE(k) do { const int bj_ = (k) >> 1, ai_ = (k) & 1; _Pragma("unroll") for (int m = 0; m < 4; ++m) { const size_t o = (size_t)(ai_ * 128 + m * 16) * D + 128 * bj_; \
            acc[ai_][bj_][m][0] = s[m][0] + g[bj_][0] * acc[ai_][bj_][m][0]; acc[ai_][bj_][m][1] = s[m][1] + g[bj_][1] * acc[ai_][bj_][m][1]; \
            *(f32x4*)(dst + o) = acc[ai_][bj_][m][0]; *(f32x4*)(dst + o + 4) = acc[ai_][bj_][m][1]; } } while (0)
        ER_LOAD(0); __builtin_amdgcn_sched_barrier(0); ER_STORE(0); __builtin_amdgcn_sched_barrier(0);
        ER_LOAD(1); __builtin_amdgcn_sched_barrier(0); ER_STORE(1); __builtin_amdgcn_sched_barrier(0);
        ER_LOAD(2); __builtin_amdgcn_sched_barrier(0); ER_STORE(2); __builtin_amdgcn_sched_barrier(0);
        ER_LOAD(3); __builtin_amdgcn_sched_barrier(0); ER_STORE(3); __builtin_amdgcn_sched_barrier(0);
#undef ER_LOAD
#undef ER_STORE
        }
        LAS float* P = (LAS float*)xl; LAS float* S = P + 1024;
        const int tid = (wr * 4 + wc) * 64 + fq * 16 + fr;
#pragma unroll
        for (int ai = 0; ai < 2; ++ai)
#pragma unroll
            for (int m = 0; m < 4; ++m) {
                float ss = 0.f;
#pragma unroll
                for (int bj = 0; bj < 2; ++bj)
#pragma unroll
                    for (int n = 0; n < 2; ++n) { const f32x4 x = acc[ai][bj][m][n]; ss += (x[0] * x[0] + x[1] * x[1]) + (x[2] * x[2] + x[3] * x[3]); }
                ss += __shfl_xor(ss, 16); ss += __shfl_xor(ss, 32);
                if (fq == 0) P[(ai * 128 + wr * 64 + m * 16 + fr) * 4 + wc] = ss;
            }
        asm volatile("s_waitcnt lgkmcnt(0)" ::: "memory"); __builtin_amdgcn_s_barrier(); asm volatile("" ::: "memory");
        if (tid < 256) {
            const float tot = (P[tid * 4 + 0] + P[tid * 4 + 1]) + (P[tid * 4 + 2] + P[tid * 4 + 3]);
            __hip_atomic_store(slots + (size_t)(row0 + tid) * 4 + u.pn, tot, __ATOMIC_RELAXED, __HIP_MEMORY_SCOPE_AGENT);
        }
        asm volatile("s_waitcnt vmcnt(0)" ::: "memory");
        if (tid < 256 && (tid & 63) == 0) __hip_atomic_fetch_add(cnt + u.pm, 1u, __ATOMIC_RELAXED, __HIP_MEMORY_SCOPE_AGENT);
        if (tid < 64) {
            unsigned sp = 0;
            while (__hip_atomic_load(cnt + u.pm, __ATOMIC_RELAXED, __HIP_MEMORY_SCOPE_AGENT) < 16u) { __builtin_amdgcn_s_sleep(2); if (++sp > (1u << 22)) break; }
            __builtin_amdgcn_fence(__ATOMIC_ACQUIRE, "agent");
        }
        asm volatile("s_waitcnt vmcnt(0) lgkmcnt(0)" ::: "memory"); __builtin_amdgcn_s_barrier(); asm volatile("" ::: "memory");
        if (tid < 256) {
            const float* sl = slots + (size_t)(row0 + tid) * 4;
            const float t4 = (__hip_atomic_load(sl + 0, __ATOMIC_RELAXED, __HIP_MEMORY_SCOPE_AGENT) + __hip_atomic_load(sl + 1, __ATOMIC_RELAXED, __HIP_MEMORY_SCOPE_AGENT))
                           + (__hip_atomic_load(sl + 2, __ATOMIC_RELAXED, __HIP_MEMORY_SCOPE_AGENT) + __hip_atomic_load(sl + 3, __ATOMIC_RELAXED, __HIP_MEMORY_SCOPE_AGENT));
            S[tid] = __builtin_amdgcn_rsqf(t4 * (1.0f / D) + EPS);
        }
        asm volatile("s_waitcnt lgkmcnt(0)" ::: "memory"); __builtin_amdgcn_s_barrier(); asm volatile("" ::: "memory");
        const float* mp = nmod + (size_t)b * NMOD + nshift + u.pn * 256 + 32 * wc + 8 * fq;
        const float* ng = ngain + u.pn * 256 + 32 * wc + 8 * fq;
        bf16_t* up = U + (size_t)(row0 + wr * 64 + fr) * D + u.pn * 256 + 32 * wc + 8 * fq;
#pragma unroll
        for (int bj = 0; bj < 2; ++bj) {
            const f32x4 sh0 = *(const f32x4*)(mp + 128 * bj), sh1 = *(const f32x4*)(mp + 128 * bj + 4);
            const f32x4 gs0 = *(const f32x4*)(ng + 128 * bj) * (*(const f32x4*)(mp + D + 128 * bj) + 1.0f), gs1 = *(const f32x4*)(ng + 128 * bj + 4) * (*(const f32x4*)(mp + D + 128 * bj + 4) + 1.0f);
#pragma unroll
            for (int ai = 0; ai < 2; ++ai)
#pragma unroll
                for (int m = 0; m < 4; ++m) {
                    const float rstd = S[ai * 128 + wr * 64 + m * 16 + fr];
                    const f32x4 y0 = acc[ai][bj][m][0] * rstd * gs0 + sh0, y1 = acc[ai][bj][m][1] * rstd * gs1 + sh1;
                    u32x4 w; w.x = pk2(y0[0], y0[1]); w.y = pk2(y0[2], y0[3]); w.z = pk2(y1[0], y1[1]); w.w = pk2(y1[2], y1[3]);
                    *(u32x4*)(up + (size_t)(ai * 128 + m * 16) * D + 128 * bj) = w;
                }
        }
    }
};

struct EpiFF1 {
    static constexpr bool IDEM = true;
    static constexpr bool MID = false;
    bf16_t* H1;
    __device__ __forceinline__ void operator()(const f32x4 (&acc)[2][2][4][2], const Unit& u, int wr, int wc, int fr, int fq) const {
        const int col = u.pn * 128 + 32 * wc + 8 * fq;
#pragma unroll
        for (int ai = 0; ai < 2; ++ai)
#pragma unroll
            for (int m = 0; m < 4; ++m) {
                const int row = u.pm * 256 + ai * 128 + wr * 64 + m * 16 + fr;
                float r[8];
#pragma unroll
                for (int n = 0; n < 2; ++n)
#pragma unroll
                    for (int j = 0; j < 4; ++j) { const float a = acc[ai][0][m][n][j], b = acc[ai][1][m][n][j]; r[4 * n + j] = a * sigmoidf_(a) * b; }
                u32x4 w; w.x = pk2(r[0], r[1]); w.y = pk2(r[2], r[3]); w.z = pk2(r[4], r[5]); w.w = pk2(r[6], r[7]);
                *(u32x4*)(H1 + (size_t)row * FF + col) = w;
            }
    }
};

struct EpiMod {
    static constexpr bool IDEM = false;
    static constexpr bool MID = false;
    float* mod; const float* bmod;
    __device__ __forceinline__ void operator()(const f32x4 (&acc)[2][2][4][2], const Unit& u, int wr, int wc, int fr, int fq) const {
        if (wr != 0) return;
#pragma unroll
        for (int m = 0; m < 3; ++m) {
            const int row = m * 16 + fr; if (row >= 33) continue;
#pragma unroll
            for (int bj = 0; bj < 2; ++bj)
#pragma unroll
                for (int n = 0; n < 2; ++n) {
                    const int nn = u.pn * 256 + 128 * bj + 32 * wc + 16 * n + 4 * fq;
                    const int l = nn / NMOD, c = nn - l * NMOD;
                    const f32x4 bv = *(const f32x4*)(bmod + nn);
                    *(f32x4*)(mod + ((size_t)l * 33 + row) * NMOD + c) = acc[0][bj][m][n] + bv;
                }
        }
    }
};

struct Args { const float* in[23]; float* out; unsigned char* ws; float freq[16]; int ph_lo, ph_hi; };
typedef const __attribute__((address_space(4))) Args* KArgsPtr;

__device__ __forceinline__ int p8map(int p) { return (p & 0xe0) | (((p >> 2) & 3) << 3) | (((p >> 4) & 1) << 2) | (p & 3); }
__device__ __forceinline__ void prep_item(KArgsPtr a, unsigned char* ws, int l, int mid, int item, LAS float* scr, int lane) {
    int K, N; if (mid == 0) { K = D; N = NIN; } else if (mid == 1 || mid == 2) { K = D; N = D; } else if (mid == 3) { K = D; N = 2 * FF; } else if (mid == 4) { K = FF; N = D; } else { K = D; N = NMOD; }
    const int nblk = N / 32, kb = item / nblk, nb = item % nblk, k0 = 64 * kb, n0 = 32 * nb;
    const int r = n0 + (lane & 31), tile = r >> 8, p = r & 255;
    const float* src; int ld, col, krow = k0; bf16_t* WT;
    if (mid == 0) { src = a->in[8] + (size_t)l * D * NIN; ld = NIN; col = tile * 256 + ((p >> 5) & 3) * 64 + (p >> 7) * 32 + (p & 31); WT = (bf16_t*)(ws + WS_WIN) + (size_t)l * NIN * D; }
    else if (mid == 1) { ld = D; col = tile * 256 + p8map(p); WT = (bf16_t*)(ws + WS_WBR) + (size_t)l * D * D;
        if (k0 < 384) { src = a->in[16] + (size_t)l * 384 * D; } else if (k0 < 768) { src = a->in[17] + (size_t)l * 384 * D; krow = k0 - 384; } else { src = a->in[18] + (size_t)l * 256 * D; krow = k0 - 768; } }
    else if (mid == 2) { src = a->in[19] + (size_t)l * D * D; ld = D; col = tile * 256 + p8map(p); WT = (bf16_t*)(ws + WS_WOUT) + (size_t)l * D * D; }
    else if (mid == 3) { src = ((p >> 7) ? a->in[21] : a->in[20]) + (size_t)l * D * FF; ld = FF; col = tile * 128 + (p8map(p) & 127); WT = (bf16_t*)(ws + WS_W13) + (size_t)l * 2 * FF * D; }
    else if (mid == 4) { src = a->in[22] + (size_t)l * FF * D; ld = D; col = tile * 256 + p8map(p); WT = (bf16_t*)(ws + WS_W2) + (size_t)l * D * FF; }
    else { src = a->in[4] + (size_t)l * D * NMOD; ld = NMOD; col = r; WT = (bf16_t*)(ws + WS_BIG) + (size_t)l * NMOD * D; }
#pragma unroll 8
    for (int i = 0; i < 32; ++i) { const int kk = 2 * i + (lane >> 5); scr[kk * 33 + (lane & 31)] = src[(size_t)(krow + kk) * ld + col]; }
    asm volatile("s_waitcnt lgkmcnt(0)" ::: "memory");
    const int c = lane & 7;
#pragma unroll
    for (int j = 0; j < 4; ++j) { const int n = (lane >> 3) + 8 * j; const LAS float* s = scr + (8 * c) * 33 + n;
        u32x4 o; o.x = pk2(s[0 * 33], s[1 * 33]); o.y = pk2(s[2 * 33], s[3 * 33]); o.z = pk2(s[4 * 33], s[5 * 33]); o.w = pk2(s[6 * 33], s[7 * 33]);
        *(u32x4*)(WT + (size_t)(n0 + n) * K + k0 + 8 * c) = o; }
    asm volatile("s_waitcnt lgkmcnt(0)" ::: "memory");
}

__device__ __forceinline__ void prep_phase(KArgsPtr a, LAS unsigned char* lds, int tid, int wid, int lane, int bid, int nblk_) {
    unsigned char* ws = a->ws;
    LAS float* scr = (LAS float*)(lds + wid * 8704);
    const int gw = bid * 8 + wid, NGW = nblk_ * 8;
    constexpr int I0 = 16 * 160, I1 = 16 * 32, I2 = 16 * 32, I3 = 16 * 176, I4 = 44 * 32, I5 = 16 * 192, IL = I0 + I1 + I2 + I3 + I4 + I5;
    for (int it = gw; it < IL * DEPTH; it += NGW) {
        const int l = it / IL; int r = it - l * IL; int mid;
        if (r < I0) mid = 0; else if ((r -= I0) < I1) mid = 1; else if ((r -= I1) < I2) mid = 2; else if ((r -= I2) < I3) mid = 3; else if ((r -= I3) < I4) mid = 4; else { r -= I4; mid = 5; }
        prep_item(a, ws, l, mid, r, scr, lane);
    }
    bf16_t* SC = (bf16_t*)(ws + WS_SC);
    for (int i = bid * 512 + tid; i < 256 * 1024; i += nblk_ * 512) {
        const int row = i >> 10, k = i & 1023; float v = 0.f;
        if (row < 32) v = a->in[1][row * D + k]; else if (row == 32) v = a->in[3][k];
        SC[i] = (bf16_t)f2bf(row <= 32 ? v * sigmoidf_(v) : 0.f);
    }
    f32x2* rope = (f32x2*)(ws + WS_ROPE);
    for (int i = bid * 512 + tid; i < 64 * 16; i += nblk_ * 512) {
        const int pos = i >> 4, fi = i & 15;
        const float ang = (float)pos * a->freq[fi];
        float rev = ang * 0.15915494309189535f; rev = rev - floorf(rev);
        rope[i] = (f32x2){__builtin_amdgcn_cosf(rev), __builtin_amdgcn_sinf(rev)};
    }
}

__device__ __forceinline__ void norm_phase(const float* xl, const float* xc, const float* gain, const float* modl, int shift_off, int nrows, bf16_t* U, int wid, int lane, int bid, int nblk_) {
    const int gw = bid * 8 + wid, NGW = nblk_ * 8;
    f32x4 gv[4];
#pragma unroll
    for (int j = 0; j < 4; ++j) gv[j] = *(const f32x4*)(gain + 4 * (lane + 64 * j));
    for (int row0 = gw; row0 < nrows; row0 += 4 * NGW) {
        f32x4 v[4][4]; float ss[4];
#pragma unroll
        for (int r = 0; r < 4; ++r) {
            const int row = row0 + r * NGW; ss[r] = 0.f;
            if (row < nrows) {
                const float* src = row < TL ? xl + (size_t)row * D : xc + (size_t)(row - TL) * D;
#pragma unroll
                for (int j = 0; j < 4; ++j) v[r][j] = *(const f32x4*)(src + 4 * (lane + 64 * j));
            } else {
#pragma unroll
                for (int j = 0; j < 4; ++j) v[r][j] = (f32x4){0.f, 0.f, 0.f, 0.f};
            }
        }
#pragma unroll
        for (int r = 0; r < 4; ++r) {
            const int row = row0 + r * NGW;
            if (row >= nrows) continue;
#pragma unroll
            for (int j = 0; j < 4; ++j) ss[r] += (v[r][j][0] * v[r][j][0] + v[r][j][1] * v[r][j][1]) + (v[r][j][2] * v[r][j][2] + v[r][j][3] * v[r][j][3]);
            const float rstd = __builtin_amdgcn_rsqf(wave_sum(ss[r]) * (1.0f / D) + EPS);
            const int b = row < TL ? (row >> 11) : 32;
            const float* mp = modl + (size_t)b * NMOD + shift_off;
#pragma unroll
            for (int j = 0; j < 4; ++j) {
                const int c = 4 * (lane + 64 * j);
                const f32x4 sh = *(const f32x4*)(mp + c), sc = *(const f32x4*)(mp + D + c);
                const f32x4 y = v[r][j] * rstd * gv[j] * (sc + 1.0f) + sh;
                u32x2 w; w.x = pk2(y[0], y[1]); w.y = pk2(y[2], y[3]);
                *(u32x2*)(U + (size_t)row * D + c) = w;
            }
        }
    }
}

struct AttnJob {
    const bf16_t* Q; int qpitch;
    const bf16_t* K; int kpitch;
    const bf16_t* Vt;
    bf16_t* O;
    int ctx_row0, lat_row0, ntiles;
    int na, r0, rlo;
    int fast;
};
#define MFMA32(a, b, c) __builtin_amdgcn_mfma_f32_32x32x16_bf16((a), (b), (c), 0, 0, 0)

__device__ __forceinline__ void glds16(const void* gsrc, unsigned lds_dst) { unsigned keep;
    asm volatile("s_mov_b32 %0, m0\n\ts_mov_b32 m0, %2\n\ts_nop 0\n\tglobal_load_lds_dwordx4 %1, off\n\ts_mov_b32 m0, %0" : "=&s"(keep) : "v"(gsrc), "s"(lds_dst) : "memory"); }
template <bool FAST>
__device__ __forceinline__ void att_scores(const LAS unsigned char* kb_, const bf16x8 (&qf)[4], int pi, int kx, int hi, bool local, const LAS float* bp, unsigned vmask, bool first,
                                           float& mrun, f32x16& o0, f32x16& o1, float& lrun, bf16x8 (&pf)[2][2]) {
    constexpr float THR = 8.0f;
    f32x16 s0, s1;
    if constexpr (FAST) {
#pragma unroll
        for (int i = 0; i < 16; ++i) { s0[i] = 0.f; s1[i] = 0.f; }
    } else {
        const float nm = -mrun;
#pragma unroll
        for (int i = 0; i < 16; ++i) { s0[i] = nm; s1[i] = nm; }
    }
    {
        bf16x8 a0[4], a1[4];
#pragma unroll
        for (int ks = 0; ks < 4; ++ks) { a0[ks] = *(const LAS bf16x8*)(kb_ + pi * 128 + (((2 * ks + hi) ^ kx) << 4)); a1[ks] = *(const LAS bf16x8*)(kb_ + (32 + pi) * 128 + (((2 * ks + hi) ^ kx) << 4)); }
        __builtin_amdgcn_sched_barrier(0);
#pragma unroll
        for (int ks = 0; ks < 4; ++ks) s0 = MFMA32(a0[ks], qf[ks], s0);
#pragma unroll
        for (int ks = 0; ks < 4; ++ks) s1 = MFMA32(a1[ks], qf[ks], s1);
    }
    if (local) {
#pragma unroll
        for (int i = 0; i < 16; ++i) {
            const float b0 = bp[16 * (i >> 3) + (i & 7)], b1 = bp[32 + 16 * (i >> 3) + (i & 7)];
            const unsigned m0 = (unsigned)__builtin_amdgcn_sbfe((int)vmask, i, 1), m1 = (unsigned)__builtin_amdgcn_sbfe((int)vmask, 16 + i, 1);
            const unsigned v0 = __builtin_bit_cast(unsigned, s0[i] + b0), v1 = __builtin_bit_cast(unsigned, s1[i] + b1);
            s0[i] = __builtin_bit_cast(float, (v0 & m0) | (0xf149f2cau & ~m0));
            s1[i] = __builtin_bit_cast(float, (v1 & m1) | (0xf149f2cau & ~m1));
            if ((i & 3) == 3) __builtin_amdgcn_sched_barrier(0);
        }
    }
    if constexpr (!FAST) {
    float mt = fmaxf(s0[0], s1[0]);
#pragma unroll
    for (int i = 1; i < 16; ++i) mt = fmaxf(mt, fmaxf(s0[i], s1[i]));
    mt = fmaxf(mt, __shfl_xor(mt, 32));
    if (first || __any(mt > THR)) {
        const float delta = first ? mt : (mt > THR ? mt : 0.f);
        const float alpha = first ? 1.0f : fast_exp2(-delta);
        mrun += delta;
#pragma unroll
        for (int i = 0; i < 16; ++i) { s0[i] -= delta; s1[i] -= delta; o0[i] *= alpha; o1[i] *= alpha; }
        lrun *= alpha;
    }
    }
    float rs = 0.f;
#pragma unroll
    for (int i = 0; i < 16; ++i) { s0[i] = fast_exp2(s0[i]); s1[i] = fast_exp2(s1[i]); rs += s0[i] + s1[i]; }
    lrun += rs;
#pragma unroll
    for (int cc = 0; cc < 2; ++cc) {
        u32x4 w0, w1;
        w0.x = pk2(s0[8 * cc + 0], s0[8 * cc + 1]); w0.y = pk2(s0[8 * cc + 2], s0[8 * cc + 3]); w0.z = pk2(s0[8 * cc + 4], s0[8 * cc + 5]); w0.w = pk2(s0[8 * cc + 6], s0[8 * cc + 7]);
        w1.x = pk2(s1[8 * cc + 0], s1[8 * cc + 1]); w1.y = pk2(s1[8 * cc + 2], s1[8 * cc + 3]); w1.z = pk2(s1[8 * cc + 4], s1[8 * cc + 5]); w1.w = pk2(s1[8 * cc + 6], s1[8 * cc + 7]);
        pf[0][cc] = __builtin_bit_cast(bf16x8, w0); pf[1][cc] = __builtin_bit_cast(bf16x8, w1);
    }
}
__device__ __forceinline__ void att_pv(const LAS unsigned char* vb_, int q, int vx, int hi, const bf16x8 (&pf)[2][2], f32x16& o0, f32x16& o1) {
#pragma unroll
    for (int kb = 0; kb < 2; ++kb) {
        bf16x8 v0[2], v1[2];
#pragma unroll
        for (int cc = 0; cc < 2; ++cc) { const int ch = 4 * kb + 2 * cc + hi;
            v0[cc] = *(const LAS bf16x8*)(vb_ + q * 128 + ((ch ^ vx) << 4)); v1[cc] = *(const LAS bf16x8*)(vb_ + (32 + q) * 128 + ((ch ^ vx) << 4)); }
        __builtin_amdgcn_sched_barrier(0);
#pragma unroll
        for (int cc = 0; cc < 2; ++cc) { o0 = MFMA32(v0[cc], pf[kb][cc], o0); o1 = MFMA32(v1[cc], pf[kb][cc], o1); }
        __builtin_amdgcn_sched_barrier(0);
    }
}

__device__ __forceinline__ void att_tile_fast(const LAS unsigned char* kb_, const LAS unsigned char* vb_, const bf16x8 (&qf)[4], int pi, int kx, int q, int vx, int hi,
                                              f32x16& o0, f32x16& o1, float& lrun) {
    bf16x8 a0[4], a1[4];
#pragma unroll
    for (int ks = 0; ks < 4; ++ks) { a0[ks] = *(const LAS bf16x8*)(kb_ + pi * 128 + (((2 * ks + hi) ^ kx) << 4)); a1[ks] = *(const LAS bf16x8*)(kb_ + (32 + pi) * 128 + (((2 * ks + hi) ^ kx) << 4)); }
    __builtin_amdgcn_sched_barrier(0);
    f32x16 s0, s1;
#pragma unroll
    for (int i = 0; i < 16; ++i) { s0[i] = 0.f; s1[i] = 0.f; }
#pragma unroll
    for (int ks = 0; ks < 4; ++ks) s0 = MFMA32(a0[ks], qf[ks], s0);
    __builtin_amdgcn_sched_barrier(0);
    float rs = 0.f;
#pragma unroll
    for (int ks = 0; ks < 4; ++ks) {
        s1 = MFMA32(a1[ks], qf[ks], s1);
#pragma unroll
        for (int i = 4 * ks; i < 4 * ks + 4; ++i) { s0[i] = fast_exp2(s0[i]); rs += s0[i]; }
        __builtin_amdgcn_sched_barrier(0);
    }
    bf16x8 p0[2];
#pragma unroll
    for (int cc = 0; cc < 2; ++cc) { u32x4 w; w.x = pk2(s0[8 * cc + 0], s0[8 * cc + 1]); w.y = pk2(s0[8 * cc + 2], s0[8 * cc + 3]); w.z = pk2(s0[8 * cc + 4], s0[8 * cc + 5]); w.w = pk2(s0[8 * cc + 6], s0[8 * cc + 7]); p0[cc] = __builtin_bit_cast(bf16x8, w); }
    bf16x8 va0[2], va1[2];
#pragma unroll
    for (int cc = 0; cc < 2; ++cc) { const int ch = 2 * cc + hi; va0[cc] = *(const LAS bf16x8*)(vb_ + q * 128 + ((ch ^ vx) << 4)); va1[cc] = *(const LAS bf16x8*)(vb_ + (32 + q) * 128 + ((ch ^ vx) << 4)); }
    __builtin_amdgcn_sched_barrier(0);
#pragma unroll
    for (int g = 0; g < 4; ++g) {
        if (g & 1) o1 = MFMA32(va1[g >> 1], p0[g >> 1], o1); else o0 = MFMA32(va0[g >> 1], p0[g >> 1], o0);
#pragma unroll
        for (int i = 4 * g; i < 4 * g + 4; ++i) { s1[i] = fast_exp2(s1[i]); rs += s1[i]; }
        __builtin_amdgcn_sched_barrier(0);
    }
    bf16x8 vb0[2], vb1[2];
#pragma unroll
    for (int cc = 0; cc < 2; ++cc) { const int ch = 4 + 2 * cc + hi; vb0[cc] = *(const LAS bf16x8*)(vb_ + q * 128 + ((ch ^ vx) << 4)); vb1[cc] = *(const LAS bf16x8*)(vb_ + (32 + q) * 128 + ((ch ^ vx) << 4)); }
    bf16x8 p1[2];
#pragma unroll
    for (int cc = 0; cc < 2; ++cc) { u32x4 w; w.x = pk2(s1[8 * cc + 0], s1[8 * cc + 1]); w.y = pk2(s1[8 * cc + 2], s1[8 * cc + 3]); w.z = pk2(s1[8 * cc + 4], s1[8 * cc + 5]); w.w = pk2(s1[8 * cc + 6], s1[8 * cc + 7]); p1[cc] = __builtin_bit_cast(bf16x8, w); }
#pragma unroll
    for (int cc = 0; cc < 2; ++cc) { o0 = MFMA32(vb0[cc], p1[cc], o0); o1 = MFMA32(vb1[cc], p1[cc], o1); }
    lrun += rs;
}

__device__ __forceinline__ void attn_unit(LAS unsigned char* lds, const AttnJob& J, const LAS float* biasL, int tid, int wid, int lane) {
    const int q = lane & 31, hi = lane >> 5;
    bf16x8 qf[4];
    f32x16 o0, o1; float lrun = 0.f;
#pragma unroll
    for (int i = 0; i < 16; ++i) { o0[i] = 0.f; o1[i] = 0.f; }
    float mrun = 0.f;
    bf16x8 pf[2][2];
#pragma unroll
    for (int a = 0; a < 2; ++a)
#pragma unroll
        for (int b = 0; b < 2; ++b) pf[a][b] = (bf16x8){0, 0, 0, 0, 0, 0, 0, 0};
    const int srow = tid >> 3;
    const int gch = (tid & 7) ^ ((srow >> 1) & 7);
    const int pi = (q & 0x13) | ((q & 4) << 1) | ((q & 8) >> 1);
    const int kx = (pi >> 1) & 7, vx = (q >> 1) & 7;
    const int rq = J.r0 + (wid >> 1), cq = (wid & 1) * 32 + q;
    const int rs_ = min(max(rq - 4, 0), 24), cs_ = min(max(cq - 8, 0), 48);
    unsigned vmask = 0u;
    if (J.na) {
#pragma unroll
        for (int i = 0; i < 32; ++i) { const int kc = 32 * (i >> 4) + 16 * ((i >> 3) & 1) + 8 * hi + (i & 7); vmask |= ((unsigned)(kc - cs_) < 16u ? 1u : 0u) << i; }
    }
    const int blane = 8 * hi - cq + 15 + 48;
    const bool fast = J.fast != 0;
    const bf16_t* kg = J.K + (size_t)srow * J.kpitch + gch * 8;
    const bf16_t* vg = J.Vt + (size_t)srow * T + gch * 8;
    const unsigned ldsw0 = (unsigned)(unsigned long long)lds + (unsigned)wid * 1024u;
#define ATT_ISSUE(tile, vslot) do { const int t_ = (tile); const int tk_ = t_ < 4 ? J.ctx_row0 + 64 * t_ : J.lat_row0 + 64 * (t_ - 4); \
        glds16(kg + (size_t)tk_ * J.kpitch, (unsigned)__builtin_amdgcn_readfirstlane((int)(ldsw0 + (t_ & 3) * 8192))); \
        glds16(vg + tk_, (unsigned)__builtin_amdgcn_readfirstlane((int)(ldsw0 + 32768 + (vslot) * 8192))); } while (0)
    ATT_ISSUE(0, 0); ATT_ISSUE(1, 1); ATT_ISSUE(2, 2);
    { const bf16_t* qrow = J.Q + (size_t)(wid * 32 + q) * J.qpitch + 8 * hi;
#pragma unroll
      for (int ks = 0; ks < 4; ++ks) qf[ks] = *(const bf16x8*)(qrow + 16 * ks); }
    asm volatile("s_waitcnt vmcnt(0) lgkmcnt(0)" :: "v"(qf[0]), "v"(qf[1]), "v"(qf[2]), "v"(qf[3]) : "memory");
    __builtin_amdgcn_s_barrier(); asm volatile("" ::: "memory");
    int vcur = 0, vprev = 4;
    for (int it = 0; it < J.ntiles; ++it) {
        const LAS unsigned char* kb_ = lds + (it & 3) * 8192;
        const int vnext = vcur == 4 ? 0 : vcur + 1;
        if (it + 3 < J.ntiles) { const int v3 = vcur + 3 >= 5 ? vcur - 2 : vcur + 3; ATT_ISSUE(it + 3, v3); }
        const int kr = J.rlo + it - 4;
        const bool local = J.na && it >= 4;
        const bool active = !local || (kr >= rs_ && kr < rs_ + 8);
        const LAS float* bp = biasL + (kr - rq + 7) * 128 + blane;
        if (active) {
            if (fast && !local) att_tile_fast(kb_, lds + 32768 + vcur * 8192, qf, pi, kx, q, vx, hi, o0, o1, lrun);
            else {
                if (fast) att_scores<true>(kb_, qf, pi, kx, hi, local, bp, vmask, it == 0, mrun, o0, o1, lrun, pf); else att_scores<false>(kb_, qf, pi, kx, hi, local, bp, vmask, it == 0, mrun, o0, o1, lrun, pf);
                att_pv(lds + 32768 + vcur * 8192, q, vx, hi, pf, o0, o1);
            }
        }
        const int ny = J.ntiles - (it + 2);
        if (ny >= 2) asm volatile("s_waitcnt vmcnt(4)" ::: "memory"); else if (ny == 1) asm volatile("s_waitcnt vmcnt(2)" ::: "memory"); else asm volatile("s_waitcnt vmcnt(0)" ::: "memory");
        __builtin_amdgcn_s_barrier(); asm volatile("" ::: "memory");
        vprev = vcur; vcur = vnext;
    }
#undef ATT_ISSUE
    const float inv = fast_rcp(lrun + __shfl_xor(lrun, 32));
    bf16_t* orow = J.O + (size_t)(wid * 32 + q) * D + 4 * hi;
#pragma unroll
    for (int c = 0; c < 4; ++c) {
        u32x2 w0, w1;
        w0.x = pk2(o0[4 * c] * inv, o0[4 * c + 1] * inv); w0.y = pk2(o0[4 * c + 2] * inv, o0[4 * c + 3] * inv);
        w1.x = pk2(o1[4 * c] * inv, o1[4 * c + 1] * inv); w1.y = pk2(o1[4 * c + 2] * inv, o1[4 * c + 3] * inv);
        *(u32x2*)(orow + 8 * c) = w0; *(u32x2*)(orow + 32 + 8 * c) = w1;
    }
}

__device__ __forceinline__ void pool_unit(LAS unsigned char* lds, const bf16_t* PC, const float* wpool, const float* pscale, bf16_t* Y, int unit, int tid) {
    const int row0 = unit * 64;
    const int seq0 = row0 < TL ? (row0 & ~(SEQ - 1)) : TL + ((row0 - TL) & ~(LCTX - 1));
    const int N = row0 < TL ? SEQ : LCTX;
    const int t0 = row0 - seq0;
    LAS unsigned short* vin = (LAS unsigned short*)lds;
    constexpr int PP = 264;
    LAS unsigned short* pooled = (LAS unsigned short*)(lds + 40960);
    for (int i = tid; i < 80 * 32; i += 512) {
        const int lr = i >> 5, ch8 = i & 31, t = t0 - 8 + lr;
        u32x4 v = (u32x4){0u, 0u, 0u, 0u};
        if (t >= 0 && t < N) v = *(const u32x4*)(PC + (size_t)(seq0 + t) * 256 + ch8 * 8);
        *(LAS u32x4*)(lds + (lr * 256 + ch8 * 8) * 2) = v;
    }
    __syncthreads();
    {
        const int ch = tid & 255, th = tid >> 8, g = ch >> 6, hw = 1 << g;
        const LAS unsigned short* vp = vin + (th * 32 + 8) * 256 + ch;
        float s = 0.f;
        for (int k = -hw; k < hw; ++k) s += bf2f(vp[k * 256]);
#pragma unroll 8
        for (int i = 0; i < 32; ++i) {
            const int tl = th * 32 + i, t = t0 + tl;
            const int lo = max(t - hw, 0), hi2 = min(t + hw, N);
            pooled[tl * PP + ch] = (unsigned short)f2bf(s * fast_rcp((float)(hi2 - lo)) - bf2f(vp[i * 256]));
            s += bf2f(vp[(i + hw) * 256]) - bf2f(vp[(i - hw) * 256]);
        }
    }
    __syncthreads();
    {
        const int lane = tid & 63, wid = tid >> 6, g = wid & 3, th = wid >> 2, q = lane & 31, hi = lane >> 5;
        const float* wg = wpool + (size_t)g * 64 * 64;
        bf16x8 af[4];
#pragma unroll
        for (int ks = 0; ks < 4; ++ks) af[ks] = *(const LAS bf16x8*)(pooled + (th * 32 + q) * PP + g * 64 + 16 * ks + 8 * hi);
#pragma unroll
        for (int db = 0; db < 2; ++db) {
            f32x16 dacc;
#pragma unroll
            for (int i = 0; i < 16; ++i) dacc[i] = 0.f;
#pragma unroll
            for (int ks = 0; ks < 4; ++ks) {
                const float* wp = wg + (size_t)(16 * ks + 8 * hi) * 64 + 32 * db + q;
                u32x4 w; w.x = pk2(wp[0], wp[64]); w.y = pk2(wp[128], wp[192]); w.z = pk2(wp[256], wp[320]); w.w = pk2(wp[384], wp[448]);
                dacc = MFMA32(af[ks], __builtin_bit_cast(bf16x8, w), dacc);
            }
            const int col = g * 64 + 32 * db + q;
            const float sc = pscale[col];
#pragma unroll
            for (int r = 0; r < 16; ++r) { const int tok = 8 * (r >> 2) + 4 * hi + (r & 3);
                Y[(size_t)(row0 + th * 32 + tok) * D + 768 + col] = (bf16_t)f2bf(dacc[r] * sc); }
        }
    }
    __syncthreads();
}

__device__ __forceinline__ void mixer_phase(KArgsPtr a, int l, bool lastl, LAS unsigned char* lds, unsigned* ctr, int tid_) {
    unsigned char* ws = a->ws;
    const bf16_t* big = (const bf16_t*)(ws + WS_BIG);
    bf16_t* Y = (bf16_t*)(ws + WS_U);
    constexpr int NG = NB * 6 * 8, NN = NB * 6 * 8, NCA = NB * 6, NCB = NB * 6;
    const int ncx = lastl ? 0 : NCA + NCB;
    const int npool = (lastl ? TL : T) / 64;
    const int total0 = NG + NN + ncx + npool;
    const int total = total0 + (MIX_DUP == 1 ? NG : MIX_DUP == 2 ? NN : MIX_DUP == 3 ? npool : 0);
    LAS int* shu = (LAS int*)(lds + LDS_MISC);
    LAS float* biasL = (LAS float*)(lds + 73728);
    int fastA, fastB, fastN;
    { const int ln = tid_ & 63;
      float qa = fabsf(a->in[9][l * 64 + ln]), ka = fabsf(a->in[10][l * 64 + ln]), qb = fabsf(a->in[11][l * 64 + ln]), kb = fabsf(a->in[12][l * 64 + ln]), bm = 0.f;
      for (int i = ln; i < 6 * 465; i += 64) bm = fmaxf(bm, fabsf(a->in[13][(size_t)l * 6 * 465 + i]));
#pragma unroll
      for (int o = 1; o < 64; o <<= 1) { qa = fmaxf(qa, __shfl_xor(qa, o)); ka = fmaxf(ka, __shfl_xor(ka, o)); qb = fmaxf(qb, __shfl_xor(qb, o)); kb = fmaxf(kb, __shfl_xor(kb, o)); bm = fmaxf(bm, __shfl_xor(bm, o)); }
      fastA = __builtin_amdgcn_readfirstlane((int)(11.5416f * qa * ka < 60.f));
      fastB = __builtin_amdgcn_readfirstlane((int)(11.5416f * qb * kb < 60.f));
      fastN = __builtin_amdgcn_readfirstlane((int)(11.5416f * qa * ka + bm * LOG2E < 60.f)); }
    if (tid_ == 0) shu[0] = (int)atomicAdd(ctr, 1u);
    __syncthreads();
    int u = __builtin_amdgcn_readfirstlane(shu[0]);
    for (int uit = 0;; ++uit) {
        int tid = tid_; asm volatile("" : "+v"(tid));
        const int lane = tid & 63, wid = __builtin_amdgcn_readfirstlane(tid >> 6);
        if (u >= total) break;
        if (u >= total0) u = u - total0 + (MIX_DUP == 2 ? NG : MIX_DUP == 3 ? NG + NN + ncx : 0);
        int nxt_ = 0; if (tid == 0) nxt_ = (int)atomicAdd(ctr, 1u);
        if (u < NG + NN + ncx) {
            AttnJob J;
            if (u < NG) {
                const int qb = u & 7, hq = (u >> 3) % 6, b = u / 48, hkv = hq / 3;
                J.Q = big + B_QB + (size_t)(b * SEQ + qb * 256) * 384 + hq * 64; J.qpitch = 384;
                J.K = big + B_KB + hkv * 64; J.kpitch = 128; J.Vt = big + B_VBT + (size_t)(hkv * 64) * T;
                J.O = Y + (size_t)(b * SEQ + qb * 256) * D + 384 + hq * 64;
                J.ctx_row0 = TL + b * LCTX; J.lat_row0 = b * SEQ; J.ntiles = 4 + 32; J.na = 0; J.r0 = 0; J.rlo = 0;
                J.fast = fastB;
            } else if ((u -= NG) < NN) {
                const int rg = u & 7, h = (u >> 3) % 6, b = u / 48, r0 = rg * 4;
                const int rlo = min(max(r0 - 4, 0), 24), rhi = min(max(r0 + 3 - 4, 0), 24) + 8;
                const float* rpb = a->in[13] + ((size_t)l * 6 + h) * 15 * 31;
                for (int i = tid; i < 15 * 128; i += 512) { const int dc = (i & 127) - 48; biasL[i] = (dc >= 0 && dc < 31) ? rpb[(i >> 7) * 31 + dc] * LOG2E : 0.f; }
                J.Q = big + B_QA + (size_t)(b * SEQ + r0 * 64) * 384 + h * 64; J.qpitch = 384;
                J.K = big + B_KA + h * 64; J.kpitch = 384; J.Vt = big + B_VAT + (size_t)(h * 64) * T;
                J.O = Y + (size_t)(b * SEQ + r0 * 64) * D + h * 64;
                J.ctx_row0 = TL + b * LCTX; J.lat_row0 = b * SEQ + rlo * 64; J.ntiles = 4 + (rhi - rlo); J.na = 1; J.r0 = r0; J.rlo = rlo;
                J.fast = fastN;
            } else {
                u -= NN;
                const bool second = u >= NCA; if (second) u -= NCA;
                const int h = u % 6, b = u / 6;
                if (!second) { J.Q = big + B_QA + (size_t)(TL + b * LCTX) * 384 + h * 64; J.K = big + B_KA + h * 64; J.kpitch = 384; J.Vt = big + B_VAT + (size_t)(h * 64) * T; J.O = Y + (size_t)(TL + b * LCTX) * D + h * 64; }
                else { const int hkv = h / 3; J.Q = big + B_QB + (size_t)(TL + b * LCTX) * 384 + h * 64; J.K = big + B_KB + hkv * 64; J.kpitch = 128; J.Vt = big + B_VBT + (size_t)(hkv * 64) * T; J.O = Y + (size_t)(TL + b * LCTX) * D + 384 + h * 64; }
                J.qpitch = 384; J.ctx_row0 = TL + b * LCTX; J.lat_row0 = 0; J.ntiles = 4; J.na = 0; J.r0 = 0; J.rlo = 0;
                J.fast = second ? fastB : fastA;
            }
            attn_unit(lds, J, biasL, tid, wid, lane);
        } else {
            u -= NG + NN + ncx;
            pool_unit(lds, big + B_PC, a->in[14] + (size_t)l * 4 * 64 * 64, a->in[15] + (size_t)l * 256, Y, u, tid);
        }
        if (tid == 0) shu[(uit + 1) & 1] = nxt_;
        __syncthreads();
        u = __builtin_amdgcn_readfirstlane(shu[(uit + 1) & 1]);
    }
}


#define XB_TMO      128
#define XB_XCNT(j)  (256  + 64 * (j))
#define XB_XSUB(j)  (1280 + 64 * (j))
#define XB_XGEN(j)  (2304 + 64 * (j))
#define XB_TOP      3328
#define XB_TOPGEN   3392
#define XB_SPIN_CAP (1u << 22)
constexpr int CW_BAR = 4096;
__device__ __forceinline__ unsigned xb_ld(unsigned* p)              { return __hip_atomic_load(p, __ATOMIC_RELAXED, __HIP_MEMORY_SCOPE_AGENT); }
__device__ __forceinline__ unsigned xb_add(unsigned* p, unsigned v) { return __hip_atomic_fetch_add(p, v, __ATOMIC_RELAXED, __HIP_MEMORY_SCOPE_AGENT); }
__device__ __forceinline__ unsigned xb_xcc_id() { return (unsigned)__builtin_amdgcn_s_getreg((3 << 11) | 20) & 0xFu; }
#define XB_SPIN(cond, bar) do { unsigned _sp = 0; while (cond) { __builtin_amdgcn_s_sleep(1); \
    if ((++_sp & 255u) == 0u) { if (xb_ld(&(bar)[XB_TMO])) break; if (_sp > XB_SPIN_CAP) { atomicAdd(&(bar)[XB_TMO], 1u); break; } } } } while (0)
__device__ __forceinline__ void xcd_barrier_complete(unsigned* bar, unsigned x, unsigned& nloc, unsigned& nx) {
    const unsigned G = gridDim.x * gridDim.y * gridDim.z;
    unsigned sum, cnt, mine, sp = 0u;
    for (;;) {
        sum = 0u; cnt = 0u; mine = 0u;
#pragma unroll
        for (unsigned j = 0; j < 16; ++j) { const unsigned c = xb_ld(&bar[XB_XCNT(j)]); sum += c; cnt += (c > 0u) ? 1u : 0u; mine = (j == x) ? c : mine; }
        if (sum == G) break;
        __builtin_amdgcn_s_sleep(1);
        if ((++sp & 255u) == 0u) { if (xb_ld(&bar[XB_TMO])) break; if (sp > XB_SPIN_CAP) { atomicAdd(&bar[XB_TMO], 1u); break; } }
    }
    nloc = mine > 0u ? mine : 1u; nx = cnt > 0u ? cnt : 1u;
}
__device__ __forceinline__ void xcd_barrier(unsigned* bar, volatile LAS unsigned* st) {
    asm volatile("s_waitcnt vmcnt(0)" ::: "memory");
    __syncthreads();
    if (threadIdx.x == 0) {
        const unsigned x = xb_xcc_id();
        __builtin_amdgcn_s_waitcnt(0);
        unsigned nloc = st[0], nx = st[1];
        if (nloc == 0u) { xcd_barrier_complete(bar, x, nloc, nx); st[0] = nloc; st[1] = nx; }
        const unsigned old = xb_add(&bar[XB_XSUB(x)], 1u);
        const unsigned gen = old / nloc;
        if (old + 1u == (gen + 1u) * nloc) {
            __builtin_amdgcn_fence(__ATOMIC_RELEASE, "agent");
            asm volatile("s_waitcnt vmcnt(0)" ::: "memory");
            const unsigned og = xb_add(&bar[XB_TOP], 1u);
            const unsigned tg = og / nx;
            if (og + 1u == (tg + 1u) * nx) xb_add(&bar[XB_TOPGEN], 1u);
            else XB_SPIN(xb_ld(&bar[XB_TOPGEN]) == tg, bar);
            __builtin_amdgcn_fence(__ATOMIC_ACQUIRE, "agent");
            xb_add(&bar[XB_XGEN(x)], 1u);
            asm volatile("s_waitcnt vmcnt(0)" ::: "memory");
        } else {
            XB_SPIN(xb_ld(&bar[XB_XGEN(x)]) == gen, bar);
            __builtin_amdgcn_fence(__ATOMIC_ACQUIRE, "agent");
            asm volatile("s_waitcnt vmcnt(0)" ::: "memory");
        }
    }
    __syncthreads();
}

__device__ __forceinline__ KArgsPtr fresh_args() {
    KArgsPtr p = (KArgsPtr)__builtin_amdgcn_kernarg_segment_ptr();
    asm volatile("" : "+s"(p) :: "memory");
    return p;
}
#define IN(k) (lo <= (k) && (k) < hi)
#define SEAM(k) do { if ((k) + 1 < hi) { if (lo < 0) { __threadfence(); cg::this_grid().sync(); } else xcd_barrier((unsigned*)(a_.ws + WS_CTL) + CW_BAR, (volatile LAS unsigned*)(lds + LDS_MISC + 16)); } } while (0)
#define PH_COMMON KArgsPtr a = fresh_args(); unsigned char* ws = a->ws; int tid = threadIdx.x; asm volatile("" : "+v"(tid)); const int lane = tid & 63, wid = __builtin_amdgcn_readfirstlane(tid >> 6); \
    int G = __builtin_amdgcn_readfirstlane((int)gridDim.x), c = __builtin_amdgcn_readfirstlane((int)blockIdx.x); \
    bf16_t* U = (bf16_t*)(ws + WS_U); bf16_t* BIG = (bf16_t*)(ws + WS_BIG); float* modall = (float*)(ws + WS_MOD); float* hbuf = (float*)(ws + WS_H); float* xout = a->out; \
    const bool lastl = (l == DEPTH - 1); const float* modl = modall + (size_t)l * 33 * NMOD; const float* xs = l == 0 ? a->in[0] : xout; const float* hs = l == 0 ? a->in[2] : hbuf; const int M = lastl ? TL : T; \
    (void)tid; (void)lane; (void)wid; (void)G; (void)c; (void)U; (void)BIG; (void)hbuf; (void)modl; (void)xs; (void)hs; (void)M; (void)lastl; (void)xout;
__global__ void __launch_bounds__(512, 2) mega_fwd(Args a_) {
    extern __shared__ __attribute__((aligned(16))) unsigned char lds_raw[];
    LAS unsigned char* lds = (LAS unsigned char*)lds_raw;
    const int lo = a_.ph_lo, hi = a_.ph_hi;
    if (threadIdx.x == 0) { ((volatile LAS unsigned*)(lds + LDS_MISC + 16))[0] = 0u; ((volatile LAS unsigned*)(lds + LDS_MISC + 16))[1] = 0u;
        (void)xb_add((unsigned*)(a_.ws + WS_CTL) + CW_BAR + XB_XCNT(xb_xcc_id()), 1u); }
    __syncthreads();
    if (IN(0)) { const int l = 0; PH_COMMON prep_phase(a, lds, tid, wid, lane, c, G);
#if PREP_DOUBLE
        xcd_barrier((unsigned*)(a_.ws + WS_CTL) + CW_BAR, (volatile LAS unsigned*)(lds + LDS_MISC + 16)); prep_phase(a, lds, tid, wid, lane, c, G);
#endif
        SEAM(0); }
    if (IN(1)) { const int l = 0; PH_COMMON
        pg8::Gemm g{(const bf16_t*)(ws + WS_SC), (const bf16_t*)(ws + WS_BIG), 256, DEPTH * NMOD, D};
        pg8::StaticOrder S; S.init(256, DEPTH * NMOD, G, c);
        EpiMod E{modall, a->in[5]};
        pg8::gemm_phase<EpiMod, pg8::StaticOrder, false, true>(lds, g, S, E, tid);
        SEAM(1);
    }
#pragma unroll 1
    for (int l = 0; l < DEPTH; ++l) {
        const int pb = 2 + 8 * l;
        if (IN(pb + 0) && l == 0) { for (int rep_ = 0; rep_ < ((REP_MASK >> 0) & 1) + 1; ++rep_) { if (rep_) { xcd_barrier((unsigned*)(a_.ws + WS_CTL) + CW_BAR, (volatile LAS unsigned*)(lds + LDS_MISC + 16)); } PH_COMMON norm_phase(xs, hs, a->in[6] + l * D, modl, 0, T, U, wid, lane, c, G); } SEAM(pb + 0); }
        if (IN(pb + 1)) { for (int rep_ = 0; rep_ < ((REP_MASK >> 1) & 1) + 1; ++rep_) { if (rep_) { xcd_barrier((unsigned*)(a_.ws + WS_CTL) + CW_BAR, (volatile LAS unsigned*)(lds + LDS_MISC + 16)); } PH_COMMON
            pg8::Gemm g{U, (const bf16_t*)(ws + WS_WIN) + (size_t)l * NIN * D, T, NIN, D};
            pg8::StaticOrder S; S.init(lastl ? TL : T, NIN, G, c); if (lastl) S.xtra = (TC / 256) * 5;
            EpiIn E{BIG, a->in[9] + l * 64, a->in[10] + l * 64, a->in[11] + l * 64, a->in[12] + l * 64, (const f32x2*)(ws + WS_ROPE)};
            pg8::gemm_phase<EpiIn, pg8::StaticOrder, true, true>(lds, g, S, E, tid, ((c >> 3) & 3) * STG_K1024);
            } SEAM(pb + 1);
        }
        if (IN(pb + 2)) { for (int rep_ = 0; rep_ < ((REP_MASK >> 2) & 1) + 1; ++rep_) { if (rep_) { xcd_barrier((unsigned*)(a_.ws + WS_CTL) + CW_BAR, (volatile LAS unsigned*)(lds + LDS_MISC + 16)); } PH_COMMON mixer_phase(a, l, lastl, lds, (unsigned*)(ws + WS_CTL) + 64 * (1 + l + 8 * rep_), tid); } SEAM(pb + 2); }
        if (IN(pb + 3)) { for (int rep_ = 0; rep_ < ((REP_MASK >> 3) & 1) + 1; ++rep_) { if (rep_) { xcd_barrier((unsigned*)(a_.ws + WS_CTL) + CW_BAR, (volatile LAS unsigned*)(lds + LDS_MISC + 16)); } PH_COMMON
            pg8::Gemm g{U, (const bf16_t*)(ws + WS_WBR) + (size_t)l * D * D, M, D, D};
            pg8::StaticOrder S; S.init(M, D, G, c);
            S.dbl = 0; EpiMerge E{BIG + B_G, BIG};
            pg8::gemm_phase<EpiMerge, pg8::StaticOrder, true, true>(lds, g, S, E, tid, ((c >> 3) & 3) * STG_K1024);
            } SEAM(pb + 3);
        }
        if (IN(pb + 4)) { PH_COMMON
            pg8::Gemm g{BIG, (const bf16_t*)(ws + WS_WOUT) + (size_t)l * D * D, M, D, D};
            pg8::PanelOrder S; S.init(M, G, c);
            EpiResNorm E{xs, xout, hs, hbuf, modl, 2 * D, a->in[7] + l * D, modl, 3 * D, U, (float*)(ws + WS_SLOTS), (unsigned*)(ws + WS_CTL + CTL_PANEL) + (l * 2 + 0) * 512, lds + LDS_XCH};
            pg8::gemm_phase<EpiResNorm, pg8::PanelOrder, true, true>(lds, g, S, E, tid);
            SEAM(pb + 4);
        }
        if (IN(pb + 6)) { for (int rep_ = 0; rep_ < ((REP_MASK >> 6) & 1) + 1; ++rep_) { if (rep_) { xcd_barrier((unsigned*)(a_.ws + WS_CTL) + CW_BAR, (volatile LAS unsigned*)(lds + LDS_MISC + 16)); } PH_COMMON
            pg8::Gemm g{U, (const bf16_t*)(ws + WS_W13) + (size_t)l * 2 * FF * D, M, 2 * FF, D};
            pg8::StaticOrder S; S.init(M, 2 * FF, G, c);
            EpiFF1 E{BIG};
            pg8::gemm_phase<EpiFF1, pg8::StaticOrder, true, true>(lds, g, S, E, tid, ((c >> 3) & 3) * STG_K1024);
            } SEAM(pb + 6);
        }
        if (IN(pb + 7)) { PH_COMMON
            pg8::Gemm g{BIG, (const bf16_t*)(ws + WS_W2) + (size_t)l * D * FF, M, D, FF};
            if (lastl) {
                pg8::StaticOrder S; S.init(M, D, G, c);
                EpiRes E{xout, xout, hbuf, hbuf, modl, 5 * D};
                pg8::gemm_phase<EpiRes, pg8::StaticOrder, true, true>(lds, g, S, E, tid, ((c >> 3) & 3) * STG_K2816);
            } else {
                pg8::PanelOrder S; S.init(M, G, c);
                EpiResNorm E{xout, xout, hbuf, hbuf, modl, 5 * D, a->in[6] + (l + 1) * D, modall + (size_t)(l + 1) * 33 * NMOD, 0, U, (float*)(ws + WS_SLOTS), (unsigned*)(ws + WS_CTL + CTL_PANEL) + (l * 2 + 1) * 512, lds + LDS_XCH};
                pg8::gemm_phase<EpiResNorm, pg8::PanelOrder, true, true>(lds, g, S, E, tid);
            }
            SEAM(pb + 7);
        }
    }
}
#undef IN
#undef SEAM

extern "C" void kernel_launch(void* const* d_in, const int* in_sizes, int n_in, void* d_out, int out_size, void* d_ws, size_t ws_size, hipStream_t stream) {
    static int grid = 0;
    if (grid == 0) {
        if (n_in != 23 || out_size != TL * D || ws_size < WS_END2) { fprintf(stderr, "kernel_launch: unexpected shapes (n_in %d out %d ws %zu need %zu)\n", n_in, out_size, ws_size, (size_t)WS_END2); grid = -1; return; }
        int dev = 0, cus = 0, per_cu = 0;
        hipGetDevice(&dev); hipDeviceGetAttribute(&cus, hipDeviceAttributeMultiprocessorCount, dev);
        if (hipFuncSetAttribute((const void*)mega_fwd, hipFuncAttributeMaxDynamicSharedMemorySize, LDS_BYTES) != hipSuccess) { fprintf(stderr, "kernel_launch: hipFuncSetAttribute failed\n"); grid = -1; return; }
        if (hipOccupancyMaxActiveBlocksPerMultiprocessor(&per_cu, (const void*)mega_fwd, 512, LDS_BYTES) != hipSuccess || per_cu < 1) { fprintf(stderr, "kernel_launch: occupancy query gave %d\n", per_cu); per_cu = 1; }
        (void)hipGetLastError();
        grid = cus;
        fprintf(stderr, "kernel_launch: cus %d per_cu %d grid %d ws %zu\n", cus, per_cu, grid, ws_size);
    }
    if (grid < 0) return;
    hipMemsetAsync((char*)d_ws + WS_CTL, 0, CTL_BYTES, stream);
    Args a{};
    for (int i = 0; i < 23; ++i) a.in[i] = (const float*)d_in[i];
    a.out = (float*)d_out; a.ws = (unsigned char*)d_ws;
    for (int i = 0; i < 16; ++i) a.freq[i] = (float)pow(10000.0, -(double)i / 16.0);
#if MK_PER_PHASE
    for (int ph = 0; ph < NPH; ++ph) { a.ph_lo = ph; a.ph_hi = ph + 1; hipLaunchKernelGGL(mega_fwd, dim3(grid), dim3(512), LDS_BYTES, stream, a); }
#else
    a.ph_lo = 0; a.ph_hi = NPH;
    void* args[] = {&a};
    hipError_t e = hipLaunchCooperativeKernel((const void*)mega_fwd, dim3(grid), dim3(512), args, LDS_BYTES, stream);
    if (e != hipSuccess) fprintf(stderr, "kernel_launch: cooperative launch failed: %s (grid %d)\n", hipGetErrorString(e), grid);
#endif
}
```

```cpp
#include <hip/hip_runtime.h>
#include <hip/hip_cooperative_groups.h>
#include <cstdio>
#include <cstdint>
#include <cmath>
namespace cg = cooperative_groups;

#ifndef REP_MASK
#define REP_MASK 0
#endif
#ifndef EPI_DOUBLE
#define EPI_DOUBLE 0
#endif
#ifndef PREP_DOUBLE
#define PREP_DOUBLE 0
#endif
#ifndef MIX_DUP
#define MIX_DUP 0
#endif
#ifndef GEMM_DOUBLE
#define GEMM_DOUBLE 0
#endif
#ifndef STG_K1024
#define STG_K1024 0
#define STG_K2816 0
#endif
#ifndef MK_PER_PHASE
#define MK_PER_PHASE 0
#endif

#define LAS __attribute__((address_space(3)))
typedef unsigned short bf16_t;
typedef short bf16x8 __attribute__((ext_vector_type(8)));
typedef float f32x4 __attribute__((ext_vector_type(4)));
typedef float f32x2 __attribute__((ext_vector_type(2)));
typedef float f32x16 __attribute__((ext_vector_type(16)));
typedef unsigned u32x4 __attribute__((ext_vector_type(4)));
typedef unsigned u32x2 __attribute__((ext_vector_type(2)));

constexpr int D = 1024, NB = 32, SEQ = 2048, DEPTH = 4, LCTX = 256, GW = 64;
constexpr int TL = NB * SEQ, TC = NB * LCTX, T = TL + TC;
constexpr int NIN = 5120, FF = 2816, NMOD = 6144;
constexpr float EPS = 1e-6f;
constexpr float LOG2E = 1.4426950408889634f;
constexpr float QSCALE = 0.125f * LOG2E;
constexpr int NPH = 2 + 8 * DEPTH;

constexpr size_t WS_CTL = 0, CTL_BYTES = 65536;
constexpr size_t WS_ROPE = WS_CTL + CTL_BYTES;
constexpr size_t WS_MOD = WS_ROPE + 8192;
constexpr size_t WS_SC = WS_MOD + (size_t)DEPTH * 33 * NMOD * 4;
constexpr size_t WS_H = WS_SC + 256 * 1024 * 2;
constexpr size_t WS_WIN = WS_H + (size_t)TC * D * 4;
constexpr size_t WS_WBR = WS_WIN + (size_t)DEPTH * NIN * D * 2;
constexpr size_t WS_WOUT = WS_WBR + (size_t)DEPTH * D * D * 2;
constexpr size_t WS_W13 = WS_WOUT + (size_t)DEPTH * D * D * 2;
constexpr size_t WS_W2 = WS_W13 + (size_t)DEPTH * 2 * FF * D * 2;
constexpr size_t WS_U = WS_W2 + (size_t)DEPTH * D * FF * 2;
constexpr size_t WS_BIG = WS_U + (size_t)T * D * 2;
constexpr size_t WS_END = WS_BIG + (size_t)T * NIN * 2;
constexpr size_t WS_SLOTS = WS_END;
constexpr size_t WS_END2 = WS_SLOTS + (size_t)T * 4 * 4;
static_assert(WS_END2 <= (size_t)1073741824, "workspace map exceeds 1 GiB");
constexpr size_t CTL_PANEL = 32768;
constexpr size_t B_QA = 0, B_KA = B_QA + (size_t)T * 384, B_VAT = B_KA + (size_t)T * 384, B_QB = B_VAT + (size_t)T * 384, B_KB = B_QB + (size_t)T * 384,
                 B_VBT = B_KB + (size_t)T * 128, B_PC = B_VBT + (size_t)T * 128, B_G = B_PC + (size_t)T * 256;
static_assert(B_G == (size_t)T * 2048, "BIG layout");

constexpr int LDS_BYTES = 131072 + 1024 + 6144;
constexpr int LDS_XCH = 131072 + 1024;
constexpr int LDS_MISC = 131072;

__device__ __forceinline__ unsigned f2bf(float f) { unsigned u = __builtin_bit_cast(unsigned, f); return (u + 0x7fffu + ((u >> 16) & 1u)) >> 16; }
typedef __bf16 hwbf2 __attribute__((ext_vector_type(2)));
__device__ __forceinline__ unsigned pk2(float lo, float hi) { const f32x2 v = {lo, hi}; const hwbf2 b = __builtin_convertvector(v, hwbf2); return __builtin_bit_cast(unsigned, b); }
__device__ __forceinline__ float bf2f(unsigned short h) { return __builtin_bit_cast(float, (unsigned)h << 16); }
__device__ __forceinline__ float bflo(unsigned w) { return __builtin_bit_cast(float, w << 16); }
__device__ __forceinline__ float bfhi(unsigned w) { return __builtin_bit_cast(float, w & 0xffff0000u); }
__device__ __forceinline__ float wave_sum(float v) {
#pragma unroll
    for (int o = 1; o < 64; o <<= 1) v += __shfl_xor(v, o);
    return v;
}
__device__ __forceinline__ float fast_exp2(float x) { return __builtin_amdgcn_exp2f(x); }
__device__ __forceinline__ float fast_rcp(float x) { return __builtin_amdgcn_rcpf(x); }
__device__ __forceinline__ float sigmoidf_(float x) { return fast_rcp(1.0f + fast_exp2(x * -LOG2E)); }

namespace pg8 {
constexpr int BM = 256, BK = 64, HALF = 128, HTB = HALF * BK * 2, NXCD = 8, WGM = 8;
__host__ __device__ __forceinline__ int lds_byte(int r, int c) { const int st = (r >> 4) * 2 + (c >> 5), rr = r & 15, cc = c & 31, ob = rr * 64 + cc * 2; return st * 1024 + (ob ^ (((ob >> 9) & 1) << 5)); }
__host__ __device__ __forceinline__ void stage_rc(int b, int& R, int& C) { const int st = b / 1024, sb = b % 1024, swz = sb ^ (((sb >> 9) & 1) << 5); R = (st >> 1) * 16 + swz / 64; C = (st & 1) * 32 + (swz % 64) / 2; }

struct Unit { int pm, pn, second; };
struct Gemm { const bf16_t* A; const bf16_t* Bt; int M, N, K; };

struct StaticOrder {
    int nM, nN, nwg, G, c, dbl, xtra, rev;
    __device__ void init(int M, int N, int G_, int c_) { nM = M / BM; nN = N / BM; nwg = nM * nN; G = G_; c = c_; dbl = GEMM_DOUBLE; xtra = 0; rev = 0; }
    __device__ bool next(int i, Unit& u) const {
        const long L = (long)(dbl ? (i >> 1) : i) * G + c; u.second = dbl ? (i & 1) : 1;
        if (L >= nwg) { const int k = (int)(L - nwg); if (k >= xtra) return false; const int t = k % 5; u.pm = nM + k / 5; u.pn = t < 4 ? t + 1 : 6; return true; }
        int wgid = (int)L; { const int q = nwg / NXCD, r = nwg % NXCD, xcd = wgid % NXCD; int off = wgid / NXCD; if (rev) off = (xcd < r ? q : q - 1) - off; wgid = (xcd < r ? xcd * (q + 1) : r * (q + 1) + (xcd - r) * q) + off; }
        const int nig = WGM * nN, gid = wgid / nig, fm = gid * WGM, gsz = (nM - fm) < WGM ? (nM - fm) : WGM;
        u.pm = fm + ((wgid % nig) % gsz); u.pn = (wgid % nig) / gsz; return true;
    }
};

struct PanelOrder {
    int nM, G, c, dbl, rev;
    __device__ void init(int M, int G_, int c_) { nM = M / BM; G = G_; c = c_; dbl = 0; rev = 0; }
    __device__ bool next(int i, Unit& u) const {
        if (G < 256 || c >= 256) { if (G >= 256) return false; const long L = (long)i * (G & ~3) + c; if (c >= (G & ~3) || L >= (long)nM * 4) return false; u.pm = (int)(L >> 2); u.pn = (int)(L & 3); u.second = 1; return true; }
        if (rev && (nM & 7) == 0) {
            const int per = nM >> 3, k = 8 * i + (c >> 5); if (k >= per) return false;
            u.pm = (c & 7) * per + per - 1 - k; u.pn = (c >> 3) & 3; u.second = 1; return true;
        }
        const int pm = i * 64 + (c & 7) * 8 + (c >> 5); if (pm >= nM) return false;
        u.pm = pm; u.pn = (c >> 3) & 3; u.second = 1; return true;
    }
};

template <class Epi, class Sched, bool ALIGN_EPI = false, bool SP2 = false>
__device__ __forceinline__ void gemm_phase(LAS unsigned char* lds, const Gemm g, const Sched& S, const Epi& E, const int tid, const int stagger_ticks = 0) {
    const int wid = __builtin_amdgcn_readfirstlane(tid >> 6), lane = tid & 63, wr = wid >> 2, wc = wid & 3, fr = lane & 15, fq = lane >> 4;
    const int K = g.K, nt = K / BK;
    unsigned voffA[2], voffB[2];
#pragma unroll
    for (int i = 0; i < 2; ++i) { int R, C; stage_rc(tid * 16 + i * 8192, R, C); voffA[i] = (unsigned)(R * K + C) * 2u; voffB[i] = (unsigned)(R * K + C) * 2u; }
    const size_t kstep = (size_t)(BK * 2);
    const size_t hstep = (size_t)HALF * K * 2;
    const size_t tstep = 2 * hstep;
    const unsigned ldsw = (unsigned)wid * 1024u;
    const int aoff = lds_byte(wr * 64 + fr, fq * 8), boff = lds_byte(wc * 32 + fr, fq * 8);
#define PG8_SA(b, h) (((b) * 2 + (h)) * HTB)
#define PG8_SB(b, h) ((4 + (b) * 2 + (h)) * HTB)
#define PG8_STAGE(bufoff, gbase, voff) do { _Pragma("unroll") for (int _i = 0; _i < 2; ++_i) \
        __builtin_amdgcn_global_load_lds((const unsigned*)((const char*)(gbase) + (voff)[_i]), (LAS unsigned*)(lds + (bufoff) + ldsw + _i * 8192), 16, 0, 0); } while (0)
#define PG8_LDA(dst, b, h) do { _Pragma("unroll") for (int m = 0; m < 4; ++m) _Pragma("unroll") for (int k = 0; k < 2; ++k) dst[m][k] = *(const LAS bf16x8*)(lds + PG8_SA(b, h) + aoff + m * 2048 + k * 1024); } while (0)
#define PG8_LDB(dst, b, h) do { _Pragma("unroll") for (int n = 0; n < 2; ++n) _Pragma("unroll") for (int k = 0; k < 2; ++k) dst[n][k] = *(const LAS bf16x8*)(lds + PG8_SB(b, h) + boff + n * 2048 + k * 1024); } while (0)
#define PG8_MMA(ai, bj, At, Bt) do { __builtin_amdgcn_s_setprio(1); _Pragma("unroll") for (int m = 0; m < 4; ++m) _Pragma("unroll") for (int n = 0; n < 2; ++n) _Pragma("unroll") for (int k = 0; k < 2; ++k) \
        acc[ai][bj][m][n] = __builtin_amdgcn_mfma_f32_16x16x32_bf16(Bt[n][k], At[m][k], acc[ai][bj][m][n], 0, 0, 0); __builtin_amdgcn_s_setprio(0); } while (0)
#define PG8_WAIT_V(n) asm volatile("s_waitcnt vmcnt(" #n ")" ::: "memory")
#define PG8_WAIT_L(n) asm volatile("s_waitcnt lgkmcnt(" #n ")" ::: "memory")
#define PG8_BAR __builtin_amdgcn_s_barrier()
#define PG8_SCHED __builtin_amdgcn_sched_barrier(0)
    Unit cur, nxt; int ui = 0;
    if (!S.next(0, cur)) return;
    if (stagger_ticks > 0) {
        const unsigned long long t0 = __builtin_amdgcn_s_memrealtime();
        while ((long long)(__builtin_amdgcn_s_memrealtime() - t0) < (long long)stagger_ticks) __builtin_amdgcn_s_sleep(16);
    }
    f32x4 acc[2][2][4][2];
#pragma unroll
    for (int a = 0; a < 2; ++a)
#pragma unroll
        for (int b = 0; b < 2; ++b)
#pragma unroll
            for (int m = 0; m < 4; ++m)
#pragma unroll
                for (int n = 0; n < 2; ++n) acc[a][b][m][n] = (f32x4){0.f, 0.f, 0.f, 0.f};
    bf16x8 At[4][2], B0[2][2], B1[2][2];
    const char* cA = (const char*)g.A + (size_t)cur.pm * tstep; const char* cB = (const char*)g.Bt + (size_t)cur.pn * tstep;
    if constexpr (SP2) {
        PG8_STAGE(PG8_SB(0, 0), cB, voffB); PG8_STAGE(PG8_SB(0, 1), cB + hstep, voffB); PG8_STAGE(PG8_SA(0, 0), cA, voffA); PG8_STAGE(PG8_SA(0, 1), cA + hstep, voffA);
        if (wr == 1) PG8_BAR;
        PG8_WAIT_V(2); PG8_BAR;
        PG8_STAGE(PG8_SB(1, 0), cB + kstep, voffB); PG8_STAGE(PG8_SA(1, 0), cA + kstep, voffA); PG8_STAGE(PG8_SB(1, 1), cB + hstep + kstep, voffB);
        PG8_WAIT_V(6); PG8_BAR;
    } else {
        PG8_STAGE(PG8_SB(0, 0), cB, voffB); PG8_STAGE(PG8_SA(0, 0), cA, voffA); PG8_STAGE(PG8_SB(0, 1), cB + hstep, voffB); PG8_STAGE(PG8_SA(0, 1), cA + hstep, voffA);
        if (wr == 1) PG8_BAR;
        PG8_WAIT_V(4); PG8_BAR;
        PG8_STAGE(PG8_SB(1, 0), cB + kstep, voffB); PG8_STAGE(PG8_SA(1, 0), cA + kstep, voffA); PG8_STAGE(PG8_SB(1, 1), cB + hstep + kstep, voffB);
        PG8_WAIT_V(6); PG8_BAR;
    }
    for (;;) {
        const bool has_next = S.next(ui + 1, nxt);
        const char* nA = has_next ? (const char*)g.A + (size_t)nxt.pm * tstep : cA; const char* nB = has_next ? (const char*)g.Bt + (size_t)nxt.pn * tstep : cB;
        for (int t = 0; t < nt; t += 2) {
            if constexpr (Epi::MID) { if (t == 6 || t == 12) E.mid(acc, cur, t == 6 ? 0 : 1, wr, wc, fr, fq); }
            const bool last = (t == nt - 2);
            const char* a1 = cA + (size_t)(t + 1) * kstep;
            const char* a2 = last ? nA : cA + (size_t)(t + 2) * kstep; const char* b2 = last ? nB : cB + (size_t)(t + 2) * kstep;
            const char* a3 = a2 + kstep; const char* b3 = b2 + kstep;
            if constexpr (SP2) {
            PG8_LDB(B0, 0, 0); PG8_LDB(B1, 0, 1); PG8_SCHED; PG8_LDA(At, 0, 0); PG8_STAGE(PG8_SA(1, 1), a1 + hstep, voffA);
            PG8_WAIT_V(8); PG8_WAIT_L(0); PG8_BAR; PG8_MMA(0, 0, At, B0); PG8_MMA(0, 1, At, B1); PG8_BAR; PG8_SCHED;
            PG8_LDA(At, 0, 1); PG8_STAGE(PG8_SB(0, 0), b2, voffB); PG8_STAGE(PG8_SB(0, 1), b2 + hstep, voffB); PG8_STAGE(PG8_SA(0, 0), a2, voffA);
            PG8_WAIT_V(8); PG8_WAIT_L(0); PG8_BAR; PG8_MMA(1, 0, At, B0); PG8_MMA(1, 1, At, B1); PG8_BAR; PG8_SCHED;
            PG8_LDB(B0, 1, 0); PG8_LDB(B1, 1, 1); PG8_SCHED; PG8_LDA(At, 1, 0); PG8_STAGE(PG8_SA(0, 1), a2 + hstep, voffA);
            PG8_WAIT_V(8); PG8_WAIT_L(0); PG8_BAR; PG8_MMA(0, 0, At, B0); PG8_MMA(0, 1, At, B1); PG8_BAR; PG8_SCHED;
            PG8_LDA(At, 1, 1); PG8_STAGE(PG8_SB(1, 0), b3, voffB); PG8_STAGE(PG8_SB(1, 1), b3 + hstep, voffB); PG8_STAGE(PG8_SA(1, 0), a3, voffA);
            PG8_WAIT_V(8); PG8_WAIT_L(0); PG8_BAR; PG8_MMA(1, 0, At, B0); PG8_MMA(1, 1, At, B1); PG8_BAR; PG8_SCHED;
            } else {
            PG8_LDB(B0, 0, 0); PG8_SCHED; PG8_LDA(At, 0, 0); PG8_STAGE(PG8_SA(1, 1), a1 + hstep, voffA);
            PG8_WAIT_L(8); PG8_BAR; PG8_WAIT_L(0); PG8_MMA(0, 0, At, B0); PG8_BAR; PG8_SCHED;
            PG8_LDB(B1, 0, 1); PG8_STAGE(PG8_SB(0, 0), b2, voffB);
            PG8_BAR; PG8_WAIT_L(0); PG8_MMA(0, 1, At, B1); PG8_BAR;
            PG8_LDA(At, 0, 1); PG8_STAGE(PG8_SA(0, 0), a2, voffA);
            PG8_BAR; PG8_WAIT_L(0); PG8_MMA(1, 0, At, B0); PG8_BAR; PG8_SCHED;
            PG8_STAGE(PG8_SB(0, 1), b2 + hstep, voffB);
            PG8_WAIT_V(6); PG8_BAR; PG8_MMA(1, 1, At, B1); PG8_BAR;
            PG8_LDB(B0, 1, 0); PG8_SCHED; PG8_LDA(At, 1, 0); PG8_STAGE(PG8_SA(0, 1), a2 + hstep, voffA);
            PG8_WAIT_L(8); PG8_BAR; PG8_WAIT_L(0); PG8_MMA(0, 0, At, B0); PG8_BAR; PG8_SCHED;
            PG8_LDB(B1, 1, 1); PG8_STAGE(PG8_SB(1, 0), b3, voffB);
            PG8_BAR; PG8_WAIT_L(0); PG8_MMA(0, 1, At, B1); PG8_BAR;
            PG8_LDA(At, 1, 1); PG8_STAGE(PG8_SA(1, 0), a3, voffA);
            PG8_BAR; PG8_WAIT_L(0); PG8_MMA(1, 0, At, B0); PG8_BAR; PG8_SCHED;
            PG8_STAGE(PG8_SB(1, 1), b3 + hstep, voffB);
            PG8_WAIT_V(6); PG8_BAR; PG8_MMA(1, 1, At, B1); PG8_BAR;
            }
        }
        if constexpr (ALIGN_EPI) { if (wr == 0) PG8_BAR; }
        if (cur.second) {
        if (S.dbl) {
#pragma unroll
        for (int a = 0; a < 2; ++a)
#pragma unroll
            for (int b = 0; b < 2; ++b)
#pragma unroll
                for (int m = 0; m < 4; ++m)
#pragma unroll
                    for (int n = 0; n < 2; ++n) acc[a][b][m][n] = acc[a][b][m][n] * 0.5f;
        }
        E(acc, cur, wr, wc, fr, fq);
        if constexpr (Epi::IDEM) { if (EPI_DOUBLE) { asm volatile("" ::: "memory"); E(acc, cur, wr, wc, fr, fq); } }
        }
        if (!has_next) break;
        if (cur.second) {
#pragma unroll
        for (int a = 0; a < 2; ++a)
#pragma unroll
            for (int b = 0; b < 2; ++b)
#pragma unroll
                for (int m = 0; m < 4; ++m)
#pragma unroll
                    for (int n = 0; n < 2; ++n) acc[a][b][m][n] = (f32x4){0.f, 0.f, 0.f, 0.f};
        }
        cur = nxt; cA = nA; cB = nB; ++ui;
        if constexpr (ALIGN_EPI) { if (wr == 1) PG8_BAR; }
    }
    PG8_WAIT_V(0);
    if constexpr (!ALIGN_EPI) { if (wr == 0) PG8_BAR; }
    PG8_BAR;
#undef PG8_SA
#undef PG8_SB
#undef PG8_STAGE
#undef PG8_LDA
#undef PG8_LDB
#undef PG8_MMA
#undef PG8_WAIT_V
#undef PG8_WAIT_L
#undef PG8_BAR
#undef PG8_SCHED
}
}
using pg8::Unit;

struct EpiIn {
    static constexpr bool IDEM = true;
    static constexpr bool MID = false;
    bf16_t* big; const float* qn_a; const float* kn_a; const float* qn_b; const float* kn_b; const f32x2* rope;
    __device__ __forceinline__ void operator()(const f32x4 (&acc)[2][2][4][2], const Unit& u, int wr, int wc, int fr, int fq) const {
        const int hg = u.pn * 4 + wc;
        int kind; bf16_t* dst; int pitch, hcol; const float* gain = nullptr;
        if (hg < 6)       { kind = 1 | 256; dst = big + B_QA; pitch = 384; hcol = hg * 64; gain = qn_a; }
        else if (hg < 12) { kind = 1;       dst = big + B_KA; pitch = 384; hcol = (hg - 6) * 64; gain = kn_a; }
        else if (hg < 18) { kind = 3;       dst = big + B_VAT; pitch = T; hcol = (hg - 12) * 64; }
        else if (hg < 24) { kind = 2 | 256; dst = big + B_QB; pitch = 384; hcol = (hg - 18) * 64; gain = qn_b; }
        else if (hg < 26) { kind = 2;       dst = big + B_KB; pitch = 128; hcol = (hg - 24) * 64; gain = kn_b; }
        else if (hg < 28) { kind = 3;       dst = big + B_VBT; pitch = T; hcol = (hg - 26) * 64; }
        else if (hg < 32) { kind = 0;       dst = big + B_PC; pitch = 256; hcol = (hg - 28) * 64; }
        else              { kind = 4;       dst = big + B_G; pitch = 3072; hcol = (hg - 32) * 64; }
        const int k = kind & 255; const float qs = (kind & 256) ? QSCALE : 1.0f;
        f32x4 gv[2][2];
        if (k == 1 || k == 2) {
#pragma unroll
            for (int bj = 0; bj < 2; ++bj)
#pragma unroll
                for (int n = 0; n < 2; ++n) gv[bj][n] = *(const f32x4*)(gain + 32 * bj + 16 * n + 4 * fq) * qs;
        }
        f32x4 ropeR[2][2], ropeC[4][2];
        const bool do_rope = (k == 2 && u.pm * 256 < TL);
        if (do_rope) {
#pragma unroll
            for (int m = 0; m < 4; ++m) { const int pos = m * 16 + fr; const f32x4* rp = (const f32x4*)(rope + pos * 16 + 4 * fq); ropeC[m][0] = rp[0]; ropeC[m][1] = rp[1]; }
            __builtin_amdgcn_sched_barrier(0);
        }
#pragma unroll
        for (int ai = 0; ai < 2; ++ai) {
            if (do_rope) { const int pos = ((u.pm * 256 + ai * 128 + wr * 64) & (SEQ - 1)) >> 6; const f32x4* rp = (const f32x4*)(rope + pos * 16 + 4 * fq); ropeR[ai][0] = rp[0]; ropeR[ai][1] = rp[1]; }
#pragma unroll
            for (int m = 0; m < 4; ++m) {
                const int row = u.pm * 256 + ai * 128 + wr * 64 + m * 16 + fr;
                f32x4 v[2][2];
#pragma unroll
                for (int bj = 0; bj < 2; ++bj)
#pragma unroll
                    for (int n = 0; n < 2; ++n) v[bj][n] = acc[ai][bj][m][n];
                if (k == 1 || k == 2) {
                    float ss = 0.f;
#pragma unroll
                    for (int bj = 0; bj < 2; ++bj)
#pragma unroll
                        for (int n = 0; n < 2; ++n) { const f32x4 x = v[bj][n]; ss += (x[0] * x[0] + x[1] * x[1]) + (x[2] * x[2] + x[3] * x[3]); }
                    ss += __shfl_xor(ss, 16); ss += __shfl_xor(ss, 32);
                    const float rinv = __builtin_amdgcn_rsqf(ss * (1.0f / 64.0f) + EPS);
#pragma unroll
                    for (int bj = 0; bj < 2; ++bj)
#pragma unroll
                        for (int n = 0; n < 2; ++n) v[bj][n] = v[bj][n] * rinv * gv[bj][n];
                    if (k == 2 && row < TL) {
#pragma unroll
                        for (int bj = 0; bj < 2; ++bj) {
                            const f32x4 q0 = bj ? ropeC[m][0] : ropeR[ai][0], q1 = bj ? ropeC[m][1] : ropeR[ai][1];
                            const float cs[4] = {q0[0], q0[2], q1[0], q1[2]}, sn[4] = {q0[1], q0[3], q1[1], q1[3]};
#pragma unroll
                            for (int j = 0; j < 4; ++j) { const float x1 = v[bj][0][j], x2 = v[bj][1][j];
                                v[bj][0][j] = x1 * cs[j] - x2 * sn[j]; v[bj][1][j] = x2 * cs[j] + x1 * sn[j]; }
                        }
                    }
                } else if (k == 4) {
#pragma unroll
                    for (int bj = 0; bj < 2; ++bj)
#pragma unroll
                        for (int n = 0; n < 2; ++n)
#pragma unroll
                            for (int j = 0; j < 4; ++j) v[bj][n][j] = sigmoidf_(v[bj][n][j]);
                }
                if (k == 3) {
#pragma unroll
                    for (int bj = 0; bj < 2; ++bj)
#pragma unroll
                        for (int n = 0; n < 2; ++n)
#pragma unroll
                            for (int j = 0; j < 4; ++j) dst[(size_t)(hcol + 32 * bj + 16 * n + 4 * fq + j) * T + row] = (bf16_t)f2bf(v[bj][n][j]);
                } else {
                    bf16_t* rp = dst + (size_t)row * pitch + hcol + 4 * fq;
#pragma unroll
                    for (int bj = 0; bj < 2; ++bj)
#pragma unroll
                        for (int n = 0; n < 2; ++n) { u32x2 w; w.x = pk2(v[bj][n][0], v[bj][n][1]); w.y = pk2(v[bj][n][2], v[bj][n][3]); *(u32x2*)(rp + 32 * bj + 16 * n) = w; }
                }
            }
        }
    }
};

struct EpiMerge {
    static constexpr bool IDEM = false;
    static constexpr bool MID = true;
    const bf16_t* G; bf16_t* Mo;
    __device__ __forceinline__ void mid(f32x4 (&acc)[2][2][4][2], const Unit& u, int which, int wr, int wc, int fr, int fq) const {
        const bf16_t* g0 = G + (size_t)(u.pm * 256 + wr * 64 + fr) * 3072 + which * 1024 + u.pn * 256 + 32 * wc + 8 * fq;
#pragma unroll
        for (int ai = 0; ai < 2; ++ai) {
            u32x4 ga[4][2], gb[4][2];
#pragma unroll
            for (int m = 0; m < 4; ++m)
#pragma unroll
                for (int bj = 0; bj < 2; ++bj) { const bf16_t* gp = g0 + (size_t)(ai * 128 + m * 16) * 3072 + 128 * bj; ga[m][bj] = *(const u32x4*)gp; gb[m][bj] = *(const u32x4*)(gp + 1024); }
            __builtin_amdgcn_sched_barrier(0);
#pragma unroll
            for (int m = 0; m < 4; ++m)
#pragma unroll
                for (int bj = 0; bj < 2; ++bj) {
                    const u32x4 a = ga[m][bj], b = gb[m][bj];
#pragma unroll
                    for (int n = 0; n < 2; ++n) {
                        const unsigned a0 = n ? a.z : a.x, a1 = n ? a.w : a.y, b0 = n ? b.z : b.x, b1 = n ? b.w : b.y;
                        acc[ai][bj][m][n][0] *= bflo(a0) * fast_rcp(bflo(b0)); acc[ai][bj][m][n][1] *= bfhi(a0) * fast_rcp(bfhi(b0));
                        acc[ai][bj][m][n][2] *= bflo(a1) * fast_rcp(bflo(b1)); acc[ai][bj][m][n][3] *= bfhi(a1) * fast_rcp(bfhi(b1));
                    }
                }
            __builtin_amdgcn_sched_barrier(0);
        }
    }
    __device__ __forceinline__ void operator()(const f32x4 (&acc)[2][2][4][2], const Unit& u, int wr, int wc, int fr, int fq) const {
        const size_t r0 = (size_t)(u.pm * 256 + wr * 64 + fr); const int c0 = u.pn * 256 + 32 * wc + 8 * fq;
        u32x4 gc[2][4][2];
#pragma unroll
        for (int ai = 0; ai < 2; ++ai)
#pragma unroll
            for (int m = 0; m < 4; ++m)
#pragma unroll
                for (int bj = 0; bj < 2; ++bj) gc[ai][m][bj] = *(const u32x4*)(G + (r0 + ai * 128 + m * 16) * 3072 + 2048 + c0 + 128 * bj);
        __builtin_amdgcn_sched_barrier(0);
#pragma unroll
        for (int ai = 0; ai < 2; ++ai)
#pragma unroll
            for (int m = 0; m < 4; ++m)
#pragma unroll
                for (int bj = 0; bj < 2; ++bj) {
                    const u32x4 c = gc[ai][m][bj];
                    const f32x4 x0 = acc[ai][bj][m][0], x1 = acc[ai][bj][m][1];
                    u32x4 w;
                    w.x = pk2(x0[0] * bflo(c.x), x0[1] * bfhi(c.x)); w.y = pk2(x0[2] * bflo(c.y), x0[3] * bfhi(c.y));
                    w.z = pk2(x1[0] * bflo(c.z), x1[1] * bfhi(c.z)); w.w = pk2(x1[2] * bflo(c.w), x1[3] * bfhi(c.w));
                    *(u32x4*)(Mo + (r0 + ai * 128 + m * 16) * D + c0 + 128 * bj) = w;
                }
    }
};

struct EpiRes {
    static constexpr bool IDEM = false;
    static constexpr bool MID = false;
    const float* xs; float* xd; const float* hs; float* hd; const float* modl; int goff;
    __device__ __forceinline__ void operator()(const f32x4 (&acc)[2][2][4][2], const Unit& u, int wr, int wc, int fr, int fq) const {
        const int row0 = u.pm * 256; const bool lat = row0 < TL;
        const int b = lat ? (row0 >> 11) : 32;
        const float* src = (lat ? xs + (size_t)row0 * D : hs + (size_t)(row0 - TL) * D) + (size_t)(wr * 64 + fr) * D + u.pn * 256 + 32 * wc + 8 * fq;
        float* dst = (lat ? xd + (size_t)row0 * D : hd + (size_t)(row0 - TL) * D) + (size_t)(wr * 64 + fr) * D + u.pn * 256 + 32 * wc + 8 * fq;
        const float* gp = modl + (size_t)b * NMOD + goff + u.pn * 256 + 32 * wc + 8 * fq;
        f32x4 g[2][2];
#pragma unroll
        for (int bj = 0; bj < 2; ++bj) { g[bj][0] = *(const f32x4*)(gp + 128 * bj); g[bj][1] = *(const f32x4*)(gp + 128 * bj + 4); }
        f32x4 s[2][4][2];
#define ER_LOAD(k) do { const int bj_ = (k) >> 1, ai_ = (k) & 1; _Pragma("unroll") for (int m = 0; m < 4; ++m) { const size_t o = (size_t)(ai_ * 128 + m * 16) * D + 128 * bj_; \
            s[(k) & 1][m][0] = *(const f32x4*)(src + o); s[(k) & 1][m][1] = *(const f32x4*)(src + o + 4); } } while (0)
#define ER_STORE(k) do { const int bj_ = (k) >> 1, ai_ = (k) & 1; _Pragma("unroll") for (int m = 0; m < 4; ++m) { const size_t o = (size_t)(ai_ * 128 + m * 16) * D + 128 * bj_; \
            *(f32x4*)(dst + o) = s[(k) & 1][m][0] + g[bj_][0] * acc[ai_][bj_][m][0]; *(f32x4*)(dst + o + 4) = s[(k) & 1][m][1] + g[bj_][1] * acc[ai_][bj_][m][1]; } } while (0)
        ER_LOAD(0); __builtin_amdgcn_sched_barrier(0);
        ER_LOAD(1); __builtin_amdgcn_sched_barrier(0);
        ER_STORE(0); __builtin_amdgcn_sched_barrier(0);
        ER_LOAD(2); __builtin_amdgcn_sched_barrier(0);
        ER_STORE(1); __builtin_amdgcn_sched_barrier(0);
        ER_LOAD(3); __builtin_amdgcn_sched_barrier(0);
        ER_STORE(2); __builtin_amdgcn_sched_barrier(0);
        ER_STORE(3);
#undef ER_LOAD
#undef ER_STORE
    }
};

struct EpiResNorm {
    static constexpr bool IDEM = false;
    static constexpr bool MID = false;
    const float* xs; float* xd; const float* hs; float* hd; const float* modl; int goff;
    const float* ngain; const float* nmod; int nshift; bf16_t* U; float* slots; unsigned* cnt; LAS unsigned char* xl;
    __device__ __forceinline__ void operator()(f32x4 (&acc)[2][2][4][2], const Unit& u, int wr, int wc, int fr, int fq) const {
        const int row0 = u.pm * 256; const bool lat = row0 < TL;
        const int b = lat ? (row0 >> 11) : 32;
        const float* src = (lat ? xs + (size_t)row0 * D : hs + (size_t)(row0 - TL) * D) + (size_t)(wr * 64 + fr) * D + u.pn * 256 + 32 * wc + 8 * fq;
        float* dst = (lat ? xd + (size_t)row0 * D : hd + (size_t)(row0 - TL) * D) + (size_t)(wr * 64 + fr) * D + u.pn * 256 + 32 * wc + 8 * fq;
        const float* gp = modl + (size_t)b * NMOD + goff + u.pn * 256 + 32 * wc + 8 * fq;
        {
        f32x4 g[2][2];
#pragma unroll
        for (int bj = 0; bj < 2; ++bj) { g[bj][0] = *(const f32x4*)(gp + 128 * bj); g[bj][1] = *(const f32x4*)(gp + 128 * bj + 4); }
        f32x4 s[4][2];
#define ER_LOAD(k) do { const int bj_ = (k) >> 1, ai_ = (k) & 1; _Pragma("unroll") for (int m = 0; m < 4; ++m) { const size_t o = (size_t)(ai_ * 128 + m * 16) * D + 128 * bj_; \
            s[m][0] = *(const f32x4*)(src + o); s[m][1] = *(const f32x4*)(src + o + 4); } } while (0)
#define ER_STORE(k) do { const int bj_ = (k) >> 1, ai_ = (k) & 1; _Pragma("unroll") for (int m = 0; m < 4; ++m) { const size_t o = (size_t)(ai_ * 128 + m * 16) * D + 128 * bj_; \
            acc[ai_][bj_][m][0] = s[m][0] + g[bj_][0] * acc[ai_][bj_][m][0]; acc[ai_][bj_][m][1] = s[m][1] + g[bj_][1] * acc[ai_][bj_][m][1]; \
            *(f32x4*)(dst + o) = acc[ai_][bj_][m][0]; *(f32x4*)(dst + o + 4) = acc[ai_][bj_][m][1]; } } while (0)
        ER_LOAD(0); __builtin_amdgcn_sched_barrier(0); ER_STORE(0); __builtin_amdgcn_sched_barrier(0);
        ER_LOAD(1); __builtin_amdgcn_sched_barrier(0); ER_STORE(1); __builtin_amdgcn_sched_barrier(0);
        ER_LOAD(2); __builtin_amdgcn_sched_barrier(0); ER_STORE(2); __builtin_amdgcn_sched_barrier(0);
        ER_LOAD(3); __builtin_amdgcn_sched_barrier(0); ER_STORE(3); __builtin_amdgcn_sched_barrier(0);
#undef ER_LOAD
#undef ER_STORE
        }
        LAS float* P = (LAS float*)xl; LAS float* S = P + 1024;
        const int tid = (wr * 4 + wc) * 64 + fq * 16 + fr;
#pragma unroll
        for (int ai = 0; ai < 2; ++ai)
#pragma unroll
            for (int m = 0; m < 4; ++m) {
                float ss = 0.f;
#pragma unroll
                for (int bj = 0; bj < 2; ++bj)
#pragma unroll
                    for (int n = 0; n < 2; ++n) { const f32x4 x = acc[ai][bj][m][n]; ss += (x[0] * x[0] + x[1] * x[1]) + (x[2] * x[2] + x[3] * x[3]); }
                ss += __shfl_xor(ss, 16); ss += __shfl_xor(ss, 32);
                if (fq == 0) P[(ai * 128 + wr * 64 + m * 16 + fr) * 4 + wc] = ss;
            }
        asm volatile("s_waitcnt lgkmcnt(0)" ::: "memory"); __builtin_amdgcn_s_barrier(); asm volatile("" ::: "memory");
        if (tid < 256) {
            const float tot = (P[tid * 4 + 0] + P[tid * 4 + 1]) + (P[tid * 4 + 2] + P[tid * 4 + 3]);
            __hip_atomic_store(slots + (size_t)(row0 + tid) * 4 + u.pn, tot, __ATOMIC_RELAXED, __HIP_MEMORY_SCOPE_AGENT);
        }
        asm volatile("s_waitcnt vmcnt(0)" ::: "memory");
        if (tid < 256 && (tid & 63) == 0) __hip_atomic_fetch_add(cnt + u.pm, 1u, __ATOMIC_RELAXED, __HIP_MEMORY_SCOPE_AGENT);
        if (tid < 64) {
            unsigned sp = 0;
            while (__hip_atomic_load(cnt + u.pm, __ATOMIC_RELAXED, __HIP_MEMORY_SCOPE_AGENT) < 16u) { __builtin_amdgcn_s_sleep(2); if (++sp > (1u << 22)) break; }
            __builtin_amdgcn_fence(__ATOMIC_ACQUIRE, "agent");
        }
        asm volatile("s_waitcnt vmcnt(0) lgkmcnt(0)" ::: "memory"); __builtin_amdgcn_s_barrier(); asm volatile("" ::: "memory");
        if (tid < 256) {
            const float* sl = slots + (size_t)(row0 + tid) * 4;
            const float t4 = (__hip_atomic_load(sl + 0, __ATOMIC_RELAXED, __HIP_MEMORY_SCOPE_AGENT) + __hip_atomic_load(sl + 1, __ATOMIC_RELAXED, __HIP_MEMORY_SCOPE_AGENT))
                           + (__hip_atomic_load(sl + 2, __ATOMIC_RELAXED, __HIP_MEMORY_SCOPE_AGENT) + __hip_atomic_load(sl + 3, __ATOMIC_RELAXED, __HIP_MEMORY_SCOPE_AGENT));
            S[tid] = __builtin_amdgcn_rsqf(t4 * (1.0f / D) + EPS);
        }
        asm volatile("s_waitcnt lgkmcnt(0)" ::: "memory"); __builtin_amdgcn_s_barrier(); asm volatile("" ::: "memory");
        const float* mp = nmod + (size_t)b * NMOD + nshift + u.pn * 256 + 32 * wc + 8 * fq;
        const float* ng = ngain + u.pn * 256 + 32 * wc + 8 * fq;
        bf16_t* up = U + (size_t)(row0 + wr * 64 + fr) * D + u.pn * 256 + 32 * wc + 8 * fq;
#pragma unroll
        for (int bj = 0; bj < 2; ++bj) {
            const f32x4 sh0 = *(const f32x4*)(mp + 128 * bj), sh1 = *(const f32x4*)(mp + 128 * bj + 4);
            const f32x4 gs0 = *(const f32x4*)(ng + 128 * bj) * (*(const f32x4*)(mp + D + 128 * bj) + 1.0f), gs1 = *(const f32x4*)(ng + 128 * bj + 4) * (*(const f32x4*)(mp + D + 128 * bj + 4) + 1.0f);
#pragma unroll
            for (int ai = 0; ai < 2; ++ai)
#pragma unroll
                for (int m = 0; m < 4; ++m) {
                    const float rstd = S[ai * 128 + wr * 64 + m * 16 + fr];
                    const f32x4 y0 = acc[ai][bj][m][0] * rstd * gs0 + sh0, y1 = acc[ai][bj][m][1] * rstd * gs1 + sh1;
                    u32x4 w; w.x = pk2(y0[0], y0[1]); w.y = pk2(y0[2], y0[3]); w.z = pk2(y1[0], y1[1]); w.w = pk2(y1[2], y1[3]);
                    *(u32x4*)(up + (size_t)(ai * 128 + m * 16) * D + 128 * bj) = w;
                }
        }
    }
};

struct EpiFF1 {
    static constexpr bool IDEM = true;
    static constexpr bool MID = false;
    bf16_t* H1;
    __device__ __forceinline__ void operator()(const f32x4 (&acc)[2][2][4][2], const Unit& u, int wr, int wc, int fr, int fq) const {
        const int col = u.pn * 128 + 32 * wc + 8 * fq;
#pragma unroll
        for (int ai = 0; ai < 2; ++ai)
#pragma unroll
            for (int m = 0; m < 4; ++m) {
                const int row = u.pm * 256 + ai * 128 + wr * 64 + m * 16 + fr;
                float r[8];
#pragma unroll
                for (int n = 0; n < 2; ++n)
#pragma unroll
                    for (int j = 0; j < 4; ++j) { const float a = acc[ai][0][m][n][j], b = acc[ai][1][m][n][j]; r[4 * n + j] = a * sigmoidf_(a) * b; }
                u32x4 w; w.x = pk2(r[0], r[1]); w.y = pk2(r[2], r[3]); w.z = pk2(r[4], r[5]); w.w = pk2(r[6], r[7]);
                *(u32x4*)(H1 + (size_t)row * FF + col) = w;
            }
    }
};

struct EpiMod {
    static constexpr bool IDEM = false;
    static constexpr bool MID = false;
    float* mod; const float* bmod;
    __device__ __forceinline__ void operator()(const f32x4 (&acc)[2][2][4][2], const Unit& u, int wr, int wc, int fr, int fq) const {
        if (wr != 0) return;
#pragma unroll
        for (int m = 0; m < 3; ++m) {
            const int row = m * 16 + fr; if (row >= 33) continue;
#pragma unroll
            for (int bj = 0; bj < 2; ++bj)
#pragma unroll
                for (int n = 0; n < 2; ++n) {
                    const int nn = u.pn * 256 + 128 * bj + 32 * wc + 16 * n + 4 * fq;
                    const int l = nn / NMOD, c = nn - l * NMOD;
                    const f32x4 bv = *(const f32x4*)(bmod + nn);
                    *(f32x4*)(mod + ((size_t)l * 33 + row) * NMOD + c) = acc[0][bj][m][n] + bv;
                }
        }
    }
};

struct Args { const float* in[23]; float* out; unsigned char* ws; float freq[16]; int ph_lo, ph_hi; };
typedef const __attribute__((address_space(4))) Args* KArgsPtr;

__device__ __forceinline__ int p8map(int p) { return (p & 0xe0) | (((p >> 2) & 3) << 3) | (((p >> 4) & 1) << 2) | (p & 3); }
__device__ __forceinline__ void prep_item(KArgsPtr a, unsigned char* ws, int l, int mid, int item, LAS float* scr, int lane) {
    int K, N; if (mid == 0) { K = D; N = NIN; } else if (mid == 1 || mid == 2) { K = D; N = D; } else if (mid == 3) { K = D; N = 2 * FF; } else if (mid == 4) { K = FF; N = D; } else { K = D; N = NMOD; }
    const int nblk = N / 32, kb = item / nblk, nb = item % nblk, k0 = 64 * kb, n0 = 32 * nb;
    const int r = n0 + (lane & 31), tile = r >> 8, p = r & 255;
    const float* src; int ld, col, krow = k0; bf16_t* WT;
    if (mid == 0) { src = a->in[8] + (size_t)l * D * NIN; ld = NIN; col = tile * 256 + ((p >> 5) & 3) * 64 + (p >> 7) * 32 + (p & 31); WT = (bf16_t*)(ws + WS_WIN) + (size_t)l * NIN * D; }
    else if (mid == 1) { ld = D; col = tile * 256 + p8map(p); WT = (bf16_t*)(ws + WS_WBR) + (size_t)l * D * D;
        if (k0 < 384) { src = a->in[16] + (size_t)l * 384 * D; } else if (k0 < 768) { src = a->in[17] + (size_t)l * 384 * D; krow = k0 - 384; } else { src = a->in[18] + (size_t)l * 256 * D; krow = k0 - 768; } }
    else if (mid == 2) { src = a->in[19] + (size_t)l * D * D; ld = D; col = tile * 256 + p8map(p); WT = (bf16_t*)(ws + WS_WOUT) + (size_t)l * D * D; }
    else if (mid == 3) { src = ((p >> 7) ? a->in[21] : a->in[20]) + (size_t)l * D * FF; ld = FF; col = tile * 128 + (p8map(p) & 127); WT = (bf16_t*)(ws + WS_W13) + (size_t)l * 2 * FF * D; }
    else if (mid == 4) { src = a->in[22] + (size_t)l * FF * D; ld = D; col = tile * 256 + p8map(p); WT = (bf16_t*)(ws + WS_W2) + (size_t)l * D * FF; }
    else { src = a->in[4] + (size_t)l * D * NMOD; ld = NMOD; col = r; WT = (bf16_t*)(ws + WS_BIG) + (size_t)l * NMOD * D; }
#pragma unroll 8
    for (int i = 0; i < 32; ++i) { const int kk = 2 * i + (lane >> 5); scr[kk * 33 + (lane & 31)] = src[(size_t)(krow + kk) * ld + col]; }
    asm volatile("s_waitcnt lgkmcnt(0)" ::: "memory");
    const int c = lane & 7;
#pragma unroll
    for (int j = 0; j < 4; ++j) { const int n = (lane >> 3) + 8 * j; const LAS float* s = scr + (8 * c) * 33 + n;
        u32x4 o; o.x = pk2(s[0 * 33], s[1 * 33]); o.y = pk2(s[2 * 33], s[3 * 33]); o.z = pk2(s[4 * 33], s[5 * 33]); o.w = pk2(s[6 * 33], s[7 * 33]);
        *(u32x4*)(WT + (size_t)(n0 + n) * K + k0 + 8 * c) = o; }
    asm volatile("s_waitcnt lgkmcnt(0)" ::: "memory");
}

__device__ __forceinline__ void prep_phase(KArgsPtr a, LAS unsigned char* lds, int tid, int wid, int lane, int bid, int nblk_) {
    unsigned char* ws = a->ws;
    LAS float* scr = (LAS float*)(lds + wid * 8704);
    const int gw = bid * 8 + wid, NGW = nblk_ * 8;
    constexpr int I0 = 16 * 160, I1 = 16 * 32, I2 = 16 * 32, I3 = 16 * 176, I4 = 44 * 32, I5 = 16 * 192, IL = I0 + I1 + I2 + I3 + I4 + I5;
    for (int it = gw; it < IL * DEPTH; it += NGW) {
        const int l = it / IL; int r = it - l * IL; int mid;
        if (r < I0) mid = 0; else if ((r -= I0) < I1) mid = 1; else if ((r -= I1) < I2) mid = 2; else if ((r -= I2) < I3) mid = 3; else if ((r -= I3) < I4) mid = 4; else { r -= I4; mid = 5; }
        prep_item(a, ws, l, mid, r, scr, lane);
    }
    bf16_t* SC = (bf16_t*)(ws + WS_SC);
    for (int i = bid * 512 + tid; i < 256 * 1024; i += nblk_ * 512) {
        const int row = i >> 10, k = i & 1023; float v = 0.f;
        if (row < 32) v = a->in[1][row * D + k]; else if (row == 32) v = a->in[3][k];
        SC[i] = (bf16_t)f2bf(row <= 32 ? v * sigmoidf_(v) : 0.f);
    }
    f32x2* rope = (f32x2*)(ws + WS_ROPE);
    for (int i = bid * 512 + tid; i < 64 * 16; i += nblk_ * 512) {
        const int pos = i >> 4, fi = i & 15;
        const float ang = (float)pos * a->freq[fi];
        float rev = ang * 0.15915494309189535f; rev = rev - floorf(rev);
        rope[i] = (f32x2){__builtin_amdgcn_cosf(rev), __builtin_amdgcn_sinf(rev)};
    }
}

__device__ __forceinline__ void norm_phase(const float* xl, const float* xc, const float* gain, const float* modl, int shift_off, int nrows, bf16_t* U, int wid, int lane, int bid, int nblk_) {
    const int gw = bid * 8 + wid, NGW = nblk_ * 8;
    f32x4 gv[4];
#pragma unroll
    for (int j = 0; j < 4; ++j) gv[j] = *(const f32x4*)(gain + 4 * (lane + 64 * j));
    for (int row0 = gw; row0 < nrows; row0 += 4 * NGW) {
        f32x4 v[4][4]; float ss[4];
#pragma unroll
        for (int r = 0; r < 4; ++r) {
            const int row = row0 + r * NGW; ss[r] = 0.f;
            if (row < nrows) {
                const float* src = row < TL ? xl + (size_t)row * D : xc + (size_t)(row - TL) * D;
#pragma unroll
                for (int j = 0; j < 4; ++j) v[r][j] = *(const f32x4*)(src + 4 * (lane + 64 * j));
            } else {
#pragma unroll
                for (int j = 0; j < 4; ++j) v[r][j] = (f32x4){0.f, 0.f, 0.f, 0.f};
            }
        }
#pragma unroll
        for (int r = 0; r < 4; ++r) {
            const int row = row0 + r * NGW;
            if (row >= nrows) continue;
#pragma unroll
            for (int j = 0; j < 4; ++j) ss[r] += (v[r][j][0] * v[r][j][0] + v[r][j][1] * v[r][j][1]) + (v[r][j][2] * v[r][j][2] + v[r][j][3] * v[r][j][3]);
            const float rstd = __builtin_amdgcn_rsqf(wave_sum(ss[r]) * (1.0f / D) + EPS);
            const int b = row < TL ? (row >> 11) : 32;
            const float* mp = modl + (size_t)b * NMOD + shift_off;
#pragma unroll
            for (int j = 0; j < 4; ++j) {
                const int c = 4 * (lane + 64 * j);
                const f32x4 sh = *(const f32x4*)(mp + c), sc = *(const f32x4*)(mp + D + c);
                const f32x4 y = v[r][j] * rstd * gv[j] * (sc + 1.0f) + sh;
                u32x2 w; w.x = pk2(y[0], y[1]); w.y = pk2(y[2], y[3]);
                *(u32x2*)(U + (size_t)row * D + c) = w;
            }
        }
    }
}

struct AttnJob {
    const bf16_t* Q; int qpitch;
    const bf16_t* K; int kpitch;
    const bf16_t* Vt;
    bf16_t* O;
    int ctx_row0, lat_row0, ntiles;
    int na, r0, rlo;
    int fast;
};
#define MFMA32(a, b, c) __builtin_amdgcn_mfma_f32_32x32x16_bf16((a), (b), (c), 0, 0, 0)

__device__ __forceinline__ void glds16(const void* gsrc, unsigned lds_dst) { unsigned keep;
    asm volatile("s_mov_b32 %0, m0\n\ts_mov_b32 m0, %2\n\ts_nop 0\n\tglobal_load_lds_dwordx4 %1, off\n\ts_mov_b32 m0, %0" : "=&s"(keep) : "v"(gsrc), "s"(lds_dst) : "memory"); }
template <bool FAST>
__device__ __forceinline__ void att_scores(const LAS unsigned char* kb_, const bf16x8 (&qf)[4], int pi, int kx, int hi, bool local, const LAS float* bp, unsigned vmask, bool first,
                                           float& mrun, f32x16& o0, f32x16& o1, float& lrun, bf16x8 (&pf)[2][2]) {
    constexpr float THR = 8.0f;
    f32x16 s0, s1;
    if constexpr (FAST) {
#pragma unroll
        for (int i = 0; i < 16; ++i) { s0[i] = 0.f; s1[i] = 0.f; }
    } else {
        const float nm = -mrun;
#pragma unroll
        for (int i = 0; i < 16; ++i) { s0[i] = nm; s1[i] = nm; }
    }
    {
        bf16x8 a0[4], a1[4];
#pragma unroll
        for (int ks = 0; ks < 4; ++ks) { a0[ks] = *(const LAS bf16x8*)(kb_ + pi * 128 + (((2 * ks + hi) ^ kx) << 4)); a1[ks] = *(const LAS bf16x8*)(kb_ + (32 + pi) * 128 + (((2 * ks + hi) ^ kx) << 4)); }
        __builtin_amdgcn_sched_barrier(0);
#pragma unroll
        for (int ks = 0; ks < 4; ++ks) s0 = MFMA32(a0[ks], qf[ks], s0);
#pragma unroll
        for (int ks = 0; ks < 4; ++ks) s1 = MFMA32(a1[ks], qf[ks], s1);
    }
    if (local) {
#pragma unroll
        for (int i = 0; i < 16; ++i) {
            const float b0 = bp[16 * (i >> 3) + (i & 7)], b1 = bp[32 + 16 * (i >> 3) + (i & 7)];
            const unsigned m0 = (unsigned)__builtin_amdgcn_sbfe((int)vmask, i, 1), m1 = (unsigned)__builtin_amdgcn_sbfe((int)vmask, 16 + i, 1);
            const unsigned v0 = __builtin_bit_cast(unsigned, s0[i] + b0), v1 = __builtin_bit_cast(unsigned, s1[i] + b1);
            s0[i] = __builtin_bit_cast(float, (v0 & m0) | (0xf149f2cau & ~m0));
            s1[i] = __builtin_bit_cast(float, (v1 & m1) | (0xf149f2cau & ~m1));
            if ((i & 3) == 3) __builtin_amdgcn_sched_barrier(0);
        }
    }
    if constexpr (!FAST) {
    float mt = fmaxf(s0[0], s1[0]);
#pragma unroll
    for (int i = 1; i < 16; ++i) mt = fmaxf(mt, fmaxf(s0[i], s1[i]));
    mt = fmaxf(mt, __shfl_xor(mt, 32));
    if (first || __any(mt > THR)) {
        const float delta = first ? mt : (mt > THR ? mt : 0.f);
        const float alpha = first ? 1.0f : fast_exp2(-delta);
        mrun += delta;
#pragma unroll
        for (int i = 0; i < 16; ++i) { s0[i] -= delta; s1[i] -= delta; o0[i] *= alpha; o1[i] *= alpha; }
        lrun *= alpha;
    }
    }
    float rs = 0.f;
#pragma unroll
    for (int i = 0; i < 16; ++i) { s0[i] = fast_exp2(s0[i]); s1[i] = fast_exp2(s1[i]); rs += s0[i] + s1[i]; }
    lrun += rs;
#pragma unroll
    for (int cc = 0; cc < 2; ++cc) {
        u32x4 w0, w1;
        w0.x = pk2(s0[8 * cc + 0], s0[8 * cc + 1]); w0.y = pk2(s0[8 * cc + 2], s0[8 * cc + 3]); w0.z = pk2(s0[8 * cc + 4], s0[8 * cc + 5]); w0.w = pk2(s0[8 * cc + 6], s0[8 * cc + 7]);
        w1.x = pk2(s1[8 * cc + 0], s1[8 * cc + 1]); w1.y = pk2(s1[8 * cc + 2], s1[8 * cc + 3]); w1.z = pk2(s1[8 * cc + 4], s1[8 * cc + 5]); w1.w = pk2(s1[8 * cc + 6], s1[8 * cc + 7]);
        pf[0][cc] = __builtin_bit_cast(bf16x8, w0); pf[1][cc] = __builtin_bit_cast(bf16x8, w1);
    }
}
__device__ __forceinline__ void att_pv(const LAS unsigned char* vb_, int q, int vx, int hi, const bf16x8 (&pf)[2][2], f32x16& o0, f32x16& o1) {
#pragma unroll
    for (int kb = 0; kb < 2; ++kb) {
        bf16x8 v0[2], v1[2];
#pragma unroll
        for (int cc = 0; cc < 2; ++cc) { const int ch = 4 * kb + 2 * cc + hi;
            v0[cc] = *(const LAS bf16x8*)(vb_ + q * 128 + ((ch ^ vx) << 4)); v1[cc] = *(const LAS bf16x8*)(vb_ + (32 + q) * 128 + ((ch ^ vx) << 4)); }
        __builtin_amdgcn_sched_barrier(0);
#pragma unroll
        for (int cc = 0; cc < 2; ++cc) { o0 = MFMA32(v0[cc], pf[kb][cc], o0); o1 = MFMA32(v1[cc], pf[kb][cc], o1); }
        __builtin_amdgcn_sched_barrier(0);
    }
}

__device__ __forceinline__ void att_tile_fast(const LAS unsigned char* kb_, const LAS unsigned char* vb_, const bf16x8 (&qf)[4], int pi, int kx, int q, int vx, int hi,
                                              f32x16& o0, f32x16& o1, float& lrun) {
    bf16x8 a0[4], a1[4];
#pragma unroll
    for (int ks = 0; ks < 4; ++ks) { a0[ks] = *(const LAS bf16x8*)(kb_ + pi * 128 + (((2 * ks + hi) ^ kx) << 4)); a1[ks] = *(const LAS bf16x8*)(kb_ + (32 + pi) * 128 + (((2 * ks + hi) ^ kx) << 4)); }
    __builtin_amdgcn_sched_barrier(0);
    f32x16 s0, s1;
#pragma unroll
    for (int i = 0; i < 16; ++i) { s0[i] = 0.f; s1[i] = 0.f; }
#pragma unroll
    for (int ks = 0; ks < 4; ++ks) s0 = MFMA32(a0[ks], qf[ks], s0);
    __builtin_amdgcn_sched_barrier(0);
    float rs = 0.f;
#pragma unroll
    for (int ks = 0; ks < 4; ++ks) {
        s1 = MFMA32(a1[ks], qf[ks], s1);
#pragma unroll
        for (int i = 4 * ks; i < 4 * ks + 4; ++i) { s0[i] = fast_exp2(s0[i]); rs += s0[i]; }
        __builtin_amdgcn_sched_barrier(0);
    }
    bf16x8 p0[2];
#pragma unroll
    for (int cc = 0; cc < 2; ++cc) { u32x4 w; w.x = pk2(s0[8 * cc + 0], s0[8 * cc + 1]); w.y = pk2(s0[8 * cc + 2], s0[8 * cc + 3]); w.z = pk2(s0[8 * cc + 4], s0[8 * cc + 5]); w.w = pk2(s0[8 * cc + 6], s0[8 * cc + 7]); p0[cc] = __builtin_bit_cast(bf16x8, w); }
    bf16x8 va0[2], va1[2];
#pragma unroll
    for (int cc = 0; cc < 2; ++cc) { const int ch = 2 * cc + hi; va0[cc] = *(const LAS bf16x8*)(vb_ + q * 128 + ((ch ^ vx) << 4)); va1[cc] = *(const LAS bf16x8*)(vb_ + (32 + q) * 128 + ((ch ^ vx) << 4)); }
    __builtin_amdgcn_sched_barrier(0);
#pragma unroll
    for (int g = 0; g < 4; ++g) {
        if (g & 1) o1 = MFMA32(va1[g >> 1], p0[g >> 1], o1); else o0 = MFMA32(va0[g >> 1], p0[g >> 1], o0);
#pragma unroll
        for (int i = 4 * g; i < 4 * g + 4; ++i) { s1[i] = fast_exp2(s1[i]); rs += s1[i]; }
        __builtin_amdgcn_sched_barrier(0);
    }
    bf16x8 vb0[2], vb1[2];
#pragma unroll
    for (int cc = 0; cc < 2; ++cc) { const int ch = 4 + 2 * cc + hi; vb0[cc] = *(const LAS bf16x8*)(vb_ + q * 128 + ((ch ^ vx) << 4)); vb1[cc] = *(const LAS bf16x8*)(vb_ + (32 + q) * 128 + ((ch ^ vx) << 4)); }
    bf16x8 p1[2];
#pragma unroll
    for (int cc = 0; cc < 2; ++cc) { u32x4 w; w.x = pk2(s1[8 * cc + 0], s1[8 * cc + 1]); w.y = pk2(s1[8 * cc + 2], s1[8 * cc + 3]); w.z = pk2(s1[8 * cc + 4], s1[8 * cc + 5]); w.w = pk2(s1[8 * cc + 6], s1[8 * cc + 7]); p1[cc] = __builtin_bit_cast(bf16x8, w); }
#pragma unroll
    for (int cc = 0; cc < 2; ++cc) { o0 = MFMA32(vb0[cc], p1[cc], o0); o1 = MFMA32(vb1[cc], p1[cc], o1); }
    lrun += rs;
}

__device__ __forceinline__ void attn_unit(LAS unsigned char* lds, const AttnJob& J, const LAS float* biasL, int tid, int wid, int lane) {
    const int q = lane & 31, hi = lane >> 5;
    bf16x8 qf[4];
    f32x16 o0, o1; float lrun = 0.f;
#pragma unroll
    for (int i = 0; i < 16; ++i) { o0[i] = 0.f; o1[i] = 0.f; }
    float mrun = 0.f;
    bf16x8 pf[2][2];
#pragma unroll
    for (int a = 0; a < 2; ++a)
#pragma unroll
        for (int b = 0; b < 2; ++b) pf[a][b] = (bf16x8){0, 0, 0, 0, 0, 0, 0, 0};
    const int srow = tid >> 3;
    const int gch = (tid & 7) ^ ((srow >> 1) & 7);
    const int pi = (q & 0x13) | ((q & 4) << 1) | ((q & 8) >> 1);
    const int kx = (pi >> 1) & 7, vx = (q >> 1) & 7;
    const int rq = J.r0 + (wid >> 1), cq = (wid & 1) * 32 + q;
    const int rs_ = min(max(rq - 4, 0), 24), cs_ = min(max(cq - 8, 0), 48);
    unsigned vmask = 0u;
    if (J.na) {
#pragma unroll
        for (int i = 0; i < 32; ++i) { const int kc = 32 * (i >> 4) + 16 * ((i >> 3) & 1) + 8 * hi + (i & 7); vmask |= ((unsigned)(kc - cs_) < 16u ? 1u : 0u) << i; }
    }
    const int blane = 8 * hi - cq + 15 + 48;
    const bool fast = J.fast != 0;
    const bf16_t* kg = J.K + (size_t)srow * J.kpitch + gch * 8;
    const bf16_t* vg = J.Vt + (size_t)srow * T + gch * 8;
    const unsigned ldsw0 = (unsigned)(unsigned long long)lds + (unsigned)wid * 1024u;
#define ATT_ISSUE(tile, vslot) do { const int t_ = (tile); const int tk_ = t_ < 4 ? J.ctx_row0 + 64 * t_ : J.lat_row0 + 64 * (t_ - 4); \
        glds16(kg + (size_t)tk_ * J.kpitch, (unsigned)__builtin_amdgcn_readfirstlane((int)(ldsw0 + (t_ & 3) * 8192))); \
        glds16(vg + tk_, (unsigned)__builtin_amdgcn_readfirstlane((int)(ldsw0 + 32768 + (vslot) * 8192))); } while (0)
    ATT_ISSUE(0, 0); ATT_ISSUE(1, 1); ATT_ISSUE(2, 2);
    { const bf16_t* qrow = J.Q + (size_t)(wid * 32 + q) * J.qpitch + 8 * hi;
#pragma unroll
      for (int ks = 0; ks < 4; ++ks) qf[ks] = *(const bf16x8*)(qrow + 16 * ks); }
    asm volatile("s_waitcnt vmcnt(0) lgkmcnt(0)" :: "v"(qf[0]), "v"(qf[1]), "v"(qf[2]), "v"(qf[3]) : "memory");
    __builtin_amdgcn_s_barrier(); asm volatile("" ::: "memory");
    int vcur = 0, vprev = 4;
    for (int it = 0; it < J.ntiles; ++it) {
        const LAS unsigned char* kb_ = lds + (it & 3) * 8192;
        const int vnext = vcur == 4 ? 0 : vcur + 1;
        if (it + 3 < J.ntiles) { const int v3 = vcur + 3 >= 5 ? vcur - 2 : vcur + 3; ATT_ISSUE(it + 3, v3); }
        const int kr = J.rlo + it - 4;
        const bool local = J.na && it >= 4;
        const bool active = !local || (kr >= rs_ && kr < rs_ + 8);
        const LAS float* bp = biasL + (kr - rq + 7) * 128 + blane;
        if (active) {
            if (fast && !local) att_tile_fast(kb_, lds + 32768 + vcur * 8192, qf, pi, kx, q, vx, hi, o0, o1, lrun);
            else {
                if (fast) att_scores<true>(kb_, qf, pi, kx, hi, local, bp, vmask, it == 0, mrun, o0, o1, lrun, pf); else att_scores<false>(kb_, qf, pi, kx, hi, local, bp, vmask, it == 0, mrun, o0, o1, lrun, pf);
                att_pv(lds + 32768 + vcur * 8192, q, vx, hi, pf, o0, o1);
            }
        }
        const int ny = J.ntiles - (it + 2);
        if (ny >= 2) asm volatile("s_waitcnt vmcnt(4)" ::: "memory"); else if (ny == 1) asm volatile("s_waitcnt vmcnt(2)" ::: "memory"); else asm volatile("s_waitcnt vmcnt(0)" ::: "memory");
        __builtin_amdgcn_s_barrier(); asm volatile("" ::: "memory");
        vprev = vcur; vcur = vnext;
    }
#undef ATT_ISSUE
    const float inv = fast_rcp(lrun + __shfl_xor(lrun, 32));
    bf16_t* orow = J.O + (size_t)(wid * 32 + q) * D + 4 * hi;
#pragma unroll
    for (int c = 0; c < 4; ++c) {
        u32x2 w0, w1;
        w0.x = pk2(o0[4 * c] * inv, o0[4 * c + 1] * inv); w0.y = pk2(o0[4 * c + 2] * inv, o0[4 * c + 3] * inv);
        w1.x = pk2(o1[4 * c] * inv, o1[4 * c + 1] * inv); w1.y = pk2(o1[4 * c + 2] * inv, o1[4 * c + 3] * inv);
        *(u32x2*)(orow + 8 * c) = w0; *(u32x2*)(orow + 32 + 8 * c) = w1;
    }
}

__device__ __forceinline__ void pool_unit(LAS unsigned char* lds, const bf16_t* PC, const float* wpool, const float* pscale, bf16_t* Y, int unit, int tid) {
    const int row0 = unit * 64;
    const int seq0 = row0 < TL ? (row0 & ~(SEQ - 1)) : TL + ((row0 - TL) & ~(LCTX - 1));
    const int N = row0 < TL ? SEQ : LCTX;
    const int t0 = row0 - seq0;
    LAS unsigned short* vin = (LAS unsigned short*)lds;
    constexpr int PP = 264;
    LAS unsigned short* pooled = (LAS unsigned short*)(lds + 40960);
    for (int i = tid; i < 80 * 32; i += 512) {
        const int lr = i >> 5, ch8 = i & 31, t = t0 - 8 + lr;
        u32x4 v = (u32x4){0u, 0u, 0u, 0u};
        if (t >= 0 && t < N) v = *(const u32x4*)(PC + (size_t)(seq0 + t) * 256 + ch8 * 8);
        *(LAS u32x4*)(lds + (lr * 256 + ch8 * 8) * 2) = v;
    }
    __syncthreads();
    {
        const int ch = tid & 255, th = tid >> 8, g = ch >> 6, hw = 1 << g;
        const LAS unsigned short* vp = vin + (th * 32 + 8) * 256 + ch;
        float s = 0.f;
        for (int k = -hw; k < hw; ++k) s += bf2f(vp[k * 256]);
#pragma unroll 8
        for (int i = 0; i < 32; ++i) {
            const int tl = th * 32 + i, t = t0 + tl;
            const int lo = max(t - hw, 0), hi2 = min(t + hw, N);
            pooled[tl * PP + ch] = (unsigned short)f2bf(s * fast_rcp((float)(hi2 - lo)) - bf2f(vp[i * 256]));
            s += bf2f(vp[(i + hw) * 256]) - bf2f(vp[(i - hw) * 256]);
        }
    }
    __syncthreads();
    {
        const int lane = tid & 63, wid = tid >> 6, g = wid & 3, th = wid >> 2, q = lane & 31, hi = lane >> 5;
        const float* wg = wpool + (size_t)g * 64 * 64;
        bf16x8 af[4];
#pragma unroll
        for (int ks = 0; ks < 4; ++ks) af[ks] = *(const LAS bf16x8*)(pooled + (th * 32 + q) * PP + g * 64 + 16 * ks + 8 * hi);
#pragma unroll
        for (int db = 0; db < 2; ++db) {
            f32x16 dacc;
#pragma unroll
            for (int i = 0; i < 16; ++i) dacc[i] = 0.f;
#pragma unroll
            for (int ks = 0; ks < 4; ++ks) {
                const float* wp = wg + (size_t)(16 * ks + 8 * hi) * 64 + 32 * db + q;
                u32x4 w; w.x = pk2(wp[0], wp[64]); w.y = pk2(wp[128], wp[192]); w.z = pk2(wp[256], wp[320]); w.w = pk2(wp[384], wp[448]);
                dacc = MFMA32(af[ks], __builtin_bit_cast(bf16x8, w), dacc);
            }
            const int col = g * 64 + 32 * db + q;
            const float sc = pscale[col];
#pragma unroll
            for (int r = 0; r < 16; ++r) { const int tok = 8 * (r >> 2) + 4 * hi + (r & 3);
                Y[(size_t)(row0 + th * 32 + tok) * D + 768 + col] = (bf16_t)f2bf(dacc[r] * sc); }
        }
    }
    __syncthreads();
}

__device__ __forceinline__ void mixer_phase(KArgsPtr a, int l, bool lastl, LAS unsigned char* lds, unsigned* ctr, int tid_) {
    unsigned char* ws = a->ws;
    const bf16_t* big = (const bf16_t*)(ws + WS_BIG);
    bf16_t* Y = (bf16_t*)(ws + WS_U);
    constexpr int NG = NB * 6 * 8, NN = NB * 6 * 8, NCA = NB * 6, NCB = NB * 6;
    const int ncx = lastl ? 0 : NCA + NCB;
    const int npool = (lastl ? TL : T) / 64;
    const int total0 = NG + NN + ncx + npool;
    const int total = total0 + (MIX_DUP == 1 ? NG : MIX_DUP == 2 ? NN : MIX_DUP == 3 ? npool : 0);
    LAS int* shu = (LAS int*)(lds + LDS_MISC);
    LAS float* biasL = (LAS float*)(lds + 73728);
    int fastA, fastB, fastN;
    { const int ln = tid_ & 63;
      float qa = fabsf(a->in[9][l * 64 + ln]), ka = fabsf(a->in[10][l * 64 + ln]), qb = fabsf(a->in[11][l * 64 + ln]), kb = fabsf(a->in[12][l * 64 + ln]), bm = 0.f;
      for (int i = ln; i < 6 * 465; i += 64) bm = fmaxf(bm, fabsf(a->in[13][(size_t)l * 6 * 465 + i]));
#pragma unroll
      for (int o = 1; o < 64; o <<= 1) { qa = fmaxf(qa, __shfl_xor(qa, o)); ka = fmaxf(ka, __shfl_xor(ka, o)); qb = fmaxf(qb, __shfl_xor(qb, o)); kb = fmaxf(kb, __shfl_xor(kb, o)); bm = fmaxf(bm, __shfl_xor(bm, o)); }
      fastA = __builtin_amdgcn_readfirstlane((int)(11.5416f * qa * ka < 60.f));
      fastB = __builtin_amdgcn_readfirstlane((int)(11.5416f * qb * kb < 60.f));
      fastN = __builtin_amdgcn_readfirstlane((int)(11.5416f * qa * ka + bm * LOG2E < 60.f)); }
    if (tid_ == 0) shu[0] = (int)atomicAdd(ctr, 1u);
    __syncthreads();
    int u = __builtin_amdgcn_readfirstlane(shu[0]);
    for (int uit = 0;; ++uit) {
        int tid = tid_; asm volatile("" : "+v"(tid));
        const int lane = tid & 63, wid = __builtin_amdgcn_readfirstlane(tid >> 6);
        if (u >= total) break;
        if (u >= total0) u = u - total0 + (MIX_DUP == 2 ? NG : MIX_DUP == 3 ? NG + NN + ncx : 0);
        int nxt_ = 0; if (tid == 0) nxt_ = (int)atomicAdd(ctr, 1u);
        if (u < NG + NN + ncx) {
            AttnJob J;
            if (u < NG) {
                const int qb = u & 7, hq = (u >> 3) % 6, b = u / 48, hkv = hq / 3;
                J.Q = big + B_QB + (size_t)(b * SEQ + qb * 256) * 384 + hq * 64; J.qpitch = 384;
                J.K = big + B_KB + hkv * 64; J.kpitch = 128; J.Vt = big + B_VBT + (size_t)(hkv * 64) * T;
                J.O = Y + (size_t)(b * SEQ + qb * 256) * D + 384 + hq * 64;
                J.ctx_row0 = TL + b * LCTX; J.lat_row0 = b * SEQ; J.ntiles = 4 + 32; J.na = 0; J.r0 = 0; J.rlo = 0;
                J.fast = fastB;
            } else if ((u -= NG) < NN) {
                const int rg = u & 7, h = (u >> 3) % 6, b = u / 48, r0 = rg * 4;
                const int rlo = min(max(r0 - 4, 0), 24), rhi = min(max(r0 + 3 - 4, 0), 24) + 8;
                const float* rpb = a->in[13] + ((size_t)l * 6 + h) * 15 * 31;
                for (int i = tid; i < 15 * 128; i += 512) { const int dc = (i & 127) - 48; biasL[i] = (dc >= 0 && dc < 31) ? rpb[(i >> 7) * 31 + dc] * LOG2E : 0.f; }
                J.Q = big + B_QA + (size_t)(b * SEQ + r0 * 64) * 384 + h * 64; J.qpitch = 384;
                J.K = big + B_KA + h * 64; J.kpitch = 384; J.Vt = big + B_VAT + (size_t)(h * 64) * T;
                J.O = Y + (size_t)(b * SEQ + r0 * 64) * D + h * 64;
                J.ctx_row0 = TL + b * LCTX; J.lat_row0 = b * SEQ + rlo * 64; J.ntiles = 4 + (rhi - rlo); J.na = 1; J.r0 = r0; J.rlo = rlo;
                J.fast = fastN;
            } else {
                u -= NN;
                const bool second = u >= NCA; if (second) u -= NCA;
                const int h = u % 6, b = u / 6;
                if (!second) { J.Q = big + B_QA + (size_t)(TL + b * LCTX) * 384 + h * 64; J.K = big + B_KA + h * 64; J.kpitch = 384; J.Vt = big + B_VAT + (size_t)(h * 64) * T; J.O = Y + (size_t)(TL + b * LCTX) * D + h * 64; }
                else { const int hkv = h / 3; J.Q = big + B_QB + (size_t)(TL + b * LCTX) * 384 + h * 64; J.K = big + B_KB + hkv * 64; J.kpitch = 128; J.Vt = big + B_VBT + (size_t)(hkv * 64) * T; J.O = Y + (size_t)(TL + b * LCTX) * D + 384 + h * 64; }
                J.qpitch = 384; J.ctx_row0 = TL + b * LCTX; J.lat_row0 = 0; J.ntiles = 4; J.na = 0; J.r0 = 0; J.rlo = 0;
                J.fast = second ? fastB : fastA;
            }
            attn_unit(lds, J, biasL, tid, wid, lane);
        } else {
            u -= NG + NN + ncx;
            pool_unit(lds, big + B_PC, a->in[14] + (size_t)l * 4 * 64 * 64, a->in[15] + (size_t)l * 256, Y, u, tid);
        }
        if (tid == 0) shu[(uit + 1) & 1] = nxt_;
        __syncthreads();
        u = __builtin_amdgcn_readfirstlane(shu[(uit + 1) & 1]);
    }
}


#define XB_TMO      128
#define XB_XCNT(j)  (256  + 64 * (j))
#define XB_XSUB(j)  (1280 + 64 * (j))
#define XB_XGEN(j)  (2304 + 64 * (j))
#define XB_TOP      3328
#define XB_TOPGEN   3392
#define XB_SPIN_CAP (1u << 22)
constexpr int CW_BAR = 4096;
__device__ __forceinline__ unsigned xb_ld(unsigned* p)              { return __hip_atomic_load(p, __ATOMIC_RELAXED, __HIP_MEMORY_SCOPE_AGENT); }
__device__ __forceinline__ unsigned xb_add(unsigned* p, unsigned v) { return __hip_atomic_fetch_add(p, v, __ATOMIC_RELAXED, __HIP_MEMORY_SCOPE_AGENT); }
__device__ __forceinline__ unsigned xb_xcc_id() { return (unsigned)__builtin_amdgcn_s_getreg((3 << 11) | 20) & 0xFu; }
#define XB_SPIN(cond, bar) do { unsigned _sp = 0; while (cond) { __builtin_amdgcn_s_sleep(1); \
    if ((++_sp & 255u) == 0u) { if (xb_ld(&(bar)[XB_TMO])) break; if (_sp > XB_SPIN_CAP) { atomicAdd(&(bar)[XB_TMO], 1u); break; } } } } while (0)
__device__ __forceinline__ void xcd_barrier_complete(unsigned* bar, unsigned x, unsigned& nloc, unsigned& nx) {
    const unsigned G = gridDim.x * gridDim.y * gridDim.z;
    unsigned sum, cnt, mine, sp = 0u;
    for (;;) {
        sum = 0u; cnt = 0u; mine = 0u;
#pragma unroll
        for (unsigned j = 0; j < 16; ++j) { const unsigned c = xb_ld(&bar[XB_XCNT(j)]); sum += c; cnt += (c > 0u) ? 1u : 0u; mine = (j == x) ? c : mine; }
        if (sum == G) break;
        __builtin_amdgcn_s_sleep(1);
        if ((++sp & 255u) == 0u) { if (xb_ld(&bar[XB_TMO])) break; if (sp > XB_SPIN_CAP) { atomicAdd(&bar[XB_TMO], 1u); break; } }
    }
    nloc = mine > 0u ? mine : 1u; nx = cnt > 0u ? cnt : 1u;
}
__device__ __forceinline__ void xcd_barrier(unsigned* bar, volatile LAS unsigned* st) {
    asm volatile("s_waitcnt vmcnt(0)" ::: "memory");
    __syncthreads();
    if (threadIdx.x == 0) {
        const unsigned x = xb_xcc_id();
        __builtin_amdgcn_s_waitcnt(0);
        unsigned nloc = st[0], nx = st[1];
        if (nloc == 0u) { xcd_barrier_complete(bar, x, nloc, nx); st[0] = nloc; st[1] = nx; }
        const unsigned old = xb_add(&bar[XB_XSUB(x)], 1u);
        const unsigned gen = old / nloc;
        if (old + 1u == (gen + 1u) * nloc) {
            __builtin_amdgcn_fence(__ATOMIC_RELEASE, "agent");
            asm volatile("s_waitcnt vmcnt(0)" ::: "memory");
            const unsigned og = xb_add(&bar[XB_TOP], 1u);
            const unsigned tg = og / nx;
            if (og + 1u == (tg + 1u) * nx) xb_add(&bar[XB_TOPGEN], 1u);
            else XB_SPIN(xb_ld(&bar[XB_TOPGEN]) == tg, bar);
            __builtin_amdgcn_fence(__ATOMIC_ACQUIRE, "agent");
            xb_add(&bar[XB_XGEN(x)], 1u);
            asm volatile("s_waitcnt vmcnt(0)" ::: "memory");
        } else {
            XB_SPIN(xb_ld(&bar[XB_XGEN(x)]) == gen, bar);
            __builtin_amdgcn_fence(__ATOMIC_ACQUIRE, "agent");
            asm volatile("s_waitcnt vmcnt(0)" ::: "memory");
        }
    }
    __syncthreads();
}

__device__ __forceinline__ KArgsPtr fresh_args() {
    KArgsPtr p = (KArgsPtr)__builtin_amdgcn_kernarg_segment_ptr();
    asm volatile("" : "+s"(p) :: "memory");
    return p;
}
#define IN(k) (lo <= (k) && (k) < hi)
#define SEAM(k) do { if ((k) + 1 < hi) { if (lo < 0) { __threadfence(); cg::this_grid().sync(); } else xcd_barrier((unsigned*)(a_.ws + WS_CTL) + CW_BAR, (volatile LAS unsigned*)(lds + LDS_MISC + 16)); } } while (0)
#define PH_COMMON KArgsPtr a = fresh_args(); unsigned char* ws = a->ws; int tid = threadIdx.x; asm volatile("" : "+v"(tid)); const int lane = tid & 63, wid = __builtin_amdgcn_readfirstlane(tid >> 6); \
    int G = __builtin_amdgcn_readfirstlane((int)gridDim.x), c = __builtin_amdgcn_readfirstlane((int)blockIdx.x); \
    bf16_t* U = (bf16_t*)(ws + WS_U); bf16_t* BIG = (bf16_t*)(ws + WS_BIG); float* modall = (float*)(ws + WS_MOD); float* hbuf = (float*)(ws + WS_H); float* xout = a->out; \
    const bool lastl = (l == DEPTH - 1); const float* modl = modall + (size_t)l * 33 * NMOD; const float* xs = l == 0 ? a->in[0] : xout; const float* hs = l == 0 ? a->in[2] : hbuf; const int M = lastl ? TL : T; \
    (void)tid; (void)lane; (void)wid; (void)G; (void)c; (void)U; (void)BIG; (void)hbuf; (void)modl; (void)xs; (void)hs; (void)M; (void)lastl; (void)xout;
__global__ void __launch_bounds__(512, 2) mega_fwd(Args a_) {
    extern __shared__ __attribute__((aligned(16))) unsigned char lds_raw[];
    LAS unsigned char* lds = (LAS unsigned char*)lds_raw;
    const int lo = a_.ph_lo, hi = a_.ph_hi;
    if (threadIdx.x == 0) { ((volatile LAS unsigned*)(lds + LDS_MISC + 16))[0] = 0u; ((volatile LAS unsigned*)(lds + LDS_MISC + 16))[1] = 0u;
        (void)xb_add((unsigned*)(a_.ws + WS_CTL) + CW_BAR + XB_XCNT(xb_xcc_id()), 1u); }
    __syncthreads();
    if (IN(0)) { const int l = 0; PH_COMMON prep_phase(a, lds, tid, wid, lane, c, G);
#if PREP_DOUBLE
        xcd_barrier((unsigned*)(a_.ws + WS_CTL) + CW_BAR, (volatile LAS unsigned*)(lds + LDS_MISC + 16)); prep_phase(a, lds, tid, wid, lane, c, G);
#endif
        SEAM(0); }
    if (IN(1)) { const int l = 0; PH_COMMON
        pg8::Gemm g{(const bf16_t*)(ws + WS_SC), (const bf16_t*)(ws + WS_BIG), 256, DEPTH * NMOD, D};
        pg8::StaticOrder S; S.init(256, DEPTH * NMOD, G, c);
        EpiMod E{modall, a->in[5]};
        pg8::gemm_phase<EpiMod, pg8::StaticOrder, false, true>(lds, g, S, E, tid);
        SEAM(1);
    }
#pragma unroll 1
    for (int l = 0; l < DEPTH; ++l) {
        const int pb = 2 + 8 * l;
        if (IN(pb + 0) && l == 0) { for (int rep_ = 0; rep_ < ((REP_MASK >> 0) & 1) + 1; ++rep_) { if (rep_) { xcd_barrier((unsigned*)(a_.ws + WS_CTL) + CW_BAR, (volatile LAS unsigned*)(lds + LDS_MISC + 16)); } PH_COMMON norm_phase(xs, hs, a->in[6] + l * D, modl, 0, T, U, wid, lane, c, G); } SEAM(pb + 0); }
        if (IN(pb + 1)) { for (int rep_ = 0; rep_ < ((REP_MASK >> 1) & 1) + 1; ++rep_) { if (rep_) { xcd_barrier((unsigned*)(a_.ws + WS_CTL) + CW_BAR, (volatile LAS unsigned*)(lds + LDS_MISC + 16)); } PH_COMMON
            pg8::Gemm g{U, (const bf16_t*)(ws + WS_WIN) + (size_t)l * NIN * D, T, NIN, D};
            pg8::StaticOrder S; S.init(lastl ? TL : T, NIN, G, c); if (lastl) S.xtra = (TC / 256) * 5;
            EpiIn E{BIG, a->in[9] + l * 64, a->in[10] + l * 64, a->in[11] + l * 64, a->in[12] + l * 64, (const f32x2*)(ws + WS_ROPE)};
            pg8::gemm_phase<EpiIn, pg8::StaticOrder, true, true>(lds, g, S, E, tid, ((c >> 3) & 3) * STG_K1024);
            } SEAM(pb + 1);
        }
        if (IN(pb + 2)) { for (int rep_ = 0; rep_ < ((REP_MASK >> 2) & 1) + 1; ++rep_) { if (rep_) { xcd_barrier((unsigned*)(a_.ws + WS_CTL) + CW_BAR, (volatile LAS unsigned*)(lds + LDS_MISC + 16)); } PH_COMMON mixer_phase(a, l, lastl, lds, (unsigned*)(ws + WS_CTL) + 64 * (1 + l + 8 * rep_), tid); } SEAM(pb + 2); }
        if (IN(pb + 3)) { for (int rep_ = 0; rep_ < ((REP_MASK >> 3) & 1) + 1; ++rep_) { if (rep_) { xcd_barrier((unsigned*)(a_.ws + WS_CTL) + CW_BAR, (volatile LAS unsigned*)(lds + LDS_MISC + 16)); } PH_COMMON
            pg8::Gemm g{U, (const bf16_t*)(ws + WS_WBR) + (size_t)l * D * D, M, D, D};
            pg8::StaticOrder S; S.init(M, D, G, c);
            S.dbl = 0; S.rev = 1; EpiMerge E{BIG + B_G, BIG};
            pg8::gemm_phase<EpiMerge, pg8::StaticOrder, true, true>(lds, g, S, E, tid, ((c >> 3) & 3) * STG_K1024);
            } SEAM(pb + 3);
        }
        if (IN(pb + 4)) { PH_COMMON
            pg8::Gemm g{BIG, (const bf16_t*)(ws + WS_WOUT) + (size_t)l * D * D, M, D, D};
            pg8::PanelOrder S; S.init(M, G, c);
            EpiResNorm E{xs, xout, hs, hbuf, modl, 2 * D, a->in[7] + l * D, modl, 3 * D, U, (float*)(ws + WS_SLOTS), (unsigned*)(ws + WS_CTL + CTL_PANEL) + (l * 2 + 0) * 512, lds + LDS_XCH};
            pg8::gemm_phase<EpiResNorm, pg8::PanelOrder, true, true>(lds, g, S, E, tid);
            SEAM(pb + 4);
        }
        if (IN(pb + 6)) { for (int rep_ = 0; rep_ < ((REP_MASK >> 6) & 1) + 1; ++rep_) { if (rep_) { xcd_barrier((unsigned*)(a_.ws + WS_CTL) + CW_BAR, (volatile LAS unsigned*)(lds + LDS_MISC + 16)); } PH_COMMON
            pg8::Gemm g{U, (const bf16_t*)(ws + WS_W13) + (size_t)l * 2 * FF * D, M, 2 * FF, D};
            pg8::StaticOrder S; S.init(M, 2 * FF, G, c);
            EpiFF1 E{BIG};
            pg8::gemm_phase<EpiFF1, pg8::StaticOrder, true, true>(lds, g, S, E, tid, ((c >> 3) & 3) * STG_K1024);
            } SEAM(pb + 6);
        }
        if (IN(pb + 7)) { PH_COMMON
            pg8::Gemm g{BIG, (const bf16_t*)(ws + WS_W2) + (size_t)l * D * FF, M, D, FF};
            if (lastl) {
                pg8::StaticOrder S; S.init(M, D, G, c);
                EpiRes E{xout, xout, hbuf, hbuf, modl, 5 * D};
                pg8::gemm_phase<EpiRes, pg8::StaticOrder, true, true>(lds, g, S, E, tid, ((c >> 3) & 3) * STG_K2816);
            } else {
                pg8::PanelOrder S; S.init(M, G, c); S.rev = 1;
                EpiResNorm E{xout, xout, hbuf, hbuf, modl, 5 * D, a->in[6] + (l + 1) * D, modall + (size_t)(l + 1) * 33 * NMOD, 0, U, (float*)(ws + WS_SLOTS), (unsigned*)(ws + WS_CTL + CTL_PANEL) + (l * 2 + 1) * 512, lds + LDS_XCH};
                pg8::gemm_phase<EpiResNorm, pg8::PanelOrder, true, true>(lds, g, S, E, tid);
            }
            SEAM(pb + 7);
        }
    }
}
#undef IN
#undef SEAM

extern "C" void kernel_launch(void* const* d_in, const int* in_sizes, int n_in, void* d_out, int out_size, void* d_ws, size_t ws_size, hipStream_t stream) {
    static int grid = 0;
    if (grid == 0) {
        if (n_in != 23 || out_size != TL * D || ws_size < WS_END2) { fprintf(stderr, "kernel_launch: unexpected shapes (n_in %d out %d ws %zu need %zu)\n", n_in, out_size, ws_size, (size_t)WS_END2); grid = -1; return; }
        int dev = 0, cus = 0, per_cu = 0;
        hipGetDevice(&dev); hipDeviceGetAttribute(&cus, hipDeviceAttributeMultiprocessorCount, dev);
        if (hipFuncSetAttribute((const void*)mega_fwd, hipFuncAttributeMaxDynamicSharedMemorySize, LDS_BYTES) != hipSuccess) { fprintf(stderr, "kernel_launch: hipFuncSetAttribute failed\n"); grid = -1; return; }
        if (hipOccupancyMaxActiveBlocksPerMultiprocessor(&per_cu, (const void*)mega_fwd, 512, LDS_BYTES) != hipSuccess || per_cu < 1) { fprintf(stderr, "kernel_launch: occupancy query gave %d\n", per_cu); per_cu = 1; }
        (void)hipGetLastError();
        grid = cus;
        fprintf(stderr, "kernel_launch: cus %d per_cu %d grid %d ws %zu\n", cus, per_cu, grid, ws_size);
    }
    if (grid < 0) return;
    hipMemsetAsync((char*)d_ws + WS_CTL, 0, CTL_BYTES, stream);
    Args a{};
    for (int i = 0; i < 23; ++i) a.in[i] = (const float*)d_in[i];
    a.out = (float*)d_out; a.ws = (unsigned char*)d_ws;
    for (int i = 0; i < 16; ++i) a.freq[i] = (float)pow(10000.0, -(double)i / 16.0);
#if MK_PER_PHASE
    for (int ph = 0; ph < NPH; ++ph) { a.ph_lo = ph; a.ph_hi = ph + 1; hipLaunchKernelGGL(mega_fwd, dim3(grid), dim3(512), LDS_BYTES, stream, a); }
#else
    a.ph_lo = 0; a.ph_hi = NPH;
    void* args[] = {&a};
    hipError_t e = hipLaunchCooperativeKernel((const void*)mega_fwd, dim3(grid), dim3(512), args, LDS_BYTES, stream);
    if (e != hipSuccess) fprintf(stderr, "kernel_launch: cooperative launch failed: %s (grid %d)\n", hipGetErrorString(e), grid);
#endif
}
```

```cpp
#include <hip/hip_runtime.h>
#include <hip/hip_cooperative_groups.h>
#include <cstdio>
#include <cstdint>
#include <cmath>
namespace cg = cooperative_groups;

#ifndef REP_MASK
#define REP_MASK 0
#endif
#ifndef EPI_DOUBLE
#define EPI_DOUBLE 0
#endif
#ifndef PREP_DOUBLE
#define PREP_DOUBLE 0
#endif
#ifndef MIX_DUP
#define MIX_DUP 0
#endif
#ifndef GEMM_DOUBLE
#define GEMM_DOUBLE 0
#endif
#ifndef STG_K1024
#define STG_K1024 0
#define STG_K2816 0
#endif
#ifndef MK_PER_PHASE
#define MK_PER_PHASE 0
#endif

#define LAS __attribute__((address_space(3)))
typedef unsigned short bf16_t;
typedef short bf16x8 __attribute__((ext_vector_type(8)));
typedef float f32x4 __attribute__((ext_vector_type(4)));
typedef float f32x2 __attribute__((ext_vector_type(2)));
typedef float f32x16 __attribute__((ext_vector_type(16)));
typedef unsigned u32x4 __attribute__((ext_vector_type(4)));
typedef unsigned u32x2 __attribute__((ext_vector_type(2)));

constexpr int D = 1024, NB = 32, SEQ = 2048, DEPTH = 4, LCTX = 256, GW = 64;
constexpr int TL = NB * SEQ, TC = NB * LCTX, T = TL + TC;
constexpr int NIN = 5120, FF = 2816, NMOD = 6144;
constexpr float EPS = 1e-6f;
constexpr float LOG2E = 1.4426950408889634f;
constexpr float QSCALE = 0.125f * LOG2E;
constexpr int NPH = 2 + 8 * DEPTH;

constexpr size_t WS_CTL = 0, CTL_BYTES = 65536;
constexpr size_t WS_ROPE = WS_CTL + CTL_BYTES;
constexpr size_t WS_MOD = WS_ROPE + 8192;
constexpr size_t WS_SC = WS_MOD + (size_t)DEPTH * 33 * NMOD * 4;
constexpr size_t WS_H = WS_SC + 256 * 1024 * 2;
constexpr size_t WS_WIN = WS_H + (size_t)TC * D * 4;
constexpr size_t WS_WBR = WS_WIN + (size_t)DEPTH * NIN * D * 2;
constexpr size_t WS_WOUT = WS_WBR + (size_t)DEPTH * D * D * 2;
constexpr size_t WS_W13 = WS_WOUT + (size_t)DEPTH * D * D * 2;
constexpr size_t WS_W2 = WS_W13 + (size_t)DEPTH * 2 * FF * D * 2;
constexpr size_t WS_U = WS_W2 + (size_t)DEPTH * D * FF * 2;
constexpr size_t WS_BIG = WS_U + (size_t)T * D * 2;
constexpr size_t WS_END = WS_BIG + (size_t)T * NIN * 2;
constexpr size_t WS_SLOTS = WS_END;
constexpr size_t WS_END2 = WS_SLOTS + (size_t)T * 4 * 4;
static_assert(WS_END2 <= (size_t)1073741824, "workspace map exceeds 1 GiB");
constexpr size_t CTL_PANEL = 32768;
constexpr size_t B_QA = 0, B_KA = B_QA + (size_t)T * 384, B_VAT = B_KA + (size_t)T * 384, B_QB = B_VAT + (size_t)T * 384, B_KB = B_QB + (size_t)T * 384,
                 B_VBT = B_KB + (size_t)T * 128, B_PC = B_VBT + (size_t)T * 128, B_G = B_PC + (size_t)T * 256;
static_assert(B_G == (size_t)T * 2048, "BIG layout");

constexpr int LDS_BYTES = 131072 + 1024 + 6144;
constexpr int LDS_XCH = 131072 + 1024;
constexpr int LDS_MISC = 131072;

__device__ __forceinline__ unsigned f2bf(float f) { unsigned u = __builtin_bit_cast(unsigned, f); return (u + 0x7fffu + ((u >> 16) & 1u)) >> 16; }
typedef __bf16 hwbf2 __attribute__((ext_vector_type(2)));
__device__ __forceinline__ unsigned pk2(float lo, float hi) { const f32x2 v = {lo, hi}; const hwbf2 b = __builtin_convertvector(v, hwbf2); return __builtin_bit_cast(unsigned, b); }
__device__ __forceinline__ float bf2f(unsigned short h) { return __builtin_bit_cast(float, (unsigned)h << 16); }
__device__ __forceinline__ float bflo(unsigned w) { return __builtin_bit_cast(float, w << 16); }
__device__ __forceinline__ float bfhi(unsigned w) { return __builtin_bit_cast(float, w & 0xffff0000u); }
__device__ __forceinline__ float wave_sum(float v) {
#pragma unroll
    for (int o = 1; o < 64; o <<= 1) v += __shfl_xor(v, o);
    return v;
}
__device__ __forceinline__ float fast_exp2(float x) { return __builtin_amdgcn_exp2f(x); }
__device__ __forceinline__ float fast_rcp(float x) { return __builtin_amdgcn_rcpf(x); }
__device__ __forceinline__ float sigmoidf_(float x) { return fast_rcp(1.0f + fast_exp2(x * -LOG2E)); }

namespace pg8 {
constexpr int BM = 256, BK = 64, HALF = 128, HTB = HALF * BK * 2, NXCD = 8, WGM = 8;
__host__ __device__ __forceinline__ int lds_byte(int r, int c) { const int st = (r >> 4) * 2 + (c >> 5), rr = r & 15, cc = c & 31, ob = rr * 64 + cc * 2; return st * 1024 + (ob ^ (((ob >> 9) & 1) << 5)); }
__host__ __device__ __forceinline__ void stage_rc(int b, int& R, int& C) { const int st = b / 1024, sb = b % 1024, swz = sb ^ (((sb >> 9) & 1) << 5); R = (st >> 1) * 16 + swz / 64; C = (st & 1) * 32 + (swz % 64) / 2; }

struct Unit { int pm, pn, second; };
struct Gemm { const bf16_t* A; const bf16_t* Bt; int M, N, K; };

struct StaticOrder {
    int nM, nN, nwg, G, c, dbl, xtra, rev;
    __device__ void init(int M, int N, int G_, int c_) { nM = M / BM; nN = N / BM; nwg = nM * nN; G = G_; c = c_; dbl = GEMM_DOUBLE; xtra = 0; rev = 0; }
    __device__ bool next(int i, Unit& u) const {
        const long L = (long)(dbl ? (i >> 1) : i) * G + c; u.second = dbl ? (i & 1) : 1;
        if (L >= nwg) { const int k = (int)(L - nwg); if (k >= xtra) return false; const int t = k % 5; u.pm = nM + k / 5; u.pn = t < 4 ? t + 1 : 6; return true; }
        int wgid = (int)L; { const int q = nwg / NXCD, r = nwg % NXCD, xcd = wgid % NXCD; int off = wgid / NXCD; if (rev) off = (xcd < r ? q : q - 1) - off; wgid = (xcd < r ? xcd * (q + 1) : r * (q + 1) + (xcd - r) * q) + off; }
        const int nig = WGM * nN, gid = wgid / nig, fm = gid * WGM, gsz = (nM - fm) < WGM ? (nM - fm) : WGM;
        u.pm = fm + ((wgid % nig) % gsz); u.pn = (wgid % nig) / gsz; return true;
    }
};

struct PanelOrder {
    int nM, G, c, dbl, rev;
    __device__ void init(int M, int G_, int c_) { nM = M / BM; G = G_; c = c_; dbl = 0; rev = 0; }
    __device__ bool next(int i, Unit& u) const {
        if (G < 256 || c >= 256) { if (G >= 256) return false; const long L = (long)i * (G & ~3) + c; if (c >= (G & ~3) || L >= (long)nM * 4) return false; u.pm = (int)(L >> 2); u.pn = (int)(L & 3); u.second = 1; return true; }
        if (rev && (nM & 7) == 0) {
            const int per = nM >> 3, k = 8 * i + (c >> 5); if (k >= per) return false;
            u.pm = (c & 7) * per + (rev == 1 ? per - 1 - k : k); u.pn = (c >> 3) & 3; u.second = 1; return true;
        }
        const int pm = i * 64 + (c & 7) * 8 + (c >> 5); if (pm >= nM) return false;
        u.pm = pm; u.pn = (c >> 3) & 3; u.second = 1; return true;
    }
};

template <class Epi, class Sched, bool ALIGN_EPI = false, bool SP2 = false>
__device__ __forceinline__ void gemm_phase(LAS unsigned char* lds, const Gemm g, const Sched& S, const Epi& E, const int tid, const int stagger_ticks = 0) {
    const int wid = __builtin_amdgcn_readfirstlane(tid >> 6), lane = tid & 63, wr = wid >> 2, wc = wid & 3, fr = lane & 15, fq = lane >> 4;
    const int K = g.K, nt = K / BK;
    unsigned voffA[2], voffB[2];
#pragma unroll
    for (int i = 0; i < 2; ++i) { int R, C; stage_rc(tid * 16 + i * 8192, R, C); voffA[i] = (unsigned)(R * K + C) * 2u; voffB[i] = (unsigned)(R * K + C) * 2u; }
    const size_t kstep = (size_t)(BK * 2);
    const size_t hstep = (size_t)HALF * K * 2;
    const size_t tstep = 2 * hstep;
    const unsigned ldsw = (unsigned)wid * 1024u;
    const int aoff = lds_byte(wr * 64 + fr, fq * 8), boff = lds_byte(wc * 32 + fr, fq * 8);
#define PG8_SA(b, h) (((b) * 2 + (h)) * HTB)
#define PG8_SB(b, h) ((4 + (b) * 2 + (h)) * HTB)
#define PG8_STAGE(bufoff, gbase, voff) do { _Pragma("unroll") for (int _i = 0; _i < 2; ++_i) \
        __builtin_amdgcn_global_load_lds((const unsigned*)((const char*)(gbase) + (voff)[_i]), (LAS unsigned*)(lds + (bufoff) + ldsw + _i * 8192), 16, 0, 0); } while (0)
#define PG8_LDA(dst, b, h) do { _Pragma("unroll") for (int m = 0; m < 4; ++m) _Pragma("unroll") for (int k = 0; k < 2; ++k) dst[m][k] = *(const LAS bf16x8*)(lds + PG8_SA(b, h) + aoff + m * 2048 + k * 1024); } while (0)
#define PG8_LDB(dst, b, h) do { _Pragma("unroll") for (int n = 0; n < 2; ++n) _Pragma("unroll") for (int k = 0; k < 2; ++k) dst[n][k] = *(const LAS bf16x8*)(lds + PG8_SB(b, h) + boff + n * 2048 + k * 1024); } while (0)
#define PG8_MMA(ai, bj, At, Bt) do { __builtin_amdgcn_s_setprio(1); _Pragma("unroll") for (int m = 0; m < 4; ++m) _Pragma("unroll") for (int n = 0; n < 2; ++n) _Pragma("unroll") for (int k = 0; k < 2; ++k) \
        acc[ai][bj][m][n] = __builtin_amdgcn_mfma_f32_16x16x32_bf16(Bt[n][k], At[m][k], acc[ai][bj][m][n], 0, 0, 0); __builtin_amdgcn_s_setprio(0); } while (0)
#define PG8_WAIT_V(n) asm volatile("s_waitcnt vmcnt(" #n ")" ::: "memory")
#define PG8_WAIT_L(n) asm volatile("s_waitcnt lgkmcnt(" #n ")" ::: "memory")
#define PG8_BAR __builtin_amdgcn_s_barrier()
#define PG8_SCHED __builtin_amdgcn_sched_barrier(0)
    Unit cur, nxt; int ui = 0;
    if (!S.next(0, cur)) return;
    if (stagger_ticks > 0) {
        const unsigned long long t0 = __builtin_amdgcn_s_memrealtime();
        while ((long long)(__builtin_amdgcn_s_memrealtime() - t0) < (long long)stagger_ticks) __builtin_amdgcn_s_sleep(16);
    }
    f32x4 acc[2][2][4][2];
#pragma unroll
    for (int a = 0; a < 2; ++a)
#pragma unroll
        for (int b = 0; b < 2; ++b)
#pragma unroll
            for (int m = 0; m < 4; ++m)
#pragma unroll
                for (int n = 0; n < 2; ++n) acc[a][b][m][n] = (f32x4){0.f, 0.f, 0.f, 0.f};
    bf16x8 At[4][2], B0[2][2], B1[2][2];
    const char* cA = (const char*)g.A + (size_t)cur.pm * tstep; const char* cB = (const char*)g.Bt + (size_t)cur.pn * tstep;
    if constexpr (SP2) {
        PG8_STAGE(PG8_SB(0, 0), cB, voffB); PG8_STAGE(PG8_SB(0, 1), cB + hstep, voffB); PG8_STAGE(PG8_SA(0, 0), cA, voffA); PG8_STAGE(PG8_SA(0, 1), cA + hstep, voffA);
        if (wr == 1) PG8_BAR;
        PG8_WAIT_V(2); PG8_BAR;
        PG8_STAGE(PG8_SB(1, 0), cB + kstep, voffB); PG8_STAGE(PG8_SA(1, 0), cA + kstep, voffA); PG8_STAGE(PG8_SB(1, 1), cB + hstep + kstep, voffB);
        PG8_WAIT_V(6); PG8_BAR;
    } else {
        PG8_STAGE(PG8_SB(0, 0), cB, voffB); PG8_STAGE(PG8_SA(0, 0), cA, voffA); PG8_STAGE(PG8_SB(0, 1), cB + hstep, voffB); PG8_STAGE(PG8_SA(0, 1), cA + hstep, voffA);
        if (wr == 1) PG8_BAR;
        PG8_WAIT_V(4); PG8_BAR;
        PG8_STAGE(PG8_SB(1, 0), cB + kstep, voffB); PG8_STAGE(PG8_SA(1, 0), cA + kstep, voffA); PG8_STAGE(PG8_SB(1, 1), cB + hstep + kstep, voffB);
        PG8_WAIT_V(6); PG8_BAR;
    }
    for (;;) {
        const bool has_next = S.next(ui + 1, nxt);
        const char* nA = has_next ? (const char*)g.A + (size_t)nxt.pm * tstep : cA; const char* nB = has_next ? (const char*)g.Bt + (size_t)nxt.pn * tstep : cB;
        for (int t = 0; t < nt; t += 2) {
            if constexpr (Epi::MID) { if (t == 6 || t == 12) E.mid(acc, cur, t == 6 ? 0 : 1, wr, wc, fr, fq); }
            const bool last = (t == nt - 2);
            const char* a1 = cA + (size_t)(t + 1) * kstep;
            const char* a2 = last ? nA : cA + (size_t)(t + 2) * kstep; const char* b2 = last ? nB : cB + (size_t)(t + 2) * kstep;
            const char* a3 = a2 + kstep; const char* b3 = b2 + kstep;
            if constexpr (SP2) {
            PG8_LDB(B0, 0, 0); PG8_LDB(B1, 0, 1); PG8_SCHED; PG8_LDA(At, 0, 0); PG8_STAGE(PG8_SA(1, 1), a1 + hstep, voffA);
            PG8_WAIT_V(8); PG8_WAIT_L(0); PG8_BAR; PG8_MMA(0, 0, At, B0); PG8_MMA(0, 1, At, B1); PG8_BAR; PG8_SCHED;
            PG8_LDA(At, 0, 1); PG8_STAGE(PG8_SB(0, 0), b2, voffB); PG8_STAGE(PG8_SB(0, 1), b2 + hstep, voffB); PG8_STAGE(PG8_SA(0, 0), a2, voffA);
            PG8_WAIT_V(8); PG8_WAIT_L(0); PG8_BAR; PG8_MMA(1, 0, At, B0); PG8_MMA(1, 1, At, B1); PG8_BAR; PG8_SCHED;
            PG8_LDB(B0, 1, 0); PG8_LDB(B1, 1, 1); PG8_SCHED; PG8_LDA(At, 1, 0); PG8_STAGE(PG8_SA(0, 1), a2 + hstep, voffA);
            PG8_WAIT_V(8); PG8_WAIT_L(0); PG8_BAR; PG8_MMA(0, 0, At, B0); PG8_MMA(0, 1, At, B1); PG8_BAR; PG8_SCHED;
            PG8_LDA(At, 1, 1); PG8_STAGE(PG8_SB(1, 0), b3, voffB); PG8_STAGE(PG8_SB(1, 1), b3 + hstep, voffB); PG8_STAGE(PG8_SA(1, 0), a3, voffA);
            PG8_WAIT_V(8); PG8_WAIT_L(0); PG8_BAR; PG8_MMA(1, 0, At, B0); PG8_MMA(1, 1, At, B1); PG8_BAR; PG8_SCHED;
            } else {
            PG8_LDB(B0, 0, 0); PG8_SCHED; PG8_LDA(At, 0, 0); PG8_STAGE(PG8_SA(1, 1), a1 + hstep, voffA);
            PG8_WAIT_L(8); PG8_BAR; PG8_WAIT_L(0); PG8_MMA(0, 0, At, B0); PG8_BAR; PG8_SCHED;
            PG8_LDB(B1, 0, 1); PG8_STAGE(PG8_SB(0, 0), b2, voffB);
            PG8_BAR; PG8_WAIT_L(0); PG8_MMA(0, 1, At, B1); PG8_BAR;
            PG8_LDA(At, 0, 1); PG8_STAGE(PG8_SA(0, 0), a2, voffA);
            PG8_BAR; PG8_WAIT_L(0); PG8_MMA(1, 0, At, B0); PG8_BAR; PG8_SCHED;
            PG8_STAGE(PG8_SB(0, 1), b2 + hstep, voffB);
            PG8_WAIT_V(6); PG8_BAR; PG8_MMA(1, 1, At, B1); PG8_BAR;
            PG8_LDB(B0, 1, 0); PG8_SCHED; PG8_LDA(At, 1, 0); PG8_STAGE(PG8_SA(0, 1), a2 + hstep, voffA);
            PG8_WAIT_L(8); PG8_BAR; PG8_WAIT_L(0); PG8_MMA(0, 0, At, B0); PG8_BAR; PG8_SCHED;
            PG8_LDB(B1, 1, 1); PG8_STAGE(PG8_SB(1, 0), b3, voffB);
            PG8_BAR; PG8_WAIT_L(0); PG8_MMA(0, 1, At, B1); PG8_BAR;
            PG8_LDA(At, 1, 1); PG8_STAGE(PG8_SA(1, 0), a3, voffA);
            PG8_BAR; PG8_WAIT_L(0); PG8_MMA(1, 0, At, B0); PG8_BAR; PG8_SCHED;
            PG8_STAGE(PG8_SB(1, 1), b3 + hstep, voffB);
            PG8_WAIT_V(6); PG8_BAR; PG8_MMA(1, 1, At, B1); PG8_BAR;
            }
        }
        if constexpr (ALIGN_EPI) { if (wr == 0) PG8_BAR; }
        if (cur.second) {
        if (S.dbl) {
#pragma unroll
        for (int a = 0; a < 2; ++a)
#pragma unroll
            for (int b = 0; b < 2; ++b)
#pragma unroll
                for (int m = 0; m < 4; ++m)
#pragma unroll
                    for (int n = 0; n < 2; ++n) acc[a][b][m][n] = acc[a][b][m][n] * 0.5f;
        }
        E(acc, cur, wr, wc, fr, fq);
        if constexpr (Epi::IDEM) { if (EPI_DOUBLE) { asm volatile("" ::: "memory"); E(acc, cur, wr, wc, fr, fq); } }
        }
        if (!has_next) break;
        if (cur.second) {
#pragma unroll
        for (int a = 0; a < 2; ++a)
#pragma unroll
            for (int b = 0; b < 2; ++b)
#pragma unroll
                for (int m = 0; m < 4; ++m)
#pragma unroll
                    for (int n = 0; n < 2; ++n) acc[a][b][m][n] = (f32x4){0.f, 0.f, 0.f, 0.f};
        }
        cur = nxt; cA = nA; cB = nB; ++ui;
        if constexpr (ALIGN_EPI) { if (wr == 1) PG8_BAR; }
    }
    PG8_WAIT_V(0);
    if constexpr (!ALIGN_EPI) { if (wr == 0) PG8_BAR; }
    PG8_BAR;
#undef PG8_SA
#undef PG8_SB
#undef PG8_STAGE
#undef PG8_LDA
#undef PG8_LDB
#undef PG8_MMA
#undef PG8_WAIT_V
#undef PG8_WAIT_L
#undef PG8_BAR
#undef PG8_SCHED
}
}
using pg8::Unit;

struct EpiIn {
    static constexpr bool IDEM = true;
    static constexpr bool MID = false;
    bf16_t* big; const float* qn_a; const float* kn_a; const float* qn_b; const float* kn_b; const f32x2* rope;
    __device__ __forceinline__ void operator()(const f32x4 (&acc)[2][2][4][2], const Unit& u, int wr, int wc, int fr, int fq) const {
        const int hg = u.pn * 4 + wc;
        int kind; bf16_t* dst; int pitch, hcol; const float* gain = nullptr;
        if (hg < 6)       { kind = 1 | 256; dst = big + B_QA; pitch = 384; hcol = hg * 64; gain = qn_a; }
        else if (hg < 12) { kind = 1;       dst = big + B_KA; pitch = 384; hcol = (hg - 6) * 64; gain = kn_a; }
        else if (hg < 18) { kind = 3;       dst = big + B_VAT; pitch = T; hcol = (hg - 12) * 64; }
        else if (hg < 24) { kind = 2 | 256; dst = big + B_QB; pitch = 384; hcol = (hg - 18) * 64; gain = qn_b; }
        else if (hg < 26) { kind = 2;       dst = big + B_KB; pitch = 128; hcol = (hg - 24) * 64; gain = kn_b; }
        else if (hg < 28) { kind = 3;       dst = big + B_VBT; pitch = T; hcol = (hg - 26) * 64; }
        else if (hg < 32) { kind = 0;       dst = big + B_PC; pitch = 256; hcol = (hg - 28) * 64; }
        else              { kind = 4;       dst = big + B_G; pitch = 3072; hcol = (hg - 32) * 64; }
        const int k = kind & 255; const float qs = (kind & 256) ? QSCALE : 1.0f;
        f32x4 gv[2][2];
        if (k == 1 || k == 2) {
#pragma unroll
            for (int bj = 0; bj < 2; ++bj)
#pragma unroll
                for (int n = 0; n < 2; ++n) gv[bj][n] = *(const f32x4*)(gain + 32 * bj + 16 * n + 4 * fq) * qs;
        }
        f32x4 ropeR[2][2], ropeC[4][2];
        const bool do_rope = (k == 2 && u.pm * 256 < TL);
        if (do_rope) {
#pragma unroll
            for (int m = 0; m < 4; ++m) { const int pos = m * 16 + fr; const f32x4* rp = (const f32x4*)(rope + pos * 16 + 4 * fq); ropeC[m][0] = rp[0]; ropeC[m][1] = rp[1]; }
            __builtin_amdgcn_sched_barrier(0);
        }
#pragma unroll
        for (int ai = 0; ai < 2; ++ai) {
            if (do_rope) { const int pos = ((u.pm * 256 + ai * 128 + wr * 64) & (SEQ - 1)) >> 6; const f32x4* rp = (const f32x4*)(rope + pos * 16 + 4 * fq); ropeR[ai][0] = rp[0]; ropeR[ai][1] = rp[1]; }
#pragma unroll
            for (int m = 0; m < 4; ++m) {
                const int row = u.pm * 256 + ai * 128 + wr * 64 + m * 16 + fr;
                f32x4 v[2][2];
#pragma unroll
                for (int bj = 0; bj < 2; ++bj)
#pragma unroll
                    for (int n = 0; n < 2; ++n) v[bj][n] = acc[ai][bj][m][n];
                if (k == 1 || k == 2) {
                    float ss = 0.f;
#pragma unroll
                    for (int bj = 0; bj < 2; ++bj)
#pragma unroll
                        for (int n = 0; n < 2; ++n) { const f32x4 x = v[bj][n]; ss += (x[0] * x[0] + x[1] * x[1]) + (x[2] * x[2] + x[3] * x[3]); }
                    ss += __shfl_xor(ss, 16); ss += __shfl_xor(ss, 32);
                    const float rinv = __builtin_amdgcn_rsqf(ss * (1.0f / 64.0f) + EPS);
#pragma unroll
                    for (int bj = 0; bj < 2; ++bj)
#pragma unroll
                        for (int n = 0; n < 2; ++n) v[bj][n] = v[bj][n] * rinv * gv[bj][n];
                    if (k == 2 && row < TL) {
#pragma unroll
                        for (int bj = 0; bj < 2; ++bj) {
                            const f32x4 q0 = bj ? ropeC[m][0] : ropeR[ai][0], q1 = bj ? ropeC[m][1] : ropeR[ai][1];
                            const float cs[4] = {q0[0], q0[2], q1[0], q1[2]}, sn[4] = {q0[1], q0[3], q1[1], q1[3]};
#pragma unroll
                            for (int j = 0; j < 4; ++j) { const float x1 = v[bj][0][j], x2 = v[bj][1][j];
                                v[bj][0][j] = x1 * cs[j] - x2 * sn[j]; v[bj][1][j] = x2 * cs[j] + x1 * sn[j]; }
                        }
                    }
                } else if (k == 4) {
#pragma unroll
                    for (int bj = 0; bj < 2; ++bj)
#pragma unroll
                        for (int n = 0; n < 2; ++n)
#pragma unroll
                            for (int j = 0; j < 4; ++j) v[bj][n][j] = sigmoidf_(v[bj][n][j]);
                }
                if (k == 3) {
#pragma unroll
                    for (int bj = 0; bj < 2; ++bj)
#pragma unroll
                        for (int n = 0; n < 2; ++n)
#pragma unroll
                            for (int j = 0; j < 4; ++j) dst[(size_t)(hcol + 32 * bj + 16 * n + 4 * fq + j) * T + row] = (bf16_t)f2bf(v[bj][n][j]);
                } else {
                    bf16_t* rp = dst + (size_t)row * pitch + hcol + 4 * fq;
#pragma unroll
                    for (int bj = 0; bj < 2; ++bj)
#pragma unroll
                        for (int n = 0; n < 2; ++n) { u32x2 w; w.x = pk2(v[bj][n][0], v[bj][n][1]); w.y = pk2(v[bj][n][2], v[bj][n][3]); *(u32x2*)(rp + 32 * bj + 16 * n) = w; }
                }
            }
        }
    }
};

struct EpiMerge {
    static constexpr bool IDEM = false;
    static constexpr bool MID = true;
    const bf16_t* G; bf16_t* Mo;
    __device__ __forceinline__ void mid(f32x4 (&acc)[2][2][4][2], const Unit& u, int which, int wr, int wc, int fr, int fq) const {
        const bf16_t* g0 = G + (size_t)(u.pm * 256 + wr * 64 + fr) * 3072 + which * 1024 + u.pn * 256 + 32 * wc + 8 * fq;
#pragma unroll
        for (int ai = 0; ai < 2; ++ai) {
            u32x4 ga[4][2], gb[4][2];
#pragma unroll
            for (int m = 0; m < 4; ++m)
#pragma unroll
                for (int bj = 0; bj < 2; ++bj) { const bf16_t* gp = g0 + (size_t)(ai * 128 + m * 16) * 3072 + 128 * bj; ga[m][bj] = *(const u32x4*)gp; gb[m][bj] = *(const u32x4*)(gp + 1024); }
            __builtin_amdgcn_sched_barrier(0);
#pragma unroll
            for (int m = 0; m < 4; ++m)
#pragma unroll
                for (int bj = 0; bj < 2; ++bj) {
                    const u32x4 a = ga[m][bj], b = gb[m][bj];
#pragma unroll
                    for (int n = 0; n < 2; ++n) {
                        const unsigned a0 = n ? a.z : a.x, a1 = n ? a.w : a.y, b0 = n ? b.z : b.x, b1 = n ? b.w : b.y;
                        acc[ai][bj][m][n][0] *= bflo(a0) * fast_rcp(bflo(b0)); acc[ai][bj][m][n][1] *= bfhi(a0) * fast_rcp(bfhi(b0));
                        acc[ai][bj][m][n][2] *= bflo(a1) * fast_rcp(bflo(b1)); acc[ai][bj][m][n][3] *= bfhi(a1) * fast_rcp(bfhi(b1));
                    }
                }
            __builtin_amdgcn_sched_barrier(0);
        }
    }
    __device__ __forceinline__ void operator()(const f32x4 (&acc)[2][2][4][2], const Unit& u, int wr, int wc, int fr, int fq) const {
        const size_t r0 = (size_t)(u.pm * 256 + wr * 64 + fr); const int c0 = u.pn * 256 + 32 * wc + 8 * fq;
        u32x4 gc[2][4][2];
#pragma unroll
        for (int ai = 0; ai < 2; ++ai)
#pragma unroll
            for (int m = 0; m < 4; ++m)
#pragma unroll
                for (int bj = 0; bj < 2; ++bj) gc[ai][m][bj] = *(const u32x4*)(G + (r0 + ai * 128 + m * 16) * 3072 + 2048 + c0 + 128 * bj);
        __builtin_amdgcn_sched_barrier(0);
#pragma unroll
        for (int ai = 0; ai < 2; ++ai)
#pragma unroll
            for (int m = 0; m < 4; ++m)
#pragma unroll
                for (int bj = 0; bj < 2; ++bj) {
                    const u32x4 c = gc[ai][m][bj];
                    const f32x4 x0 = acc[ai][bj][m][0], x1 = acc[ai][bj][m][1];
                    u32x4 w;
                    w.x = pk2(x0[0] * bflo(c.x), x0[1] * bfhi(c.x)); w.y = pk2(x0[2] * bflo(c.y), x0[3] * bfhi(c.y));
                    w.z = pk2(x1[0] * bflo(c.z), x1[1] * bfhi(c.z)); w.w = pk2(x1[2] * bflo(c.w), x1[3] * bfhi(c.w));
                    *(u32x4*)(Mo + (r0 + ai * 128 + m * 16) * D + c0 + 128 * bj) = w;
                }
    }
};

struct EpiRes {
    static constexpr bool IDEM = false;
    static constexpr bool MID = false;
    const float* xs; float* xd; const float* hs; float* hd; const float* modl; int goff;
    __device__ __forceinline__ void operator()(const f32x4 (&acc)[2][2][4][2], const Unit& u, int wr, int wc, int fr, int fq) const {
        const int row0 = u.pm * 256; const bool lat = row0 < TL;
        const int b = lat ? (row0 >> 11) : 32;
        const float* src = (lat ? xs + (size_t)row0 * D : hs + (size_t)(row0 - TL) * D) + (size_t)(wr * 64 + fr) * D + u.pn * 256 + 32 * wc + 8 * fq;
        float* dst = (lat ? xd + (size_t)row0 * D : hd + (size_t)(row0 - TL) * D) + (size_t)(wr * 64 + fr) * D + u.pn * 256 + 32 * wc + 8 * fq;
        const float* gp = modl + (size_t)b * NMOD + goff + u.pn * 256 + 32 * wc + 8 * fq;
        f32x4 g[2][2];
#pragma unroll
        for (int bj = 0; bj < 2; ++bj) { g[bj][0] = *(const f32x4*)(gp + 128 * bj); g[bj][1] = *(const f32x4*)(gp + 128 * bj + 4); }
        f32x4 s[2][4][2];
#define ER_LOAD(k) do { const int bj_ = (k) >> 1, ai_ = (k) & 1; _Pragma("unroll") for (int m = 0; m < 4; ++m) { const size_t o = (size_t)(ai_ * 128 + m * 16) * D + 128 * bj_; \
            s[(k) & 1][m][0] = *(const f32x4*)(src + o); s[(k) & 1][m][1] = *(const f32x4*)(src + o + 4); } } while (0)
#define ER_STORE(k) do { const int bj_ = (k) >> 1, ai_ = (k) & 1; _Pragma("unroll") for (int m = 0; m < 4; ++m) { const size_t o = (size_t)(ai_ * 128 + m * 16) * D + 128 * bj_; \
            *(f32x4*)(dst + o) = s[(k) & 1][m][0] + g[bj_][0] * acc[ai_][bj_][m][0]; *(f32x4*)(dst + o + 4) = s[(k) & 1][m][1] + g[bj_][1] * acc[ai_][bj_][m][1]; } } while (0)
        ER_LOAD(0); __builtin_amdgcn_sched_barrier(0);
        ER_LOAD(1); __builtin_amdgcn_sched_barrier(0);
        ER_STORE(0); __builtin_amdgcn_sched_barrier(0);
        ER_LOAD(2); __builtin_amdgcn_sched_barrier(0);
        ER_STORE(1); __builtin_amdgcn_sched_barrier(0);
        ER_LOAD(3); __builtin_amdgcn_sched_barrier(0);
        ER_STORE(2); __builtin_amdgcn_sched_barrier(0);
        ER_STORE(3);
#undef ER_LOAD
#undef ER_STORE
    }
};

struct EpiResNorm {
    static constexpr bool IDEM = false;
    static constexpr bool MID = false;
    const float* xs; float* xd; const float* hs; float* hd; const float* modl; int goff;
    const float* ngain; const float* nmod; int nshift; bf16_t* U; float* slots; unsigned* cnt; LAS unsigned char* xl;
    __device__ __forceinline__ void operator()(f32x4 (&acc)[2][2][4][2], const Unit& u, int wr, int wc, int fr, int fq) const {
        const int row0 = u.pm * 256; const bool lat = row0 < TL;
        const int b = lat ? (row0 >> 11) : 32;
        const float* src = (lat ? xs + (size_t)row0 * D : hs + (size_t)(row0 - TL) * D) + (size_t)(wr * 64 + fr) * D + u.pn * 256 + 32 * wc + 8 * fq;
        float* dst = (lat ? xd + (size_t)row0 * D : hd + (size_t)(row0 - TL) * D) + (size_t)(wr * 64 + fr) * D + u.pn * 256 + 32 * wc + 8 * fq;
        const float* gp = modl + (size_t)b * NMOD + goff + u.pn * 256 + 32 * wc + 8 * fq;
        {
        f32x4 g[2][2];
#pragma unroll
        for (int bj = 0; bj < 2; ++bj) { g[bj][0] = *(const f32x4*)(gp + 128 * bj); g[bj][1] = *(const f32x4*)(gp + 128 * bj + 4); }
        f32x4 s[4][2];
#define ER_LOAD(k) do { const int bj_ = (k) >> 1, ai_ = (k) & 1; _Pragma("unroll") for (int m = 0; m < 4; ++m) { const size_t o = (size_t)(ai_ * 128 + m * 16) * D + 128 * bj_; \
            s[m][0] = *(const f32x4*)(src + o); s[m][1] = *(const f32x4*)(src + o + 4); } } while (0)
#define ER_STORE(k) do { const int bj_ = (k) >> 1, ai_ = (k) & 1; _Pragma("unroll") for (int m = 0; m < 4; ++m) { const size_t o = (size_t)(ai_ * 128 + m * 16) * D + 128 * bj_; \
            acc[ai_][bj_][m][0] = s[m][0] + g[bj_][0] * acc[ai_][bj_][m][0]; acc[ai_][bj_][m][1] = s[m][1] + g[bj_][1] * acc[ai_][bj_][m][1]; \
            *(f32x4*)(dst + o) = acc[ai_][bj_][m][0]; *(f32x4*)(dst + o + 4) = acc[ai_][bj_][m][1]; } } while (0)
        ER_LOAD(0); __builtin_amdgcn_sched_barrier(0); ER_STORE(0); __builtin_amdgcn_sched_barrier(0);
        ER_LOAD(1); __builtin_amdgcn_sched_barrier(0); ER_STORE(1); __builtin_amdgcn_sched_barrier(0);
        ER_LOAD(2); __builtin_amdgcn_sched_barrier(0); ER_STORE(2); __builtin_amdgcn_sched_barrier(0);
        ER_LOAD(3); __builtin_amdgcn_sched_barrier(0); ER_STORE(3); __builtin_amdgcn_sched_barrier(0);
#undef ER_LOAD
#undef ER_STORE
        }
        LAS float* P = (LAS float*)xl; LAS float* S = P + 1024;
        const int tid = (wr * 4 + wc) * 64 + fq * 16 + fr;
#pragma unroll
        for (int ai = 0; ai < 2; ++ai)
#pragma unroll
            for (int m = 0; m < 4; ++m) {
                float ss = 0.f;
#pragma unroll
                for (int bj = 0; bj < 2; ++bj)
#pragma unroll
                    for (int n = 0; n < 2; ++n) { const f32x4 x = acc[ai][bj][m][n]; ss += (x[0] * x[0] + x[1] * x[1]) + (x[2] * x[2] + x[3] * x[3]); }
                ss += __shfl_xor(ss, 16); ss += __shfl_xor(ss, 32);
                if (fq == 0) P[(ai * 128 + wr * 64 + m * 16 + fr) * 4 + wc] = ss;
            }
        asm volatile("s_waitcnt lgkmcnt(0)" ::: "memory"); __builtin_amdgcn_s_barrier(); asm volatile("" ::: "memory");
        if (tid < 256) {
            const float tot = (P[tid * 4 + 0] + P[tid * 4 + 1]) + (P[tid * 4 + 2] + P[tid * 4 + 3]);
            __hip_atomic_store(slots + (size_t)(row0 + tid) * 4 + u.pn, tot, __ATOMIC_RELAXED, __HIP_MEMORY_SCOPE_AGENT);
        }
        asm volatile("s_waitcnt vmcnt(0)" ::: "memory");
        if (tid < 256 && (tid & 63) == 0) __hip_atomic_fetch_add(cnt + u.pm, 1u, __ATOMIC_RELAXED, __HIP_MEMORY_SCOPE_AGENT);
        if (tid < 64) {
            unsigned sp = 0;
            while (__hip_atomic_load(cnt + u.pm, __ATOMIC_RELAXED, __HIP_MEMORY_SCOPE_AGENT) < 16u) { __builtin_amdgcn_s_sleep(2); if (++sp > (1u << 22)) break; }
            __builtin_amdgcn_fence(__ATOMIC_ACQUIRE, "agent");
        }
        asm volatile("s_waitcnt vmcnt(0) lgkmcnt(0)" ::: "memory"); __builtin_amdgcn_s_barrier(); asm volatile("" ::: "memory");
        if (tid < 256) {
            const float* sl = slots + (size_t)(row0 + tid) * 4;
            const float t4 = (__hip_atomic_load(sl + 0, __ATOMIC_RELAXED, __HIP_MEMORY_SCOPE_AGENT) + __hip_atomic_load(sl + 1, __ATOMIC_RELAXED, __HIP_MEMORY_SCOPE_AGENT))
                           + (__hip_atomic_load(sl + 2, __ATOMIC_RELAXED, __HIP_MEMORY_SCOPE_AGENT) + __hip_atomic_load(sl + 3, __ATOMIC_RELAXED, __HIP_MEMORY_SCOPE_AGENT));
            S[tid] = __builtin_amdgcn_rsqf(t4 * (1.0f / D) + EPS);
        }
        asm volatile("s_waitcnt lgkmcnt(0)" ::: "memory"); __builtin_amdgcn_s_barrier(); asm volatile("" ::: "memory");
        const float* mp = nmod + (size_t)b * NMOD + nshift + u.pn * 256 + 32 * wc + 8 * fq;
        const float* ng = ngain + u.pn * 256 + 32 * wc + 8 * fq;
        bf16_t* up = U + (size_t)(row0 + wr * 64 + fr) * D + u.pn * 256 + 32 * wc + 8 * fq;
#pragma unroll
        for (int bj = 0; bj < 2; ++bj) {
            const f32x4 sh0 = *(const f32x4*)(mp + 128 * bj), sh1 = *(const f32x4*)(mp + 128 * bj + 4);
            const f32x4 gs0 = *(const f32x4*)(ng + 128 * bj) * (*(const f32x4*)(mp + D + 128 * bj) + 1.0f), gs1 = *(const f32x4*)(ng + 128 * bj + 4) * (*(const f32x4*)(mp + D + 128 * bj + 4) + 1.0f);
#pragma unroll
            for (int ai = 0; ai < 2; ++ai)
#pragma unroll
                for (int m = 0; m < 4; ++m) {
                    const float rstd = S[ai * 128 + wr * 64 + m * 16 + fr];
                    const f32x4 y0 = acc[ai][bj][m][0] * rstd * gs0 + sh0, y1 = acc[ai][bj][m][1] * rstd * gs1 + sh1;
                    u32x4 w; w.x = pk2(y0[0], y0[1]); w.y = pk2(y0[2], y0[3]); w.z = pk2(y1[0], y1[1]); w.w = pk2(y1[2], y1[3]);
                    *(u32x4*)(up + (size_t)(ai * 128 + m * 16) * D + 128 * bj) = w;
                }
        }
    }
};

struct EpiFF1 {
    static constexpr bool IDEM = true;
    static constexpr bool MID = false;
    bf16_t* H1;
    __device__ __forceinline__ void operator()(const f32x4 (&acc)[2][2][4][2], const Unit& u, int wr, int wc, int fr, int fq) const {
        const int col = u.pn * 128 + 32 * wc + 8 * fq;
#pragma unroll
        for (int ai = 0; ai < 2; ++ai)
#pragma unroll
            for (int m = 0; m < 4; ++m) {
                const int row = u.pm * 256 + ai * 128 + wr * 64 + m * 16 + fr;
                float r[8];
#pragma unroll
                for (int n = 0; n < 2; ++n)
#pragma unroll
                    for (int j = 0; j < 4; ++j) { const float a = acc[ai][0][m][n][j], b = acc[ai][1][m][n][j]; r[4 * n + j] = a * sigmoidf_(a) * b; }
                u32x4 w; w.x = pk2(r[0], r[1]); w.y = pk2(r[2], r[3]); w.z = pk2(r[4], r[5]); w.w = pk2(r[6], r[7]);
                *(u32x4*)(H1 + (size_t)row * FF + col) = w;
            }
    }
};

struct EpiMod {
    static constexpr bool IDEM = false;
    static constexpr bool MID = false;
    float* mod; const float* bmod;
    __device__ __forceinline__ void operator()(const f32x4 (&acc)[2][2][4][2], const Unit& u, int wr, int wc, int fr, int fq) const {
        if (wr != 0) return;
#pragma unroll
        for (int m = 0; m < 3; ++m) {
            const int row = m * 16 + fr; if (row >= 33) continue;
#pragma unroll
            for (int bj = 0; bj < 2; ++bj)
#pragma unroll
                for (int n = 0; n < 2; ++n) {
                    const int nn = u.pn * 256 + 128 * bj + 32 * wc + 16 * n + 4 * fq;
                    const int l = nn / NMOD, c = nn - l * NMOD;
                    const f32x4 bv = *(const f32x4*)(bmod + nn);
                    *(f32x4*)(mod + ((size_t)l * 33 + row) * NMOD + c) = acc[0][bj][m][n] + bv;
                }
        }
    }
};

struct Args { const float* in[23]; float* out; unsigned char* ws; float freq[16]; int ph_lo, ph_hi; };
typedef const __attribute__((address_space(4))) Args* KArgsPtr;

__device__ __forceinline__ int p8map(int p) { return (p & 0xe0) | (((p >> 2) & 3) << 3) | (((p >> 4) & 1) << 2) | (p & 3); }
__device__ __forceinline__ void prep_item(KArgsPtr a, unsigned char* ws, int l, int mid, int item, LAS float* scr, int lane) {
    int K, N; if (mid == 0) { K = D; N = NIN; } else if (mid == 1 || mid == 2) { K = D; N = D; } else if (mid == 3) { K = D; N = 2 * FF; } else if (mid == 4) { K = FF; N = D; } else { K = D; N = NMOD; }
    const int nblk = N / 32, kb = item / nblk, nb = item % nblk, k0 = 64 * kb, n0 = 32 * nb;
    const int r = n0 + (lane & 31), tile = r >> 8, p = r & 255;
    const float* src; int ld, col, krow = k0; bf16_t* WT;
    if (mid == 0) { src = a->in[8] + (size_t)l * D * NIN; ld = NIN; col = tile * 256 + ((p >> 5) & 3) * 64 + (p >> 7) * 32 + (p & 31); WT = (bf16_t*)(ws + WS_WIN) + (size_t)l * NIN * D; }
    else if (mid == 1) { ld = D; col = tile * 256 + p8map(p); WT = (bf16_t*)(ws + WS_WBR) + (size_t)l * D * D;
        if (k0 < 384) { src = a->in[16] + (size_t)l * 384 * D; } else if (k0 < 768) { src = a->in[17] + (size_t)l * 384 * D; krow = k0 - 384; } else { src = a->in[18] + (size_t)l * 256 * D; krow = k0 - 768; } }
    else if (mid == 2) { src = a->in[19] + (size_t)l * D * D; ld = D; col = tile * 256 + p8map(p); WT = (bf16_t*)(ws + WS_WOUT) + (size_t)l * D * D; }
    else if (mid == 3) { src = ((p >> 7) ? a->in[21] : a->in[20]) + (size_t)l * D * FF; ld = FF; col = tile * 128 + (p8map(p) & 127); WT = (bf16_t*)(ws + WS_W13) + (size_t)l * 2 * FF * D; }
    else if (mid == 4) { src = a->in[22] + (size_t)l * FF * D; ld = D; col = tile * 256 + p8map(p); WT = (bf16_t*)(ws + WS_W2) + (size_t)l * D * FF; }
    else { src = a->in[4] + (size_t)l * D * NMOD; ld = NMOD; col = r; WT = (bf16_t*)(ws + WS_BIG) + (size_t)l * NMOD * D; }
#pragma unroll 8
    for (int i = 0; i < 32; ++i) { const int kk = 2 * i + (lane >> 5); scr[kk * 33 + (lane & 31)] = src[(size_t)(krow + kk) * ld + col]; }
    asm volatile("s_waitcnt lgkmcnt(0)" ::: "memory");
    const int c = lane & 7;
#pragma unroll
    for (int j = 0; j < 4; ++j) { const int n = (lane >> 3) + 8 * j; const LAS float* s = scr + (8 * c) * 33 + n;
        u32x4 o; o.x = pk2(s[0 * 33], s[1 * 33]); o.y = pk2(s[2 * 33], s[3 * 33]); o.z = pk2(s[4 * 33], s[5 * 33]); o.w = pk2(s[6 * 33], s[7 * 33]);
        *(u32x4*)(WT + (size_t)(n0 + n) * K + k0 + 8 * c) = o; }
    asm volatile("s_waitcnt lgkmcnt(0)" ::: "memory");
}

__device__ __forceinline__ void prep_phase(KArgsPtr a, LAS unsigned char* lds, int tid, int wid, int lane, int bid, int nblk_) {
    unsigned char* ws = a->ws;
    LAS float* scr = (LAS float*)(lds + wid * 8704);
    const int gw = bid * 8 + wid, NGW = nblk_ * 8;
    constexpr int I0 = 16 * 160, I1 = 16 * 32, I2 = 16 * 32, I3 = 16 * 176, I4 = 44 * 32, I5 = 16 * 192, IL = I0 + I1 + I2 + I3 + I4 + I5;
    for (int it = gw; it < IL * DEPTH; it += NGW) {
        const int l = it / IL; int r = it - l * IL; int mid;
        if (r < I0) mid = 0; else if ((r -= I0) < I1) mid = 1; else if ((r -= I1) < I2) mid = 2; else if ((r -= I2) < I3) mid = 3; else if ((r -= I3) < I4) mid = 4; else { r -= I4; mid = 5; }
        prep_item(a, ws, l, mid, r, scr, lane);
    }
    bf16_t* SC = (bf16_t*)(ws + WS_SC);
    for (int i = bid * 512 + tid; i < 256 * 1024; i += nblk_ * 512) {
        const int row = i >> 10, k = i & 1023; float v = 0.f;
        if (row < 32) v = a->in[1][row * D + k]; else if (row == 32) v = a->in[3][k];
        SC[i] = (bf16_t)f2bf(row <= 32 ? v * sigmoidf_(v) : 0.f);
    }
    f32x2* rope = (f32x2*)(ws + WS_ROPE);
    for (int i = bid * 512 + tid; i < 64 * 16; i += nblk_ * 512) {
        const int pos = i >> 4, fi = i & 15;
        const float ang = (float)pos * a->freq[fi];
        float rev = ang * 0.15915494309189535f; rev = rev - floorf(rev);
        rope[i] = (f32x2){__builtin_amdgcn_cosf(rev), __builtin_amdgcn_sinf(rev)};
    }
}

__device__ __forceinline__ void norm_phase(const float* xl, const float* xc, const float* gain, const float* modl, int shift_off, int nrows, bf16_t* U, int wid, int lane, int bid, int nblk_) {
    const int gw = bid * 8 + wid, NGW = nblk_ * 8;
    f32x4 gv[4];
#pragma unroll
    for (int j = 0; j < 4; ++j) gv[j] = *(const f32x4*)(gain + 4 * (lane + 64 * j));
    for (int row0 = gw; row0 < nrows; row0 += 4 * NGW) {
        f32x4 v[4][4]; float ss[4];
#pragma unroll
        for (int r = 0; r < 4; ++r) {
            const int row = row0 + r * NGW; ss[r] = 0.f;
            if (row < nrows) {
                const float* src = row < TL ? xl + (size_t)row * D : xc + (size_t)(row - TL) * D;
#pragma unroll
                for (int j = 0; j < 4; ++j) v[r][j] = *(const f32x4*)(src + 4 * (lane + 64 * j));
            } else {
#pragma unroll
                for (int j = 0; j < 4; ++j) v[r][j] = (f32x4){0.f, 0.f, 0.f, 0.f};
            }
        }
#pragma unroll
        for (int r = 0; r < 4; ++r) {
            const int row = row0 + r * NGW;
            if (row >= nrows) continue;
#pragma unroll
            for (int j = 0; j < 4; ++j) ss[r] += (v[r][j][0] * v[r][j][0] + v[r][j][1] * v[r][j][1]) + (v[r][j][2] * v[r][j][2] + v[r][j][3] * v[r][j][3]);
            const float rstd = __builtin_amdgcn_rsqf(wave_sum(ss[r]) * (1.0f / D) + EPS);
            const int b = row < TL ? (row >> 11) : 32;
            const float* mp = modl + (size_t)b * NMOD + shift_off;
#pragma unroll
            for (int j = 0; j < 4; ++j) {
                const int c = 4 * (lane + 64 * j);
                const f32x4 sh = *(const f32x4*)(mp + c), sc = *(const f32x4*)(mp + D + c);
                const f32x4 y = v[r][j] * rstd * gv[j] * (sc + 1.0f) + sh;
                u32x2 w; w.x = pk2(y[0], y[1]); w.y = pk2(y[2], y[3]);
                *(u32x2*)(U + (size_t)row * D + c) = w;
            }
        }
    }
}

struct AttnJob {
    const bf16_t* Q; int qpitch;
    const bf16_t* K; int kpitch;
    const bf16_t* Vt;
    bf16_t* O;
    int ctx_row0, lat_row0, ntiles;
    int na, r0, rlo;
    int fast;
};
#define MFMA32(a, b, c) __builtin_amdgcn_mfma_f32_32x32x16_bf16((a), (b), (c), 0, 0, 0)

__device__ __forceinline__ void glds16(const void* gsrc, unsigned lds_dst) { unsigned keep;
    asm volatile("s_mov_b32 %0, m0\n\ts_mov_b32 m0, %2\n\ts_nop 0\n\tglobal_load_lds_dwordx4 %1, off\n\ts_mov_b32 m0, %0" : "=&s"(keep) : "v"(gsrc), "s"(lds_dst) : "memory"); }
template <bool FAST>
__device__ __forceinline__ void att_scores(const LAS unsigned char* kb_, const bf16x8 (&qf)[4], int pi, int kx, int hi, bool local, const LAS float* bp, unsigned vmask, bool first,
                                           float& mrun, f32x16& o0, f32x16& o1, float& lrun, bf16x8 (&pf)[2][2]) {
    constexpr float THR = 8.0f;
    f32x16 s0, s1;
    if constexpr (FAST) {
#pragma unroll
        for (int i = 0; i < 16; ++i) { s0[i] = 0.f; s1[i] = 0.f; }
    } else {
        const float nm = -mrun;
#pragma unroll
        for (int i = 0; i < 16; ++i) { s0[i] = nm; s1[i] = nm; }
    }
    {
        bf16x8 a0[4], a1[4];
#pragma unroll
        for (int ks = 0; ks < 4; ++ks) { a0[ks] = *(const LAS bf16x8*)(kb_ + pi * 128 + (((2 * ks + hi) ^ kx) << 4)); a1[ks] = *(const LAS bf16x8*)(kb_ + (32 + pi) * 128 + (((2 * ks + hi) ^ kx) << 4)); }
        __builtin_amdgcn_sched_barrier(0);
#pragma unroll
        for (int ks = 0; ks < 4; ++ks) s0 = MFMA32(a0[ks], qf[ks], s0);
#pragma unroll
        for (int ks = 0; ks < 4; ++ks) s1 = MFMA32(a1[ks], qf[ks], s1);
    }
    if (local) {
#pragma unroll
        for (int i = 0; i < 16; ++i) {
            const float b0 = bp[16 * (i >> 3) + (i & 7)], b1 = bp[32 + 16 * (i >> 3) + (i & 7)];
            const unsigned m0 = (unsigned)__builtin_amdgcn_sbfe((int)vmask, i, 1), m1 = (unsigned)__builtin_amdgcn_sbfe((int)vmask, 16 + i, 1);
            const unsigned v0 = __builtin_bit_cast(unsigned, s0[i] + b0), v1 = __builtin_bit_cast(unsigned, s1[i] + b1);
            s0[i] = __builtin_bit_cast(float, (v0 & m0) | (0xf149f2cau & ~m0));
            s1[i] = __builtin_bit_cast(float, (v1 & m1) | (0xf149f2cau & ~m1));
            if ((i & 3) == 3) __builtin_amdgcn_sched_barrier(0);
        }
    }
    if constexpr (!FAST) {
    float mt = fmaxf(s0[0], s1[0]);
#pragma unroll
    for (int i = 1; i < 16; ++i) mt = fmaxf(mt, fmaxf(s0[i], s1[i]));
    mt = fmaxf(mt, __shfl_xor(mt, 32));
    if (first || __any(mt > THR)) {
        const float delta = first ? mt : (mt > THR ? mt : 0.f);
        const float alpha = first ? 1.0f : fast_exp2(-delta);
        mrun += delta;
#pragma unroll
        for (int i = 0; i < 16; ++i) { s0[i] -= delta; s1[i] -= delta; o0[i] *= alpha; o1[i] *= alpha; }
        lrun *= alpha;
    }
    }
    float rs = 0.f;
#pragma unroll
    for (int i = 0; i < 16; ++i) { s0[i] = fast_exp2(s0[i]); s1[i] = fast_exp2(s1[i]); rs += s0[i] + s1[i]; }
    lrun += rs;
#pragma unroll
    for (int cc = 0; cc < 2; ++cc) {
        u32x4 w0, w1;
        w0.x = pk2(s0[8 * cc + 0], s0[8 * cc + 1]); w0.y = pk2(s0[8 * cc + 2], s0[8 * cc + 3]); w0.z = pk2(s0[8 * cc + 4], s0[8 * cc + 5]); w0.w = pk2(s0[8 * cc + 6], s0[8 * cc + 7]);
        w1.x = pk2(s1[8 * cc + 0], s1[8 * cc + 1]); w1.y = pk2(s1[8 * cc + 2], s1[8 * cc + 3]); w1.z = pk2(s1[8 * cc + 4], s1[8 * cc + 5]); w1.w = pk2(s1[8 * cc + 6], s1[8 * cc + 7]);
        pf[0][cc] = __builtin_bit_cast(bf16x8, w0); pf[1][cc] = __builtin_bit_cast(bf16x8, w1);
    }
}
__device__ __forceinline__ void att_pv(const LAS unsigned char* vb_, int q, int vx, int hi, const bf16x8 (&pf)[2][2], f32x16& o0, f32x16& o1) {
#pragma unroll
    for (int kb = 0; kb < 2; ++kb) {
        bf16x8 v0[2], v1[2];
#pragma unroll
        for (int cc = 0; cc < 2; ++cc) { const int ch = 4 * kb + 2 * cc + hi;
            v0[cc] = *(const LAS bf16x8*)(vb_ + q * 128 + ((ch ^ vx) << 4)); v1[cc] = *(const LAS bf16x8*)(vb_ + (32 + q) * 128 + ((ch ^ vx) << 4)); }
        __builtin_amdgcn_sched_barrier(0);
#pragma unroll
        for (int cc = 0; cc < 2; ++cc) { o0 = MFMA32(v0[cc], pf[kb][cc], o0); o1 = MFMA32(v1[cc], pf[kb][cc], o1); }
        __builtin_amdgcn_sched_barrier(0);
    }
}

__device__ __forceinline__ void att_tile_fast(const LAS unsigned char* kb_, const LAS unsigned char* vb_, const bf16x8 (&qf)[4], int pi, int kx, int q, int vx, int hi,
                                              f32x16& o0, f32x16& o1, float& lrun) {
    bf16x8 a0[4], a1[4];
#pragma unroll
    for (int ks = 0; ks < 4; ++ks) { a0[ks] = *(const LAS bf16x8*)(kb_ + pi * 128 + (((2 * ks + hi) ^ kx) << 4)); a1[ks] = *(const LAS bf16x8*)(kb_ + (32 + pi) * 128 + (((2 * ks + hi) ^ kx) << 4)); }
    __builtin_amdgcn_sched_barrier(0);
    f32x16 s0, s1;
#pragma unroll
    for (int i = 0; i < 16; ++i) { s0[i] = 0.f; s1[i] = 0.f; }
#pragma unroll
    for (int ks = 0; ks < 4; ++ks) s0 = MFMA32(a0[ks], qf[ks], s0);
    __builtin_amdgcn_sched_barrier(0);
    float rs = 0.f;
#pragma unroll
    for (int ks = 0; ks < 4; ++ks) {
        s1 = MFMA32(a1[ks], qf[ks], s1);
#pragma unroll
        for (int i = 4 * ks; i < 4 * ks + 4; ++i) { s0[i] = fast_exp2(s0[i]); rs += s0[i]; }
        __builtin_amdgcn_sched_barrier(0);
    }
    bf16x8 p0[2];
#pragma unroll
    for (int cc = 0; cc < 2; ++cc) { u32x4 w; w.x = pk2(s0[8 * cc + 0], s0[8 * cc + 1]); w.y = pk2(s0[8 * cc + 2], s0[8 * cc + 3]); w.z = pk2(s0[8 * cc + 4], s0[8 * cc + 5]); w.w = pk2(s0[8 * cc + 6], s0[8 * cc + 7]); p0[cc] = __builtin_bit_cast(bf16x8, w); }
    bf16x8 va0[2], va1[2];
#pragma unroll
    for (int cc = 0; cc < 2; ++cc) { const int ch = 2 * cc + hi; va0[cc] = *(const LAS bf16x8*)(vb_ + q * 128 + ((ch ^ vx) << 4)); va1[cc] = *(const LAS bf16x8*)(vb_ + (32 + q) * 128 + ((ch ^ vx) << 4)); }
    __builtin_amdgcn_sched_barrier(0);
#pragma unroll
    for (int g = 0; g < 4; ++g) {
        if (g & 1) o1 = MFMA32(va1[g >> 1], p0[g >> 1], o1); else o0 = MFMA32(va0[g >> 1], p0[g >> 1], o0);
#pragma unroll
        for (int i = 4 * g; i < 4 * g + 4; ++i) { s1[i] = fast_exp2(s1[i]); rs += s1[i]; }
        __builtin_amdgcn_sched_barrier(0);
    }
    bf16x8 vb0[2], vb1[2];
#pragma unroll
    for (int cc = 0; cc < 2; ++cc) { const int ch = 4 + 2 * cc + hi; vb0[cc] = *(const LAS bf16x8*)(vb_ + q * 128 + ((ch ^ vx) << 4)); vb1[cc] = *(const LAS bf16x8*)(vb_ + (32 + q) * 128 + ((ch ^ vx) << 4)); }
    bf16x8 p1[2];
#pragma unroll
    for (int cc = 0; cc < 2; ++cc) { u32x4 w; w.x = pk2(s1[8 * cc + 0], s1[8 * cc + 1]); w.y = pk2(s1[8 * cc + 2], s1[8 * cc + 3]); w.z = pk2(s1[8 * cc + 4], s1[8 * cc + 5]); w.w = pk2(s1[8 * cc + 6], s1[8 * cc + 7]); p1[cc] = __builtin_bit_cast(bf16x8, w); }
#pragma unroll
    for (int cc = 0; cc < 2; ++cc) { o0 = MFMA32(vb0[cc], p1[cc], o0); o1 = MFMA32(vb1[cc], p1[cc], o1); }
    lrun += rs;
}

__device__ __forceinline__ void attn_unit(LAS unsigned char* lds, const AttnJob& J, const LAS float* biasL, int tid, int wid, int lane) {
    const int q = lane & 31, hi = lane >> 5;
    bf16x8 qf[4];
    f32x16 o0, o1; float lrun = 0.f;
#pragma unroll
    for (int i = 0; i < 16; ++i) { o0[i] = 0.f; o1[i] = 0.f; }
    float mrun = 0.f;
    bf16x8 pf[2][2];
#pragma unroll
    for (int a = 0; a < 2; ++a)
#pragma unroll
        for (int b = 0; b < 2; ++b) pf[a][b] = (bf16x8){0, 0, 0, 0, 0, 0, 0, 0};
    const int srow = tid >> 3;
    const int gch = (tid & 7) ^ ((srow >> 1) & 7);
    const int pi = (q & 0x13) | ((q & 4) << 1) | ((q & 8) >> 1);
    const int kx = (pi >> 1) & 7, vx = (q >> 1) & 7;
    const int rq = J.r0 + (wid >> 1), cq = (wid & 1) * 32 + q;
    const int rs_ = min(max(rq - 4, 0), 24), cs_ = min(max(cq - 8, 0), 48);
    unsigned vmask = 0u;
    if (J.na) {
#pragma unroll
        for (int i = 0; i < 32; ++i) { const int kc = 32 * (i >> 4) + 16 * ((i >> 3) & 1) + 8 * hi + (i & 7); vmask |= ((unsigned)(kc - cs_) < 16u ? 1u : 0u) << i; }
    }
    const int blane = 8 * hi - cq + 15 + 48;
    const bool fast = J.fast != 0;
    const bf16_t* kg = J.K + (size_t)srow * J.kpitch + gch * 8;
    const bf16_t* vg = J.Vt + (size_t)srow * T + gch * 8;
    const unsigned ldsw0 = (unsigned)(unsigned long long)lds + (unsigned)wid * 1024u;
#define ATT_ISSUE(tile, vslot) do { const int t_ = (tile); const int tk_ = t_ < 4 ? J.ctx_row0 + 64 * t_ : J.lat_row0 + 64 * (t_ - 4); \
        glds16(kg + (size_t)tk_ * J.kpitch, (unsigned)__builtin_amdgcn_readfirstlane((int)(ldsw0 + (t_ & 3) * 8192))); \
        glds16(vg + tk_, (unsigned)__builtin_amdgcn_readfirstlane((int)(ldsw0 + 32768 + (vslot) * 8192))); } while (0)
    ATT_ISSUE(0, 0); ATT_ISSUE(1, 1); ATT_ISSUE(2, 2);
    { const bf16_t* qrow = J.Q + (size_t)(wid * 32 + q) * J.qpitch + 8 * hi;
#pragma unroll
      for (int ks = 0; ks < 4; ++ks) qf[ks] = *(const bf16x8*)(qrow + 16 * ks); }
    asm volatile("s_waitcnt vmcnt(0) lgkmcnt(0)" :: "v"(qf[0]), "v"(qf[1]), "v"(qf[2]), "v"(qf[3]) : "memory");
    __builtin_amdgcn_s_barrier(); asm volatile("" ::: "memory");
    int vcur = 0, vprev = 4;
    for (int it = 0; it < J.ntiles; ++it) {
        const LAS unsigned char* kb_ = lds + (it & 3) * 8192;
        const int vnext = vcur == 4 ? 0 : vcur + 1;
        if (it + 3 < J.ntiles) { const int v3 = vcur + 3 >= 5 ? vcur - 2 : vcur + 3; ATT_ISSUE(it + 3, v3); }
        const int kr = J.rlo + it - 4;
        const bool local = J.na && it >= 4;
        const bool active = !local || (kr >= rs_ && kr < rs_ + 8);
        const LAS float* bp = biasL + (kr - rq + 7) * 128 + blane;
        if (active) {
            if (fast && !local) att_tile_fast(kb_, lds + 32768 + vcur * 8192, qf, pi, kx, q, vx, hi, o0, o1, lrun);
            else {
                if (fast) att_scores<true>(kb_, qf, pi, kx, hi, local, bp, vmask, it == 0, mrun, o0, o1, lrun, pf); else att_scores<false>(kb_, qf, pi, kx, hi, local, bp, vmask, it == 0, mrun, o0, o1, lrun, pf);
                att_pv(lds + 32768 + vcur * 8192, q, vx, hi, pf, o0, o1);
            }
        }
        const int ny = J.ntiles - (it + 2);
        if (ny >= 2) asm volatile("s_waitcnt vmcnt(4)" ::: "memory"); else if (ny == 1) asm volatile("s_waitcnt vmcnt(2)" ::: "memory"); else asm volatile("s_waitcnt vmcnt(0)" ::: "memory");
        __builtin_amdgcn_s_barrier(); asm volatile("" ::: "memory");
        vprev = vcur; vcur = vnext;
    }
#undef ATT_ISSUE
    const float inv = fast_rcp(lrun + __shfl_xor(lrun, 32));
    bf16_t* orow = J.O + (size_t)(wid * 32 + q) * D + 4 * hi;
#pragma unroll
    for (int c = 0; c < 4; ++c) {
        u32x2 w0, w1;
        w0.x = pk2(o0[4 * c] * inv, o0[4 * c + 1] * inv); w0.y = pk2(o0[4 * c + 2] * inv, o0[4 * c + 3] * inv);
        w1.x = pk2(o1[4 * c] * inv, o1[4 * c + 1] * inv); w1.y = pk2(o1[4 * c + 2] * inv, o1[4 * c + 3] * inv);
        *(u32x2*)(orow + 8 * c) = w0; *(u32x2*)(orow + 32 + 8 * c) = w1;
    }
}

__device__ __forceinline__ void pool_unit(LAS unsigned char* lds, const bf16_t* PC, const float* wpool, const float* pscale, bf16_t* Y, int unit, int tid) {
    const int row0 = unit * 64;
    const int seq0 = row0 < TL ? (row0 & ~(SEQ - 1)) : TL + ((row0 - TL) & ~(LCTX - 1));
    const int N = row0 < TL ? SEQ : LCTX;
    const int t0 = row0 - seq0;
    LAS unsigned short* vin = (LAS unsigned short*)lds;
    constexpr int PP = 264;
    LAS unsigned short* pooled = (LAS unsigned short*)(lds + 40960);
    for (int i = tid; i < 80 * 32; i += 512) {
        const int lr = i >> 5, ch8 = i & 31, t = t0 - 8 + lr;
        u32x4 v = (u32x4){0u, 0u, 0u, 0u};
        if (t >= 0 && t < N) v = *(const u32x4*)(PC + (size_t)(seq0 + t) * 256 + ch8 * 8);
        *(LAS u32x4*)(lds + (lr * 256 + ch8 * 8) * 2) = v;
    }
    __syncthreads();
    {
        const int ch = tid & 255, th = tid >> 8, g = ch >> 6, hw = 1 << g;
        const LAS unsigned short* vp = vin + (th * 32 + 8) * 256 + ch;
        float s = 0.f;
        for (int k = -hw; k < hw; ++k) s += bf2f(vp[k * 256]);
#pragma unroll 8
        for (int i = 0; i < 32; ++i) {
            const int tl = th * 32 + i, t = t0 + tl;
            const int lo = max(t - hw, 0), hi2 = min(t + hw, N);
            pooled[tl * PP + ch] = (unsigned short)f2bf(s * fast_rcp((float)(hi2 - lo)) - bf2f(vp[i * 256]));
            s += bf2f(vp[(i + hw) * 256]) - bf2f(vp[(i - hw) * 256]);
        }
    }
    __syncthreads();
    {
        const int lane = tid & 63, wid = tid >> 6, g = wid & 3, th = wid >> 2, q = lane & 31, hi = lane >> 5;
        const float* wg = wpool + (size_t)g * 64 * 64;
        bf16x8 af[4];
#pragma unroll
        for (int ks = 0; ks < 4; ++ks) af[ks] = *(const LAS bf16x8*)(pooled + (th * 32 + q) * PP + g * 64 + 16 * ks + 8 * hi);
#pragma unroll
        for (int db = 0; db < 2; ++db) {
            f32x16 dacc;
#pragma unroll
            for (int i = 0; i < 16; ++i) dacc[i] = 0.f;
#pragma unroll
            for (int ks = 0; ks < 4; ++ks) {
                const float* wp = wg + (size_t)(16 * ks + 8 * hi) * 64 + 32 * db + q;
                u32x4 w; w.x = pk2(wp[0], wp[64]); w.y = pk2(wp[128], wp[192]); w.z = pk2(wp[256], wp[320]); w.w = pk2(wp[384], wp[448]);
                dacc = MFMA32(af[ks], __builtin_bit_cast(bf16x8, w), dacc);
            }
            const int col = g * 64 + 32 * db + q;
            const float sc = pscale[col];
#pragma unroll
            for (int r = 0; r < 16; ++r) { const int tok = 8 * (r >> 2) + 4 * hi + (r & 3);
                Y[(size_t)(row0 + th * 32 + tok) * D + 768 + col] = (bf16_t)f2bf(dacc[r] * sc); }
        }
    }
    __syncthreads();
}

__device__ __forceinline__ void mixer_phase(KArgsPtr a, int l, bool lastl, LAS unsigned char* lds, unsigned* ctr, int tid_) {
    unsigned char* ws = a->ws;
    const bf16_t* big = (const bf16_t*)(ws + WS_BIG);
    bf16_t* Y = (bf16_t*)(ws + WS_U);
    constexpr int NG = NB * 6 * 8, NN = NB * 6 * 8, NCA = NB * 6, NCB = NB * 6;
    const int ncx = lastl ? 0 : NCA + NCB;
    const int npool = (lastl ? TL : T) / 64;
    const int total0 = NG + NN + ncx + npool;
    const int total = total0 + (MIX_DUP == 1 ? NG : MIX_DUP == 2 ? NN : MIX_DUP == 3 ? npool : 0);
    LAS int* shu = (LAS int*)(lds + LDS_MISC);
    LAS float* biasL = (LAS float*)(lds + 73728);
    int fastA, fastB, fastN;
    { const int ln = tid_ & 63;
      float qa = fabsf(a->in[9][l * 64 + ln]), ka = fabsf(a->in[10][l * 64 + ln]), qb = fabsf(a->in[11][l * 64 + ln]), kb = fabsf(a->in[12][l * 64 + ln]), bm = 0.f;
      for (int i = ln; i < 6 * 465; i += 64) bm = fmaxf(bm, fabsf(a->in[13][(size_t)l * 6 * 465 + i]));
#pragma unroll
      for (int o = 1; o < 64; o <<= 1) { qa = fmaxf(qa, __shfl_xor(qa, o)); ka = fmaxf(ka, __shfl_xor(ka, o)); qb = fmaxf(qb, __shfl_xor(qb, o)); kb = fmaxf(kb, __shfl_xor(kb, o)); bm = fmaxf(bm, __shfl_xor(bm, o)); }
      fastA = __builtin_amdgcn_readfirstlane((int)(11.5416f * qa * ka < 60.f));
      fastB = __builtin_amdgcn_readfirstlane((int)(11.5416f * qb * kb < 60.f));
      fastN = __builtin_amdgcn_readfirstlane((int)(11.5416f * qa * ka + bm * LOG2E < 60.f)); }
    if (tid_ == 0) shu[0] = (int)atomicAdd(ctr, 1u);
    __syncthreads();
    int u = __builtin_amdgcn_readfirstlane(shu[0]);
    for (int uit = 0;; ++uit) {
        int tid = tid_; asm volatile("" : "+v"(tid));
        const int lane = tid & 63, wid = __builtin_amdgcn_readfirstlane(tid >> 6);
        if (u >= total) break;
        if (u >= total0) u = u - total0 + (MIX_DUP == 2 ? NG : MIX_DUP == 3 ? NG + NN + ncx : 0);
        int nxt_ = 0; if (tid == 0) nxt_ = (int)atomicAdd(ctr, 1u);
        if (u < NG + NN + ncx) {
            AttnJob J;
            if (u < NG) {
                const int qb = u & 7, hq = (u >> 3) % 6, b = u / 48, hkv = hq / 3;
                J.Q = big + B_QB + (size_t)(b * SEQ + qb * 256) * 384 + hq * 64; J.qpitch = 384;
                J.K = big + B_KB + hkv * 64; J.kpitch = 128; J.Vt = big + B_VBT + (size_t)(hkv * 64) * T;
                J.O = Y + (size_t)(b * SEQ + qb * 256) * D + 384 + hq * 64;
                J.ctx_row0 = TL + b * LCTX; J.lat_row0 = b * SEQ; J.ntiles = 4 + 32; J.na = 0; J.r0 = 0; J.rlo = 0;
                J.fast = fastB;
            } else if ((u -= NG) < NN) {
                const int rg = u & 7, h = (u >> 3) % 6, b = u / 48, r0 = rg * 4;
                const int rlo = min(max(r0 - 4, 0), 24), rhi = min(max(r0 + 3 - 4, 0), 24) + 8;
                const float* rpb = a->in[13] + ((size_t)l * 6 + h) * 15 * 31;
                for (int i = tid; i < 15 * 128; i += 512) { const int dc = (i & 127) - 48; biasL[i] = (dc >= 0 && dc < 31) ? rpb[(i >> 7) * 31 + dc] * LOG2E : 0.f; }
                J.Q = big + B_QA + (size_t)(b * SEQ + r0 * 64) * 384 + h * 64; J.qpitch = 384;
                J.K = big + B_KA + h * 64; J.kpitch = 384; J.Vt = big + B_VAT + (size_t)(h * 64) * T;
                J.O = Y + (size_t)(b * SEQ + r0 * 64) * D + h * 64;
                J.ctx_row0 = TL + b * LCTX; J.lat_row0 = b * SEQ + rlo * 64; J.ntiles = 4 + (rhi - rlo); J.na = 1; J.r0 = r0; J.rlo = rlo;
                J.fast = fastN;
            } else {
                u -= NN;
                const bool second = u >= NCA; if (second) u -= NCA;
                const int h = u % 6, b = u / 6;
                if (!second) { J.Q = big + B_QA + (size_t)(TL + b * LCTX) * 384 + h * 64; J.K = big + B_KA + h * 64; J.kpitch = 384; J.Vt = big + B_VAT + (size_t)(h * 64) * T; J.O = Y + (size_t)(TL + b * LCTX) * D + h * 64; }
                else { const int hkv = h / 3; J.Q = big + B_QB + (size_t)(TL + b * LCTX) * 384 + h * 64; J.K = big + B_KB + hkv * 64; J.kpitch = 128; J.Vt = big + B_VBT + (size_t)(hkv * 64) * T; J.O = Y + (size_t)(TL + b * LCTX) * D + 384 + h * 64; }
                J.qpitch = 384; J.ctx_row0 = TL + b * LCTX; J.lat_row0 = 0; J.ntiles = 4; J.na = 0; J.r0 = 0; J.rlo = 0;
                J.fast = second ? fastB : fastA;
            }
            attn_unit(lds, J, biasL, tid, wid, lane);
        } else {
            u -= NG + NN + ncx;
            pool_unit(lds, big + B_PC, a->in[14] + (size_t)l * 4 * 64 * 64, a->in[15] + (size_t)l * 256, Y, u, tid);
        }
        if (tid == 0) shu[(uit + 1) & 1] = nxt_;
        __syncthreads();
        u = __builtin_amdgcn_readfirstlane(shu[(uit + 1) & 1]);
    }
}


#define XB_TMO      128
#define XB_XCNT(j)  (256  + 64 * (j))
#define XB_XSUB(j)  (1280 + 64 * (j))
#define XB_XGEN(j)  (2304 + 64 * (j))
#define XB_TOP      3328
#define XB_TOPGEN   3392
#define XB_SPIN_CAP (1u << 22)
constexpr int CW_BAR = 4096;
__device__ __forceinline__ unsigned xb_ld(unsigned* p)              { return __hip_atomic_load(p, __ATOMIC_RELAXED, __HIP_MEMORY_SCOPE_AGENT); }
__device__ __forceinline__ unsigned xb_add(unsigned* p, unsigned v) { return __hip_atomic_fetch_add(p, v, __ATOMIC_RELAXED, __HIP_MEMORY_SCOPE_AGENT); }
__device__ __forceinline__ unsigned xb_xcc_id() { return (unsigned)__builtin_amdgcn_s_getreg((3 << 11) | 20) & 0xFu; }
#define XB_SPIN(cond, bar) do { unsigned _sp = 0; while (cond) { __builtin_amdgcn_s_sleep(1); \
    if ((++_sp & 255u) == 0u) { if (xb_ld(&(bar)[XB_TMO])) break; if (_sp > XB_SPIN_CAP) { atomicAdd(&(bar)[XB_TMO], 1u); break; } } } } while (0)
__device__ __forceinline__ void xcd_barrier_complete(unsigned* bar, unsigned x, unsigned& nloc, unsigned& nx) {
    const unsigned G = gridDim.x * gridDim.y * gridDim.z;
    unsigned sum, cnt, mine, sp = 0u;
    for (;;) {
        sum = 0u; cnt = 0u; mine = 0u;
#pragma unroll
        for (unsigned j = 0; j < 16; ++j) { const unsigned c = xb_ld(&bar[XB_XCNT(j)]); sum += c; cnt += (c > 0u) ? 1u : 0u; mine = (j == x) ? c : mine; }
        if (sum == G) break;
        __builtin_amdgcn_s_sleep(1);
        if ((++sp & 255u) == 0u) { if (xb_ld(&bar[XB_TMO])) break; if (sp > XB_SPIN_CAP) { atomicAdd(&bar[XB_TMO], 1u); break; } }
    }
    nloc = mine > 0u ? mine : 1u; nx = cnt > 0u ? cnt : 1u;
}
__device__ __forceinline__ void xcd_barrier(unsigned* bar, volatile LAS unsigned* st) {
    asm volatile("s_waitcnt vmcnt(0)" ::: "memory");
    __syncthreads();
    if (threadIdx.x == 0) {
        const unsigned x = xb_xcc_id();
        __builtin_amdgcn_s_waitcnt(0);
        unsigned nloc = st[0], nx = st[1];
        if (nloc == 0u) { xcd_barrier_complete(bar, x, nloc, nx); st[0] = nloc; st[1] = nx; }
        const unsigned old = xb_add(&bar[XB_XSUB(x)], 1u);
        const unsigned gen = old / nloc;
        if (old + 1u == (gen + 1u) * nloc) {
            __builtin_amdgcn_fence(__ATOMIC_RELEASE, "agent");
            asm volatile("s_waitcnt vmcnt(0)" ::: "memory");
            const unsigned og = xb_add(&bar[XB_TOP], 1u);
            const unsigned tg = og / nx;
            if (og + 1u == (tg + 1u) * nx) xb_add(&bar[XB_TOPGEN], 1u);
            else XB_SPIN(xb_ld(&bar[XB_TOPGEN]) == tg, bar);
            __builtin_amdgcn_fence(__ATOMIC_ACQUIRE, "agent");
            xb_add(&bar[XB_XGEN(x)], 1u);
            asm volatile("s_waitcnt vmcnt(0)" ::: "memory");
        } else {
            XB_SPIN(xb_ld(&bar[XB_XGEN(x)]) == gen, bar);
            __builtin_amdgcn_fence(__ATOMIC_ACQUIRE, "agent");
            asm volatile("s_waitcnt vmcnt(0)" ::: "memory");
        }
    }
    __syncthreads();
}

__device__ __forceinline__ KArgsPtr fresh_args() {
    KArgsPtr p = (KArgsPtr)__builtin_amdgcn_kernarg_segment_ptr();
    asm volatile("" : "+s"(p) :: "memory");
    return p;
}
#define IN(k) (lo <= (k) && (k) < hi)
#define SEAM(k) do { if ((k) + 1 < hi) { if (lo < 0) { __threadfence(); cg::this_grid().sync(); } else xcd_barrier((unsigned*)(a_.ws + WS_CTL) + CW_BAR, (volatile LAS unsigned*)(lds + LDS_MISC + 16)); } } while (0)
#define PH_COMMON KArgsPtr a = fresh_args(); unsigned char* ws = a->ws; int tid = threadIdx.x; asm volatile("" : "+v"(tid)); const int lane = tid & 63, wid = __builtin_amdgcn_readfirstlane(tid >> 6); \
    int G = __builtin_amdgcn_readfirstlane((int)gridDim.x), c = __builtin_amdgcn_readfirstlane((int)blockIdx.x); \
    bf16_t* U = (bf16_t*)(ws + WS_U); bf16_t* BIG = (bf16_t*)(ws + WS_BIG); float* modall = (float*)(ws + WS_MOD); float* hbuf = (float*)(ws + WS_H); float* xout = a->out; \
    const bool lastl = (l == DEPTH - 1); const float* modl = modall + (size_t)l * 33 * NMOD; const float* xs = l == 0 ? a->in[0] : xout; const float* hs = l == 0 ? a->in[2] : hbuf; const int M = lastl ? TL : T; \
    (void)tid; (void)lane; (void)wid; (void)G; (void)c; (void)U; (void)BIG; (void)hbuf; (void)modl; (void)xs; (void)hs; (void)M; (void)lastl; (void)xout;
__global__ void __launch_bounds__(512, 2) mega_fwd(Args a_) {
    extern __shared__ __attribute__((aligned(16))) unsigned char lds_raw[];
    LAS unsigned char* lds = (LAS unsigned char*)lds_raw;
    const int lo = a_.ph_lo, hi = a_.ph_hi;
    if (threadIdx.x == 0) { ((volatile LAS unsigned*)(lds + LDS_MISC + 16))[0] = 0u; ((volatile LAS unsigned*)(lds + LDS_MISC + 16))[1] = 0u;
        (void)xb_add((unsigned*)(a_.ws + WS_CTL) + CW_BAR + XB_XCNT(xb_xcc_id()), 1u); }
    __syncthreads();
    if (IN(0)) { const int l = 0; PH_COMMON prep_phase(a, lds, tid, wid, lane, c, G);
#if PREP_DOUBLE
        xcd_barrier((unsigned*)(a_.ws + WS_CTL) + CW_BAR, (volatile LAS unsigned*)(lds + LDS_MISC + 16)); prep_phase(a, lds, tid, wid, lane, c, G);
#endif
        SEAM(0); }
    if (IN(1)) { const int l = 0; PH_COMMON
        pg8::Gemm g{(const bf16_t*)(ws + WS_SC), (const bf16_t*)(ws + WS_BIG), 256, DEPTH * NMOD, D};
        pg8::StaticOrder S; S.init(256, DEPTH * NMOD, G, c);
        EpiMod E{modall, a->in[5]};
        pg8::gemm_phase<EpiMod, pg8::StaticOrder, false, true>(lds, g, S, E, tid);
        SEAM(1);
    }
#pragma unroll 1
    for (int l = 0; l < DEPTH; ++l) {
        const int pb = 2 + 8 * l;
        if (IN(pb + 0) && l == 0) { for (int rep_ = 0; rep_ < ((REP_MASK >> 0) & 1) + 1; ++rep_) { if (rep_) { xcd_barrier((unsigned*)(a_.ws + WS_CTL) + CW_BAR, (volatile LAS unsigned*)(lds + LDS_MISC + 16)); } PH_COMMON norm_phase(xs, hs, a->in[6] + l * D, modl, 0, T, U, wid, lane, c, G); } SEAM(pb + 0); }
        if (IN(pb + 1)) { for (int rep_ = 0; rep_ < ((REP_MASK >> 1) & 1) + 1; ++rep_) { if (rep_) { xcd_barrier((unsigned*)(a_.ws + WS_CTL) + CW_BAR, (volatile LAS unsigned*)(lds + LDS_MISC + 16)); } PH_COMMON
            pg8::Gemm g{U, (const bf16_t*)(ws + WS_WIN) + (size_t)l * NIN * D, T, NIN, D};
            pg8::StaticOrder S; S.init(lastl ? TL : T, NIN, G, c); if (lastl) S.xtra = (TC / 256) * 5; S.rev = l & 1;
            EpiIn E{BIG, a->in[9] + l * 64, a->in[10] + l * 64, a->in[11] + l * 64, a->in[12] + l * 64, (const f32x2*)(ws + WS_ROPE)};
            pg8::gemm_phase<EpiIn, pg8::StaticOrder, true, true>(lds, g, S, E, tid, ((c >> 3) & 3) * STG_K1024);
            } SEAM(pb + 1);
        }
        if (IN(pb + 2)) { for (int rep_ = 0; rep_ < ((REP_MASK >> 2) & 1) + 1; ++rep_) { if (rep_) { xcd_barrier((unsigned*)(a_.ws + WS_CTL) + CW_BAR, (volatile LAS unsigned*)(lds + LDS_MISC + 16)); } PH_COMMON mixer_phase(a, l, lastl, lds, (unsigned*)(ws + WS_CTL) + 64 * (1 + l + 8 * rep_), tid); } SEAM(pb + 2); }
        if (IN(pb + 3)) { for (int rep_ = 0; rep_ < ((REP_MASK >> 3) & 1) + 1; ++rep_) { if (rep_) { xcd_barrier((unsigned*)(a_.ws + WS_CTL) + CW_BAR, (volatile LAS unsigned*)(lds + LDS_MISC + 16)); } PH_COMMON
            pg8::Gemm g{U, (const bf16_t*)(ws + WS_WBR) + (size_t)l * D * D, M, D, D};
            pg8::StaticOrder S; S.init(M, D, G, c);
            S.dbl = 0; S.rev = 1 - (l & 1); EpiMerge E{BIG + B_G, BIG};
            pg8::gemm_phase<EpiMerge, pg8::StaticOrder, true, true>(lds, g, S, E, tid, ((c >> 3) & 3) * STG_K1024);
            } SEAM(pb + 3);
        }
        if (IN(pb + 4)) { PH_COMMON
            pg8::Gemm g{BIG, (const bf16_t*)(ws + WS_WOUT) + (size_t)l * D * D, M, D, D};
            pg8::PanelOrder S; S.init(M, G, c); S.rev = (l & 1) ? 1 : 2;
            EpiResNorm E{xs, xout, hs, hbuf, modl, 2 * D, a->in[7] + l * D, modl, 3 * D, U, (float*)(ws + WS_SLOTS), (unsigned*)(ws + WS_CTL + CTL_PANEL) + (l * 2 + 0) * 512, lds + LDS_XCH};
            pg8::gemm_phase<EpiResNorm, pg8::PanelOrder, true, true>(lds, g, S, E, tid);
            SEAM(pb + 4);
        }
        if (IN(pb + 6)) { for (int rep_ = 0; rep_ < ((REP_MASK >> 6) & 1) + 1; ++rep_) { if (rep_) { xcd_barrier((unsigned*)(a_.ws + WS_CTL) + CW_BAR, (volatile LAS unsigned*)(lds + LDS_MISC + 16)); } PH_COMMON
            pg8::Gemm g{U, (const bf16_t*)(ws + WS_W13) + (size_t)l * 2 * FF * D, M, 2 * FF, D};
            pg8::StaticOrder S; S.init(M, 2 * FF, G, c); S.rev = 1 - (l & 1);
            EpiFF1 E{BIG};
            pg8::gemm_phase<EpiFF1, pg8::StaticOrder, true, true>(lds, g, S, E, tid, ((c >> 3) & 3) * STG_K1024);
            } SEAM(pb + 6);
        }
        if (IN(pb + 7)) { PH_COMMON
            pg8::Gemm g{BIG, (const bf16_t*)(ws + WS_W2) + (size_t)l * D * FF, M, D, FF};
            if (lastl) {
                pg8::StaticOrder S; S.init(M, D, G, c); S.rev = 1;
                EpiRes E{xout, xout, hbuf, hbuf, modl, 5 * D};
                pg8::gemm_phase<EpiRes, pg8::StaticOrder, true, true>(lds, g, S, E, tid, ((c >> 3) & 3) * STG_K2816);
            } else {
                pg8::PanelOrder S; S.init(M, G, c); S.rev = (l & 1) ? 1 : 2;
                EpiResNorm E{xout, xout, hbuf, hbuf, modl, 5 * D, a->in[6] + (l + 1) * D, modall + (size_t)(l + 1) * 33 * NMOD, 0, U, (float*)(ws + WS_SLOTS), (unsigned*)(ws + WS_CTL + CTL_PANEL) + (l * 2 + 1) * 512, lds + LDS_XCH};
                pg8::gemm_phase<EpiResNorm, pg8::PanelOrder, true, true>(lds, g, S, E, tid);
            }
            SEAM(pb + 7);
        }
    }
}
#undef IN
#undef SEAM

extern "C" void kernel_launch(void* const* d_in, const int* in_sizes, int n_in, void* d_out, int out_size, void* d_ws, size_t ws_size, hipStream_t stream) {
    static int grid = 0;
    if (grid == 0) {
        if (n_in != 23 || out_size != TL * D || ws_size < WS_END2) { fprintf(stderr, "kernel_launch: unexpected shapes (n_in %d out %d ws %zu need %zu)\n", n_in, out_size, ws_size, (size_t)WS_END2); grid = -1; return; }
        int dev = 0, cus = 0, per_cu = 0;
        hipGetDevice(&dev); hipDeviceGetAttribute(&cus, hipDeviceAttributeMultiprocessorCount, dev);
        if (hipFuncSetAttribute((const void*)mega_fwd, hipFuncAttributeMaxDynamicSharedMemorySize, LDS_BYTES) != hipSuccess) { fprintf(stderr, "kernel_launch: hipFuncSetAttribute failed\n"); grid = -1; return; }
        if (hipOccupancyMaxActiveBlocksPerMultiprocessor(&per_cu, (const void*)mega_fwd, 512, LDS_BYTES) != hipSuccess || per_cu < 1) { fprintf(stderr, "kernel_launch: occupancy query gave %d\n", per_cu); per_cu = 1; }
        (void)hipGetLastError();
        grid = cus;
        fprintf(stderr, "kernel_launch: cus %d per_cu %d grid %d ws %zu\n", cus, per_cu, grid, ws_size);
    }
    if (grid < 0) return;
    hipMemsetAsync((char*)d_ws + WS_CTL, 0, CTL_BYTES, stream);
    Args a{};
    for (int i = 0; i < 23; ++i) a.in[i] = (const float*)d_in[i];
    a.out = (float*)d_out; a.ws = (unsigned char*)d_ws;
    for (int i = 0; i < 16; ++i) a.freq[i] = (float)pow(10000.0, -(double)i / 16.0);
#if MK_PER_PHASE
    for (int ph = 0; ph < NPH; ++ph) { a.ph_lo = ph; a.ph_hi = ph + 1; hipLaunchKernelGGL(mega_fwd, dim3(grid), dim3(512), LDS_BYTES, stream, a); }
#else
    a.ph_lo = 0; a.ph_hi = NPH;
    void* args[] = {&a};
    hipError_t e = hipLaunchCooperativeKernel((const void*)mega_fwd, dim3(grid), dim3(512), args, LDS_BYTES, stream);
    if (e != hipSuccess) fprintf(stderr, "kernel_launch: cooperative launch failed: %s (grid %d)\n", hipGetErrorString(e), grid);
#endif
}
```

```cpp
#include <hip/hip_runtime.h>
#include <hip/hip_cooperative_groups.h>
#include <cstdio>
#include <cstdint>
#include <cmath>
namespace cg = cooperative_groups;

#ifndef REP_MASK
#define REP_MASK 0
#endif
#ifndef EPI_DOUBLE
#define EPI_DOUBLE 0
#endif
#ifndef PREP_DOUBLE
#define PREP_DOUBLE 0
#endif
#ifndef MIX_DUP
#define MIX_DUP 0
#endif
#ifndef GEMM_DOUBLE
#define GEMM_DOUBLE 0
#endif
#ifndef STG_K1024
#define STG_K1024 0
#define STG_K2816 0
#endif
#ifndef MK_PER_PHASE
#define MK_PER_PHASE 0
#endif

#define LAS __attribute__((address_space(3)))
typedef unsigned short bf16_t;
typedef short bf16x8 __attribute__((ext_vector_type(8)));
typedef float f32x4 __attribute__((ext_vector_type(4)));
typedef float f32x2 __attribute__((ext_vector_type(2)));
typedef float f32x16 __attribute__((ext_vector_type(16)));
typedef unsigned u32x4 __attribute__((ext_vector_type(4)));
typedef unsigned u32x2 __attribute__((ext_vector_type(2)));

constexpr int D = 1024, NB = 32, SEQ = 2048, DEPTH = 4, LCTX = 256, GW = 64;
constexpr int TL = NB * SEQ, TC = NB * LCTX, T = TL + TC;
constexpr int NIN = 5120, FF = 2816, NMOD = 6144;
constexpr float EPS = 1e-6f;
constexpr float LOG2E = 1.4426950408889634f;
constexpr float QSCALE = 0.125f * LOG2E;
constexpr int NPH = 2 + 8 * DEPTH;

constexpr size_t WS_CTL = 0, CTL_BYTES = 65536;
constexpr size_t WS_ROPE = WS_CTL + CTL_BYTES;
constexpr size_t WS_MOD = WS_ROPE + 8192;
constexpr size_t WS_SC = WS_MOD + (size_t)DEPTH * 33 * NMOD * 4;
constexpr size_t WS_H = WS_SC + 256 * 1024 * 2;
constexpr size_t WS_WIN = WS_H + (size_t)TC * D * 4;
constexpr size_t WS_WBR = WS_WIN + (size_t)DEPTH * NIN * D * 2;
constexpr size_t WS_WOUT = WS_WBR + (size_t)DEPTH * D * D * 2;
constexpr size_t WS_W13 = WS_WOUT + (size_t)DEPTH * D * D * 2;
constexpr size_t WS_W2 = WS_W13 + (size_t)DEPTH * 2 * FF * D * 2;
constexpr size_t WS_U = WS_W2 + (size_t)DEPTH * D * FF * 2;
constexpr size_t WS_BIG = WS_U + (size_t)T * D * 2;
constexpr size_t WS_END = WS_BIG + (size_t)T * NIN * 2;
constexpr size_t WS_SLOTS = WS_END;
constexpr size_t WS_END2 = WS_SLOTS + (size_t)T * 4 * 4;
static_assert(WS_END2 <= (size_t)1073741824, "workspace map exceeds 1 GiB");
constexpr size_t CTL_PANEL = 32768;
constexpr size_t B_QA = 0, B_KA = B_QA + (size_t)T * 384, B_VAT = B_KA + (size_t)T * 384, B_QB = B_VAT + (size_t)T * 384, B_KB = B_QB + (size_t)T * 384,
                 B_VBT = B_KB + (size_t)T * 128, B_PC = B_VBT + (size_t)T * 128, B_G = B_PC + (size_t)T * 256;
static_assert(B_G == (size_t)T * 2048, "BIG layout");

constexpr int LDS_BYTES = 131072 + 1024 + 6144;
constexpr int LDS_XCH = 131072 + 1024;
constexpr int LDS_MISC = 131072;

__device__ __forceinline__ unsigned f2bf(float f) { unsigned u = __builtin_bit_cast(unsigned, f); return (u + 0x7fffu + ((u >> 16) & 1u)) >> 16; }
typedef __bf16 hwbf2 __attribute__((ext_vector_type(2)));
__device__ __forceinline__ unsigned pk2(float lo, float hi) { const f32x2 v = {lo, hi}; const hwbf2 b = __builtin_convertvector(v, hwbf2); return __builtin_bit_cast(unsigned, b); }
__device__ __forceinline__ float bf2f(unsigned short h) { return __builtin_bit_cast(float, (unsigned)h << 16); }
__device__ __forceinline__ float bflo(unsigned w) { return __builtin_bit_cast(float, w << 16); }
__device__ __forceinline__ float bfhi(unsigned w) { return __builtin_bit_cast(float, w & 0xffff0000u); }
__device__ __forceinline__ float wave_sum(float v) {
#pragma unroll
    for (int o = 1; o < 64; o <<= 1) v += __shfl_xor(v, o);
    return v;
}
__device__ __forceinline__ float fast_exp2(float x) { return __builtin_amdgcn_exp2f(x); }
__device__ __forceinline__ float fast_rcp(float x) { return __builtin_amdgcn_rcpf(x); }
__device__ __forceinline__ float sigmoidf_(float x) { return fast_rcp(1.0f + fast_exp2(x * -LOG2E)); }

namespace pg8 {
constexpr int BM = 256, BK = 64, HALF = 128, HTB = HALF * BK * 2, NXCD = 8, WGM = 8;
__host__ __device__ __forceinline__ int lds_byte(int r, int c) { const int st = (r >> 4) * 2 + (c >> 5), rr = r & 15, cc = c & 31, ob = rr * 64 + cc * 2; return st * 1024 + (ob ^ (((ob >> 9) & 1) << 5)); }
__host__ __device__ __forceinline__ void stage_rc(int b, int& R, int& C) { const int st = b / 1024, sb = b % 1024, swz = sb ^ (((sb >> 9) & 1) << 5); R = (st >> 1) * 16 + swz / 64; C = (st & 1) * 32 + (swz % 64) / 2; }

struct Unit { int pm, pn, second; };
struct Gemm { const bf16_t* A; const bf16_t* Bt; int M, N, K; };

struct StaticOrder {
    int nM, nN, nwg, G, c, dbl, xtra, rev, pnrev;
    __device__ void init(int M, int N, int G_, int c_) { nM = M / BM; nN = N / BM; nwg = nM * nN; G = G_; c = c_; dbl = GEMM_DOUBLE; xtra = 0; rev = 0; pnrev = 0; }
    __device__ bool next(int i, Unit& u) const {
        const long L = (long)(dbl ? (i >> 1) : i) * G + c; u.second = dbl ? (i & 1) : 1;
        if (L >= nwg) { const int k = (int)(L - nwg); if (k >= xtra) return false; const int t = k % 5; u.pm = nM + k / 5; u.pn = t < 4 ? t + 1 : 6; return true; }
        int wgid = (int)L; { const int q = nwg / NXCD, r = nwg % NXCD, xcd = wgid % NXCD; int off = wgid / NXCD; if (rev) off = (xcd < r ? q : q - 1) - off; wgid = (xcd < r ? xcd * (q + 1) : r * (q + 1) + (xcd - r) * q) + off; }
        const int nig = WGM * nN, gid = wgid / nig, fm = gid * WGM, gsz = (nM - fm) < WGM ? (nM - fm) : WGM;
        u.pm = fm + ((wgid % nig) % gsz); u.pn = (wgid % nig) / gsz; if (pnrev) u.pn = nN - 1 - u.pn; return true;
    }
};

struct PanelOrder {
    int nM, G, c, dbl, rev;
    __device__ void init(int M, int G_, int c_) { nM = M / BM; G = G_; c = c_; dbl = 0; rev = 0; }
    __device__ bool next(int i, Unit& u) const {
        if (G < 256 || c >= 256) { if (G >= 256) return false; const long L = (long)i * (G & ~3) + c; if (c >= (G & ~3) || L >= (long)nM * 4) return false; u.pm = (int)(L >> 2); u.pn = (int)(L & 3); u.second = 1; return true; }
        if (rev && (nM & 7) == 0) {
            const int per = nM >> 3, k = 8 * i + (c >> 5); if (k >= per) return false;
            u.pm = (c & 7) * per + (rev == 1 ? per - 1 - k : k); u.pn = (c >> 3) & 3; u.second = 1; return true;
        }
        const int pm = i * 64 + (c & 7) * 8 + (c >> 5); if (pm >= nM) return false;
        u.pm = pm; u.pn = (c >> 3) & 3; u.second = 1; return true;
    }
};

template <class Epi, class Sched, bool ALIGN_EPI = false, bool SP2 = false>
__device__ __forceinline__ void gemm_phase(LAS unsigned char* lds, const Gemm g, const Sched& S, const Epi& E, const int tid, const int stagger_ticks = 0) {
    const int wid = __builtin_amdgcn_readfirstlane(tid >> 6), lane = tid & 63, wr = wid >> 2, wc = wid & 3, fr = lane & 15, fq = lane >> 4;
    const int K = g.K, nt = K / BK;
    unsigned voffA[2], voffB[2];
#pragma unroll
    for (int i = 0; i < 2; ++i) { int R, C; stage_rc(tid * 16 + i * 8192, R, C); voffA[i] = (unsigned)(R * K + C) * 2u; voffB[i] = (unsigned)(R * K + C) * 2u; }
    const size_t kstep = (size_t)(BK * 2);
    const size_t hstep = (size_t)HALF * K * 2;
    const size_t tstep = 2 * hstep;
    const unsigned ldsw = (unsigned)wid * 1024u;
    const int aoff = lds_byte(wr * 64 + fr, fq * 8), boff = lds_byte(wc * 32 + fr, fq * 8);
#define PG8_SA(b, h) (((b) * 2 + (h)) * HTB)
#define PG8_SB(b, h) ((4 + (b) * 2 + (h)) * HTB)
#define PG8_STAGE(bufoff, gbase, voff) do { _Pragma("unroll") for (int _i = 0; _i < 2; ++_i) \
        __builtin_amdgcn_global_load_lds((const unsigned*)((const char*)(gbase) + (voff)[_i]), (LAS unsigned*)(lds + (bufoff) + ldsw + _i * 8192), 16, 0, 0); } while (0)
#define PG8_LDA(dst, b, h) do { _Pragma("unroll") for (int m = 0; m < 4; ++m) _Pragma("unroll") for (int k = 0; k < 2; ++k) dst[m][k] = *(const LAS bf16x8*)(lds + PG8_SA(b, h) + aoff + m * 2048 + k * 1024); } while (0)
#define PG8_LDB(dst, b, h) do { _Pragma("unroll") for (int n = 0; n < 2; ++n) _Pragma("unroll") for (int k = 0; k < 2; ++k) dst[n][k] = *(const LAS bf16x8*)(lds + PG8_SB(b, h) + boff + n * 2048 + k * 1024); } while (0)
#define PG8_MMA(ai, bj, At, Bt) do { __builtin_amdgcn_s_setprio(1); _Pragma("unroll") for (int m = 0; m < 4; ++m) _Pragma("unroll") for (int n = 0; n < 2; ++n) _Pragma("unroll") for (int k = 0; k < 2; ++k) \
        acc[ai][bj][m][n] = __builtin_amdgcn_mfma_f32_16x16x32_bf16(Bt[n][k], At[m][k], acc[ai][bj][m][n], 0, 0, 0); __builtin_amdgcn_s_setprio(0); } while (0)
#define PG8_WAIT_V(n) asm volatile("s_waitcnt vmcnt(" #n ")" ::: "memory")
#define PG8_WAIT_L(n) asm volatile("s_waitcnt lgkmcnt(" #n ")" ::: "memory")
#define PG8_BAR __builtin_amdgcn_s_barrier()
#define PG8_SCHED __builtin_amdgcn_sched_barrier(0)
    Unit cur, nxt; int ui = 0;
    if (!S.next(0, cur)) return;
    if (stagger_ticks > 0) {
        const unsigned long long t0 = __builtin_amdgcn_s_memrealtime();
        while ((long long)(__builtin_amdgcn_s_memrealtime() - t0) < (long long)stagger_ticks) __builtin_amdgcn_s_sleep(16);
    }
    f32x4 acc[2][2][4][2];
#pragma unroll
    for (int a = 0; a < 2; ++a)
#pragma unroll
        for (int b = 0; b < 2; ++b)
#pragma unroll
            for (int m = 0; m < 4; ++m)
#pragma unroll
                for (int n = 0; n < 2; ++n) acc[a][b][m][n] = (f32x4){0.f, 0.f, 0.f, 0.f};
    bf16x8 At[4][2], B0[2][2], B1[2][2];
    const char* cA = (const char*)g.A + (size_t)cur.pm * tstep; const char* cB = (const char*)g.Bt + (size_t)cur.pn * tstep;
    if constexpr (SP2) {
        PG8_STAGE(PG8_SB(0, 0), cB, voffB); PG8_STAGE(PG8_SB(0, 1), cB + hstep, voffB); PG8_STAGE(PG8_SA(0, 0), cA, voffA); PG8_STAGE(PG8_SA(0, 1), cA + hstep, voffA);
        if (wr == 1) PG8_BAR;
        PG8_WAIT_V(2); PG8_BAR;
        PG8_STAGE(PG8_SB(1, 0), cB + kstep, voffB); PG8_STAGE(PG8_SA(1, 0), cA + kstep, voffA); PG8_STAGE(PG8_SB(1, 1), cB + hstep + kstep, voffB);
        PG8_WAIT_V(6); PG8_BAR;
    } else {
        PG8_STAGE(PG8_SB(0, 0), cB, voffB); PG8_STAGE(PG8_SA(0, 0), cA, voffA); PG8_STAGE(PG8_SB(0, 1), cB + hstep, voffB); PG8_STAGE(PG8_SA(0, 1), cA + hstep, voffA);
        if (wr == 1) PG8_BAR;
        PG8_WAIT_V(4); PG8_BAR;
        PG8_STAGE(PG8_SB(1, 0), cB + kstep, voffB); PG8_STAGE(PG8_SA(1, 0), cA + kstep, voffA); PG8_STAGE(PG8_SB(1, 1), cB + hstep + kstep, voffB);
        PG8_WAIT_V(6); PG8_BAR;
    }
    for (;;) {
        const bool has_next = S.next(ui + 1, nxt);
        const char* nA = has_next ? (const char*)g.A + (size_t)nxt.pm * tstep : cA; const char* nB = has_next ? (const char*)g.Bt + (size_t)nxt.pn * tstep : cB;
        for (int t = 0; t < nt; t += 2) {
            if constexpr (Epi::MID) { if (t == 6 || t == 12) E.mid(acc, cur, t == 6 ? 0 : 1, wr, wc, fr, fq); }
            const bool last = (t == nt - 2);
            const char* a1 = cA + (size_t)(t + 1) * kstep;
            const char* a2 = last ? nA : cA + (size_t)(t + 2) * kstep; const char* b2 = last ? nB : cB + (size_t)(t + 2) * kstep;
            const char* a3 = a2 + kstep; const char* b3 = b2 + kstep;
            if constexpr (SP2) {
            PG8_LDB(B0, 0, 0); PG8_LDB(B1, 0, 1); PG8_SCHED; PG8_LDA(At, 0, 0); PG8_STAGE(PG8_SA(1, 1), a1 + hstep, voffA);
            PG8_WAIT_V(8); PG8_WAIT_L(0); PG8_BAR; PG8_MMA(0, 0, At, B0); PG8_MMA(0, 1, At, B1); PG8_BAR; PG8_SCHED;
            PG8_LDA(At, 0, 1); PG8_STAGE(PG8_SB(0, 0), b2, voffB); PG8_STAGE(PG8_SB(0, 1), b2 + hstep, voffB); PG8_STAGE(PG8_SA(0, 0), a2, voffA);
            PG8_WAIT_V(8); PG8_WAIT_L(0); PG8_BAR; PG8_MMA(1, 0, At, B0); PG8_MMA(1, 1, At, B1); PG8_BAR; PG8_SCHED;
            PG8_LDB(B0, 1, 0); PG8_LDB(B1, 1, 1); PG8_SCHED; PG8_LDA(At, 1, 0); PG8_STAGE(PG8_SA(0, 1), a2 + hstep, voffA);
            PG8_WAIT_V(8); PG8_WAIT_L(0); PG8_BAR; PG8_MMA(0, 0, At, B0); PG8_MMA(0, 1, At, B1); PG8_BAR; PG8_SCHED;
            PG8_LDA(At, 1, 1); PG8_STAGE(PG8_SB(1, 0), b3, voffB); PG8_STAGE(PG8_SB(1, 1), b3 + hstep, voffB); PG8_STAGE(PG8_SA(1, 0), a3, voffA);
            PG8_WAIT_V(8); PG8_WAIT_L(0); PG8_BAR; PG8_MMA(1, 0, At, B0); PG8_MMA(1, 1, At, B1); PG8_BAR; PG8_SCHED;
            } else {
            PG8_LDB(B0, 0, 0); PG8_SCHED; PG8_LDA(At, 0, 0); PG8_STAGE(PG8_SA(1, 1), a1 + hstep, voffA);
            PG8_WAIT_L(8); PG8_BAR; PG8_WAIT_L(0); PG8_MMA(0, 0, At, B0); PG8_BAR; PG8_SCHED;
            PG8_LDB(B1, 0, 1); PG8_STAGE(PG8_SB(0, 0), b2, voffB);
            PG8_BAR; PG8_WAIT_L(0); PG8_MMA(0, 1, At, B1); PG8_BAR;
            PG8_LDA(At, 0, 1); PG8_STAGE(PG8_SA(0, 0), a2, voffA);
            PG8_BAR; PG8_WAIT_L(0); PG8_MMA(1, 0, At, B0); PG8_BAR; PG8_SCHED;
            PG8_STAGE(PG8_SB(0, 1), b2 + hstep, voffB);
            PG8_WAIT_V(6); PG8_BAR; PG8_MMA(1, 1, At, B1); PG8_BAR;
            PG8_LDB(B0, 1, 0); PG8_SCHED; PG8_LDA(At, 1, 0); PG8_STAGE(PG8_SA(0, 1), a2 + hstep, voffA);
            PG8_WAIT_L(8); PG8_BAR; PG8_WAIT_L(0); PG8_MMA(0, 0, At, B0); PG8_BAR; PG8_SCHED;
            PG8_LDB(B1, 1, 1); PG8_STAGE(PG8_SB(1, 0), b3, voffB);
            PG8_BAR; PG8_WAIT_L(0); PG8_MMA(0, 1, At, B1); PG8_BAR;
            PG8_LDA(At, 1, 1); PG8_STAGE(PG8_SA(1, 0), a3, voffA);
            PG8_BAR; PG8_WAIT_L(0); PG8_MMA(1, 0, At, B0); PG8_BAR; PG8_SCHED;
            PG8_STAGE(PG8_SB(1, 1), b3 + hstep, voffB);
            PG8_WAIT_V(6); PG8_BAR; PG8_MMA(1, 1, At, B1); PG8_BAR;
            }
        }
        if constexpr (ALIGN_EPI) { if (wr == 0) PG8_BAR; }
        if (cur.second) {
        if (S.dbl) {
#pragma unroll
        for (int a = 0; a < 2; ++a)
#pragma unroll
            for (int b = 0; b < 2; ++b)
#pragma unroll
                for (int m = 0; m < 4; ++m)
#pragma unroll
                    for (int n = 0; n < 2; ++n) acc[a][b][m][n] = acc[a][b][m][n] * 0.5f;
        }
        E(acc, cur, wr, wc, fr, fq);
        if constexpr (Epi::IDEM) { if (EPI_DOUBLE) { asm volatile("" ::: "memory"); E(acc, cur, wr, wc, fr, fq); } }
        }
        if (!has_next) break;
        if (cur.second) {
#pragma unroll
        for (int a = 0; a < 2; ++a)
#pragma unroll
            for (int b = 0; b < 2; ++b)
#pragma unroll
                for (int m = 0; m < 4; ++m)
#pragma unroll
                    for (int n = 0; n < 2; ++n) acc[a][b][m][n] = (f32x4){0.f, 0.f, 0.f, 0.f};
        }
        cur = nxt; cA = nA; cB = nB; ++ui;
        if constexpr (ALIGN_EPI) { if (wr == 1) PG8_BAR; }
    }
    PG8_WAIT_V(0);
    if constexpr (!ALIGN_EPI) { if (wr == 0) PG8_BAR; }
    PG8_BAR;
#undef PG8_SA
#undef PG8_SB
#undef PG8_STAGE
#undef PG8_LDA
#undef PG8_LDB
#undef PG8_MMA
#undef PG8_WAIT_V
#undef PG8_WAIT_L
#undef PG8_BAR
#undef PG8_SCHED
}
}
using pg8::Unit;

struct EpiIn {
    static constexpr bool IDEM = true;
    static constexpr bool MID = false;
    bf16_t* big; const float* qn_a; const float* kn_a; const float* qn_b; const float* kn_b; const f32x2* rope;
    __device__ __forceinline__ void operator()(const f32x4 (&acc)[2][2][4][2], const Unit& u, int wr, int wc, int fr, int fq) const {
        const int hg = u.pn * 4 + wc;
        int kind; bf16_t* dst; int pitch, hcol; const float* gain = nullptr;
        if (hg < 6)       { kind = 1 | 256; dst = big + B_QA; pitch = 384; hcol = hg * 64; gain = qn_a; }
        else if (hg < 12) { kind = 1;       dst = big + B_KA; pitch = 384; hcol = (hg - 6) * 64; gain = kn_a; }
        else if (hg < 18) { kind = 3;       dst = big + B_VAT; pitch = T; hcol = (hg - 12) * 64; }
        else if (hg < 24) { kind = 2 | 256; dst = big + B_QB; pitch = 384; hcol = (hg - 18) * 64; gain = qn_b; }
        else if (hg < 26) { kind = 2;       dst = big + B_KB; pitch = 128; hcol = (hg - 24) * 64; gain = kn_b; }
        else if (hg < 28) { kind = 3;       dst = big + B_VBT; pitch = T; hcol = (hg - 26) * 64; }
        else if (hg < 32) { kind = 0;       dst = big + B_PC; pitch = 256; hcol = (hg - 28) * 64; }
        else              { kind = 4;       dst = big + B_G; pitch = 3072; hcol = (hg - 32) * 64; }
        const int k = kind & 255; const float qs = (kind & 256) ? QSCALE : 1.0f;
        f32x4 gv[2][2];
        if (k == 1 || k == 2) {
#pragma unroll
            for (int bj = 0; bj < 2; ++bj)
#pragma unroll
                for (int n = 0; n < 2; ++n) gv[bj][n] = *(const f32x4*)(gain + 32 * bj + 16 * n + 4 * fq) * qs;
        }
        f32x4 ropeR[2][2], ropeC[4][2];
        const bool do_rope = (k == 2 && u.pm * 256 < TL);
        if (do_rope) {
#pragma unroll
            for (int m = 0; m < 4; ++m) { const int pos = m * 16 + fr; const f32x4* rp = (const f32x4*)(rope + pos * 16 + 4 * fq); ropeC[m][0] = rp[0]; ropeC[m][1] = rp[1]; }
            __builtin_amdgcn_sched_barrier(0);
        }
#pragma unroll
        for (int ai = 0; ai < 2; ++ai) {
            if (do_rope) { const int pos = ((u.pm * 256 + ai * 128 + wr * 64) & (SEQ - 1)) >> 6; const f32x4* rp = (const f32x4*)(rope + pos * 16 + 4 * fq); ropeR[ai][0] = rp[0]; ropeR[ai][1] = rp[1]; }
#pragma unroll
            for (int m = 0; m < 4; ++m) {
                const int row = u.pm * 256 + ai * 128 + wr * 64 + m * 16 + fr;
                f32x4 v[2][2];
#pragma unroll
                for (int bj = 0; bj < 2; ++bj)
#pragma unroll
                    for (int n = 0; n < 2; ++n) v[bj][n] = acc[ai][bj][m][n];
                if (k == 1 || k == 2) {
                    float ss = 0.f;
#pragma unroll
                    for (int bj = 0; bj < 2; ++bj)
#pragma unroll
                        for (int n = 0; n < 2; ++n) { const f32x4 x = v[bj][n]; ss += (x[0] * x[0] + x[1] * x[1]) + (x[2] * x[2] + x[3] * x[3]); }
                    ss += __shfl_xor(ss, 16); ss += __shfl_xor(ss, 32);
                    const float rinv = __builtin_amdgcn_rsqf(ss * (1.0f / 64.0f) + EPS);
#pragma unroll
                    for (int bj = 0; bj < 2; ++bj)
#pragma unroll
                        for (int n = 0; n < 2; ++n) v[bj][n] = v[bj][n] * rinv * gv[bj][n];
                    if (k == 2 && row < TL) {
#pragma unroll
                        for (int bj = 0; bj < 2; ++bj) {
                            const f32x4 q0 = bj ? ropeC[m][0] : ropeR[ai][0], q1 = bj ? ropeC[m][1] : ropeR[ai][1];
                            const float cs[4] = {q0[0], q0[2], q1[0], q1[2]}, sn[4] = {q0[1], q0[3], q1[1], q1[3]};
#pragma unroll
                            for (int j = 0; j < 4; ++j) { const float x1 = v[bj][0][j], x2 = v[bj][1][j];
                                v[bj][0][j] = x1 * cs[j] - x2 * sn[j]; v[bj][1][j] = x2 * cs[j] + x1 * sn[j]; }
                        }
                    }
                } else if (k == 4) {
#pragma unroll
                    for (int bj = 0; bj < 2; ++bj)
#pragma unroll
                        for (int n = 0; n < 2; ++n)
#pragma unroll
                            for (int j = 0; j < 4; ++j) v[bj][n][j] = sigmoidf_(v[bj][n][j]);
                }
                if (k == 3) {
#pragma unroll
                    for (int bj = 0; bj < 2; ++bj)
#pragma unroll
                        for (int n = 0; n < 2; ++n)
#pragma unroll
                            for (int j = 0; j < 4; ++j) dst[(size_t)(hcol + 32 * bj + 16 * n + 4 * fq + j) * T + row] = (bf16_t)f2bf(v[bj][n][j]);
                } else {
                    bf16_t* rp = dst + (size_t)row * pitch + hcol + 4 * fq;
#pragma unroll
                    for (int bj = 0; bj < 2; ++bj)
#pragma unroll
                        for (int n = 0; n < 2; ++n) { u32x2 w; w.x = pk2(v[bj][n][0], v[bj][n][1]); w.y = pk2(v[bj][n][2], v[bj][n][3]); *(u32x2*)(rp + 32 * bj + 16 * n) = w; }
                }
            }
        }
    }
};

struct EpiMerge {
    static constexpr bool IDEM = false;
    static constexpr bool MID = true;
    const bf16_t* G; bf16_t* Mo;
    __device__ __forceinline__ void mid(f32x4 (&acc)[2][2][4][2], const Unit& u, int which, int wr, int wc, int fr, int fq) const {
        const bf16_t* g0 = G + (size_t)(u.pm * 256 + wr * 64 + fr) * 3072 + which * 1024 + u.pn * 256 + 32 * wc + 8 * fq;
#pragma unroll
        for (int ai = 0; ai < 2; ++ai) {
            u32x4 ga[4][2], gb[4][2];
#pragma unroll
            for (int m = 0; m < 4; ++m)
#pragma unroll
                for (int bj = 0; bj < 2; ++bj) { const bf16_t* gp = g0 + (size_t)(ai * 128 + m * 16) * 3072 + 128 * bj; ga[m][bj] = *(const u32x4*)gp; gb[m][bj] = *(const u32x4*)(gp + 1024); }
            __builtin_amdgcn_sched_barrier(0);
#pragma unroll
            for (int m = 0; m < 4; ++m)
#pragma unroll
                for (int bj = 0; bj < 2; ++bj) {
                    const u32x4 a = ga[m][bj], b = gb[m][bj];
#pragma unroll
                    for (int n = 0; n < 2; ++n) {
                        const unsigned a0 = n ? a.z : a.x, a1 = n ? a.w : a.y, b0 = n ? b.z : b.x, b1 = n ? b.w : b.y;
                        acc[ai][bj][m][n][0] *= bflo(a0) * fast_rcp(bflo(b0)); acc[ai][bj][m][n][1] *= bfhi(a0) * fast_rcp(bfhi(b0));
                        acc[ai][bj][m][n][2] *= bflo(a1) * fast_rcp(bflo(b1)); acc[ai][bj][m][n][3] *= bfhi(a1) * fast_rcp(bfhi(b1));
                    }
                }
            __builtin_amdgcn_sched_barrier(0);
        }
    }
    __device__ __forceinline__ void operator()(const f32x4 (&acc)[2][2][4][2], const Unit& u, int wr, int wc, int fr, int fq) const {
        const size_t r0 = (size_t)(u.pm * 256 + wr * 64 + fr); const int c0 = u.pn * 256 + 32 * wc + 8 * fq;
        u32x4 gc[2][4][2];
#pragma unroll
        for (int ai = 0; ai < 2; ++ai)
#pragma unroll
            for (int m = 0; m < 4; ++m)
#pragma unroll
                for (int bj = 0; bj < 2; ++bj) gc[ai][m][bj] = *(const u32x4*)(G + (r0 + ai * 128 + m * 16) * 3072 + 2048 + c0 + 128 * bj);
        __builtin_amdgcn_sched_barrier(0);
#pragma unroll
        for (int ai = 0; ai < 2; ++ai)
#pragma unroll
            for (int m = 0; m < 4; ++m)
#pragma unroll
                for (int bj = 0; bj < 2; ++bj) {
                    const u32x4 c = gc[ai][m][bj];
                    const f32x4 x0 = acc[ai][bj][m][0], x1 = acc[ai][bj][m][1];
                    u32x4 w;
                    w.x = pk2(x0[0] * bflo(c.x), x0[1] * bfhi(c.x)); w.y = pk2(x0[2] * bflo(c.y), x0[3] * bfhi(c.y));
                    w.z = pk2(x1[0] * bflo(c.z), x1[1] * bfhi(c.z)); w.w = pk2(x1[2] * bflo(c.w), x1[3] * bfhi(c.w));
                    *(u32x4*)(Mo + (r0 + ai * 128 + m * 16) * D + c0 + 128 * bj) = w;
                }
    }
};

struct EpiRes {
    static constexpr bool IDEM = false;
    static constexpr bool MID = false;
    const float* xs; float* xd; const float* hs; float* hd; const float* modl; int goff;
    __device__ __forceinline__ void operator()(const f32x4 (&acc)[2][2][4][2], const Unit& u, int wr, int wc, int fr, int fq) const {
        const int row0 = u.pm * 256; const bool lat = row0 < TL;
        const int b = lat ? (row0 >> 11) : 32;
        const float* src = (lat ? xs + (size_t)row0 * D : hs + (size_t)(row0 - TL) * D) + (size_t)(wr * 64 + fr) * D + u.pn * 256 + 32 * wc + 8 * fq;
        float* dst = (lat ? xd + (size_t)row0 * D : hd + (size_t)(row0 - TL) * D) + (size_t)(wr * 64 + fr) * D + u.pn * 256 + 32 * wc + 8 * fq;
        const float* gp = modl + (size_t)b * NMOD + goff + u.pn * 256 + 32 * wc + 8 * fq;
        f32x4 g[2][2];
#pragma unroll
        for (int bj = 0; bj < 2; ++bj) { g[bj][0] = *(const f32x4*)(gp + 128 * bj); g[bj][1] = *(const f32x4*)(gp + 128 * bj + 4); }
        f32x4 s[2][4][2];
#define ER_LOAD(k) do { const int bj_ = (k) >> 1, ai_ = (k) & 1; _Pragma("unroll") for (int m = 0; m < 4; ++m) { const size_t o = (size_t)(ai_ * 128 + m * 16) * D + 128 * bj_; \
            s[(k) & 1][m][0] = *(const f32x4*)(src + o); s[(k) & 1][m][1] = *(const f32x4*)(src + o + 4); } } while (0)
#define ER_STORE(k) do { const int bj_ = (k) >> 1, ai_ = (k) & 1; _Pragma("unroll") for (int m = 0; m < 4; ++m) { const size_t o = (size_t)(ai_ * 128 + m * 16) * D + 128 * bj_; \
            *(f32x4*)(dst + o) = s[(k) & 1][m][0] + g[bj_][0] * acc[ai_][bj_][m][0]; *(f32x4*)(dst + o + 4) = s[(k) & 1][m][1] + g[bj_][1] * acc[ai_][bj_][m][1]; } } while (0)
        ER_LOAD(0); __builtin_amdgcn_sched_barrier(0);
        ER_LOAD(1); __builtin_amdgcn_sched_barrier(0);
        ER_STORE(0); __builtin_amdgcn_sched_barrier(0);
        ER_LOAD(2); __builtin_amdgcn_sched_barrier(0);
        ER_STORE(1); __builtin_amdgcn_sched_barrier(0);
        ER_LOAD(3); __builtin_amdgcn_sched_barrier(0);
        ER_STORE(2); __builtin_amdgcn_sched_barrier(0);
        ER_STORE(3);
#undef ER_LOAD
#undef ER_STORE
    }
};

struct EpiResNorm {
    static constexpr bool IDEM = false;
    static constexpr bool MID = false;
    const float* xs; float* xd; const float* hs; float* hd; const float* modl; int goff;
    const float* ngain; const float* nmod; int nshift; bf16_t* U; float* slots; unsigned* cnt; LAS unsigned char* xl;
    __device__ __forceinline__ void operator()(f32x4 (&acc)[2][2][4][2], const Unit& u, int wr, int wc, int fr, int fq) const {
        const int row0 = u.pm * 256; const bool lat = row0 < TL;
        const int b = lat ? (row0 >> 11) : 32;
        const float* src = (lat ? xs + (size_t)row0 * D : hs + (size_t)(row0 - TL) * D) + (size_t)(wr * 64 + fr) * D + u.pn * 256 + 32 * wc + 8 * fq;
        float* dst = (lat ? xd + (size_t)row0 * D : hd + (size_t)(row0 - TL) * D) + (size_t)(wr * 64 + fr) * D + u.pn * 256 + 32 * wc + 8 * fq;
        const float* gp = modl + (size_t)b * NMOD + goff + u.pn * 256 + 32 * wc + 8 * fq;
        {
        f32x4 g[2][2];
#pragma unroll
        for (int bj = 0; bj < 2; ++bj) { g[bj][0] = *(const f32x4*)(gp + 128 * bj); g[bj][1] = *(const f32x4*)(gp + 128 * bj + 4); }
        f32x4 s[4][2];
#define ER_LOAD(k) do { const int bj_ = (k) >> 1, ai_ = (k) & 1; _Pragma("unroll") for (int m = 0; m < 4; ++m) { const size_t o = (size_t)(ai_ * 128 + m * 16) * D + 128 * bj_; \
            s[m][0] = *(const f32x4*)(src + o); s[m][1] = *(const f32x4*)(src + o + 4); } } while (0)
#define ER_STORE(k) do { const int bj_ = (k) >> 1, ai_ = (k) & 1; _Pragma("unroll") for (int m = 0; m < 4; ++m) { const size_t o = (size_t)(ai_ * 128 + m * 16) * D + 128 * bj_; \
            acc[ai_][bj_][m][0] = s[m][0] + g[bj_][0] * acc[ai_][bj_][m][0]; acc[ai_][bj_][m][1] = s[m][1] + g[bj_][1] * acc[ai_][bj_][m][1]; \
            *(f32x4*)(dst + o) = acc[ai_][bj_][m][0]; *(f32x4*)(dst + o + 4) = acc[ai_][bj_][m][1]; } } while (0)
        ER_LOAD(0); __builtin_amdgcn_sched_barrier(0); ER_STORE(0); __builtin_amdgcn_sched_barrier(0);
        ER_LOAD(1); __builtin_amdgcn_sched_barrier(0); ER_STORE(1); __builtin_amdgcn_sched_barrier(0);
        ER_LOAD(2); __builtin_amdgcn_sched_barrier(0); ER_STORE(2); __builtin_amdgcn_sched_barrier(0);
        ER_LOAD(3); __builtin_amdgcn_sched_barrier(0); ER_STORE(3); __builtin_amdgcn_sched_barrier(0);
#undef ER_LOAD
#undef ER_STORE
        }
        LAS float* P = (LAS float*)xl; LAS float* S = P + 1024;
        const int tid = (wr * 4 + wc) * 64 + fq * 16 + fr;
#pragma unroll
        for (int ai = 0; ai < 2; ++ai)
#pragma unroll
            for (int m = 0; m < 4; ++m) {
                float ss = 0.f;
#pragma unroll
                for (int bj = 0; bj < 2; ++bj)
#pragma unroll
                    for (int n = 0; n < 2; ++n) { const f32x4 x = acc[ai][bj][m][n]; ss += (x[0] * x[0] + x[1] * x[1]) + (x[2] * x[2] + x[3] * x[3]); }
                ss += __shfl_xor(ss, 16); ss += __shfl_xor(ss, 32);
                if (fq == 0) P[(ai * 128 + wr * 64 + m * 16 + fr) * 4 + wc] = ss;
            }
        asm volatile("s_waitcnt lgkmcnt(0)" ::: "memory"); __builtin_amdgcn_s_barrier(); asm volatile("" ::: "memory");
        if (tid < 256) {
            const float tot = (P[tid * 4 + 0] + P[tid * 4 + 1]) + (P[tid * 4 + 2] + P[tid * 4 + 3]);
            __hip_atomic_store(slots + (size_t)(row0 + tid) * 4 + u.pn, tot, __ATOMIC_RELAXED, __HIP_MEMORY_SCOPE_AGENT);
        }
        asm volatile("s_waitcnt vmcnt(0)" ::: "memory");
        if (tid < 256 && (tid & 63) == 0) __hip_atomic_fetch_add(cnt + u.pm, 1u, __ATOMIC_RELAXED, __HIP_MEMORY_SCOPE_AGENT);
        if (tid < 64) {
            unsigned sp = 0;
            while (__hip_atomic_load(cnt + u.pm, __ATOMIC_RELAXED, __HIP_MEMORY_SCOPE_AGENT) < 16u) { __builtin_amdgcn_s_sleep(2); if (++sp > (1u << 22)) break; }
            __builtin_amdgcn_fence(__ATOMIC_ACQUIRE, "agent");
        }
        asm volatile("s_waitcnt vmcnt(0) lgkmcnt(0)" ::: "memory"); __builtin_amdgcn_s_barrier(); asm volatile("" ::: "memory");
        if (tid < 256) {
            const float* sl = slots + (size_t)(row0 + tid) * 4;
            const float t4 = (__hip_atomic_load(sl + 0, __ATOMIC_RELAXED, __HIP_MEMORY_SCOPE_AGENT) + __hip_atomic_load(sl + 1, __ATOMIC_RELAXED, __HIP_MEMORY_SCOPE_AGENT))
                           + (__hip_atomic_load(sl + 2, __ATOMIC_RELAXED, __HIP_MEMORY_SCOPE_AGENT) + __hip_atomic_load(sl + 3, __ATOMIC_RELAXED, __HIP_MEMORY_SCOPE_AGENT));
            S[tid] = __builtin_amdgcn_rsqf(t4 * (1.0f / D) + EPS);
        }
        asm volatile("s_waitcnt lgkmcnt(0)" ::: "memory"); __builtin_amdgcn_s_barrier(); asm volatile("" ::: "memory");
        const float* mp = nmod + (size_t)b * NMOD + nshift + u.pn * 256 + 32 * wc + 8 * fq;
        const float* ng = ngain + u.pn * 256 + 32 * wc + 8 * fq;
        bf16_t* up = U + (size_t)(row0 + wr * 64 + fr) * D + u.pn * 256 + 32 * wc + 8 * fq;
#pragma unroll
        for (int bj = 0; bj < 2; ++bj) {
            const f32x4 sh0 = *(const f32x4*)(mp + 128 * bj), sh1 = *(const f32x4*)(mp + 128 * bj + 4);
            const f32x4 gs0 = *(const f32x4*)(ng + 128 * bj) * (*(const f32x4*)(mp + D + 128 * bj) + 1.0f), gs1 = *(const f32x4*)(ng + 128 * bj + 4) * (*(const f32x4*)(mp + D + 128 * bj + 4) + 1.0f);
#pragma unroll
            for (int ai = 0; ai < 2; ++ai)
#pragma unroll
                for (int m = 0; m < 4; ++m) {
                    const float rstd = S[ai * 128 + wr * 64 + m * 16 + fr];
                    const f32x4 y0 = acc[ai][bj][m][0] * rstd * gs0 + sh0, y1 = acc[ai][bj][m][1] * rstd * gs1 + sh1;
                    u32x4 w; w.x = pk2(y0[0], y0[1]); w.y = pk2(y0[2], y0[3]); w.z = pk2(y1[0], y1[1]); w.w = pk2(y1[2], y1[3]);
                    *(u32x4*)(up + (size_t)(ai * 128 + m * 16) * D + 128 * bj) = w;
                }
        }
    }
};

struct EpiFF1 {
    static constexpr bool IDEM = true;
    static constexpr bool MID = false;
    bf16_t* H1;
    __device__ __forceinline__ void operator()(const f32x4 (&acc)[2][2][4][2], const Unit& u, int wr, int wc, int fr, int fq) const {
        const int col = u.pn * 128 + 32 * wc + 8 * fq;
#pragma unroll
        for (int ai = 0; ai < 2; ++ai)
#pragma unroll
            for (int m = 0; m < 4; ++m) {
                const int row = u.pm * 256 + ai * 128 + wr * 64 + m * 16 + fr;
                float r[8];
#pragma unroll
                for (int n = 0; n < 2; ++n)
#pragma unroll
                    for (int j = 0; j < 4; ++j) { const float a = acc[ai][0][m][n][j], b = acc[ai][1][m][n][j]; r[4 * n + j] = a * sigmoidf_(a) * b; }
                u32x4 w; w.x = pk2(r[0], r[1]); w.y = pk2(r[2], r[3]); w.z = pk2(r[4], r[5]); w.w = pk2(r[6], r[7]);
                *(u32x4*)(H1 + (size_t)row * FF + col) = w;
            }
    }
};

struct EpiMod {
    static constexpr bool IDEM = false;
    static constexpr bool MID = false;
    float* mod; const float* bmod;
    __device__ __forceinline__ void operator()(const f32x4 (&acc)[2][2][4][2], const Unit& u, int wr, int wc, int fr, int fq) const {
        if (wr != 0) return;
#pragma unroll
        for (int m = 0; m < 3; ++m) {
            const int row = m * 16 + fr; if (row >= 33) continue;
#pragma unroll
            for (int bj = 0; bj < 2; ++bj)
#pragma unroll
                for (int n = 0; n < 2; ++n) {
                    const int nn = u.pn * 256 + 128 * bj + 32 * wc + 16 * n + 4 * fq;
                    const int l = nn / NMOD, c = nn - l * NMOD;
                    const f32x4 bv = *(const f32x4*)(bmod + nn);
                    *(f32x4*)(mod + ((size_t)l * 33 + row) * NMOD + c) = acc[0][bj][m][n] + bv;
                }
        }
    }
};

struct Args { const float* in[23]; float* out; unsigned char* ws; float freq[16]; int ph_lo, ph_hi; };
typedef const __attribute__((address_space(4))) Args* KArgsPtr;

__device__ __forceinline__ int p8map(int p) { return (p & 0xe0) | (((p >> 2) & 3) << 3) | (((p >> 4) & 1) << 2) | (p & 3); }
__device__ __forceinline__ void prep_item(KArgsPtr a, unsigned char* ws, int l, int mid, int item, LAS float* scr, int lane) {
    int K, N; if (mid == 0) { K = D; N = NIN; } else if (mid == 1 || mid == 2) { K = D; N = D; } else if (mid == 3) { K = D; N = 2 * FF; } else if (mid == 4) { K = FF; N = D; } else { K = D; N = NMOD; }
    const int nblk = N / 32, kb = item / nblk, nb = item % nblk, k0 = 64 * kb, n0 = 32 * nb;
    const int r = n0 + (lane & 31), tile = r >> 8, p = r & 255;
    const float* src; int ld, col, krow = k0; bf16_t* WT;
    if (mid == 0) { src = a->in[8] + (size_t)l * D * NIN; ld = NIN; col = tile * 256 + ((p >> 5) & 3) * 64 + (p >> 7) * 32 + (p & 31); WT = (bf16_t*)(ws + WS_WIN) + (size_t)l * NIN * D; }
    else if (mid == 1) { ld = D; col = tile * 256 + p8map(p); WT = (bf16_t*)(ws + WS_WBR) + (size_t)l * D * D;
        if (k0 < 384) { src = a->in[16] + (size_t)l * 384 * D; } else if (k0 < 768) { src = a->in[17] + (size_t)l * 384 * D; krow = k0 - 384; } else { src = a->in[18] + (size_t)l * 256 * D; krow = k0 - 768; } }
    else if (mid == 2) { src = a->in[19] + (size_t)l * D * D; ld = D; col = tile * 256 + p8map(p); WT = (bf16_t*)(ws + WS_WOUT) + (size_t)l * D * D; }
    else if (mid == 3) { src = ((p >> 7) ? a->in[21] : a->in[20]) + (size_t)l * D * FF; ld = FF; col = tile * 128 + (p8map(p) & 127); WT = (bf16_t*)(ws + WS_W13) + (size_t)l * 2 * FF * D; }
    else if (mid == 4) { src = a->in[22] + (size_t)l * FF * D; ld = D; col = tile * 256 + p8map(p); WT = (bf16_t*)(ws + WS_W2) + (size_t)l * D * FF; }
    else { src = a->in[4] + (size_t)l * D * NMOD; ld = NMOD; col = r; WT = (bf16_t*)(ws + WS_BIG) + (size_t)l * NMOD * D; }
#pragma unroll 8
    for (int i = 0; i < 32; ++i) { const int kk = 2 * i + (lane >> 5); scr[kk * 33 + (lane & 31)] = src[(size_t)(krow + kk) * ld + col]; }
    asm volatile("s_waitcnt lgkmcnt(0)" ::: "memory");
    const int c = lane & 7;
#pragma unroll
    for (int j = 0; j < 4; ++j) { const int n = (lane >> 3) + 8 * j; const LAS float* s = scr + (8 * c) * 33 + n;
        u32x4 o; o.x = pk2(s[0 * 33], s[1 * 33]); o.y = pk2(s[2 * 33], s[3 * 33]); o.z = pk2(s[4 * 33], s[5 * 33]); o.w = pk2(s[6 * 33], s[7 * 33]);
        *(u32x4*)(WT + (size_t)(n0 + n) * K + k0 + 8 * c) = o; }
    asm volatile("s_waitcnt lgkmcnt(0)" ::: "memory");
}

__device__ __forceinline__ void prep_phase(KArgsPtr a, LAS unsigned char* lds, int tid, int wid, int lane, int bid, int nblk_) {
    unsigned char* ws = a->ws;
    LAS float* scr = (LAS float*)(lds + wid * 8704);
    const int gw = bid * 8 + wid, NGW = nblk_ * 8;
    constexpr int I0 = 16 * 160, I1 = 16 * 32, I2 = 16 * 32, I3 = 16 * 176, I4 = 44 * 32, I5 = 16 * 192, IL = I0 + I1 + I2 + I3 + I4 + I5;
    for (int it = gw; it < IL * DEPTH; it += NGW) {
        const int l = it / IL; int r = it - l * IL; int mid;
        if (r < I0) mid = 0; else if ((r -= I0) < I1) mid = 1; else if ((r -= I1) < I2) mid = 2; else if ((r -= I2) < I3) mid = 3; else if ((r -= I3) < I4) mid = 4; else { r -= I4; mid = 5; }
        prep_item(a, ws, l, mid, r, scr, lane);
    }
    bf16_t* SC = (bf16_t*)(ws + WS_SC);
    for (int i = bid * 512 + tid; i < 256 * 1024; i += nblk_ * 512) {
        const int row = i >> 10, k = i & 1023; float v = 0.f;
        if (row < 32) v = a->in[1][row * D + k]; else if (row == 32) v = a->in[3][k];
        SC[i] = (bf16_t)f2bf(row <= 32 ? v * sigmoidf_(v) : 0.f);
    }
    f32x2* rope = (f32x2*)(ws + WS_ROPE);
    for (int i = bid * 512 + tid; i < 64 * 16; i += nblk_ * 512) {
        const int pos = i >> 4, fi = i & 15;
        const float ang = (float)pos * a->freq[fi];
        float rev = ang * 0.15915494309189535f; rev = rev - floorf(rev);
        rope[i] = (f32x2){__builtin_amdgcn_cosf(rev), __builtin_amdgcn_sinf(rev)};
    }
}

__device__ __forceinline__ void norm_phase(const float* xl, const float* xc, const float* gain, const float* modl, int shift_off, int nrows, bf16_t* U, int wid, int lane, int bid, int nblk_) {
    const int gw = bid * 8 + wid, NGW = nblk_ * 8;
    f32x4 gv[4];
#pragma unroll
    for (int j = 0; j < 4; ++j) gv[j] = *(const f32x4*)(gain + 4 * (lane + 64 * j));
    for (int row0 = gw; row0 < nrows; row0 += 4 * NGW) {
        f32x4 v[4][4]; float ss[4];
#pragma unroll
        for (int r = 0; r < 4; ++r) {
            const int row = row0 + r * NGW; ss[r] = 0.f;
            if (row < nrows) {
                const float* src = row < TL ? xl + (size_t)row * D : xc + (size_t)(row - TL) * D;
#pragma unroll
                for (int j = 0; j < 4; ++j) v[r][j] = *(const f32x4*)(src + 4 * (lane + 64 * j));
            } else {
#pragma unroll
                for (int j = 0; j < 4; ++j) v[r][j] = (f32x4){0.f, 0.f, 0.f, 0.f};
            }
        }
#pragma unroll
        for (int r = 0; r < 4; ++r) {
            const int row = row0 + r * NGW;
            if (row >= nrows) continue;
#pragma unroll
            for (int j = 0; j < 4; ++j) ss[r] += (v[r][j][0] * v[r][j][0] + v[r][j][1] * v[r][j][1]) + (v[r][j][2] * v[r][j][2] + v[r][j][3] * v[r][j][3]);
            const float rstd = __builtin_amdgcn_rsqf(wave_sum(ss[r]) * (1.0f / D) + EPS);
            const int b = row < TL ? (row >> 11) : 32;
            const float* mp = modl + (size_t)b * NMOD + shift_off;
#pragma unroll
            for (int j = 0; j < 4; ++j) {
                const int c = 4 * (lane + 64 * j);
                const f32x4 sh = *(const f32x4*)(mp + c), sc = *(const f32x4*)(mp + D + c);
                const f32x4 y = v[r][j] * rstd * gv[j] * (sc + 1.0f) + sh;
                u32x2 w; w.x = pk2(y[0], y[1]); w.y = pk2(y[2], y[3]);
                *(u32x2*)(U + (size_t)row * D + c) = w;
            }
        }
    }
}

struct AttnJob {
    const bf16_t* Q; int qpitch;
    const bf16_t* K; int kpitch;
    const bf16_t* Vt;
    bf16_t* O;
    int ctx_row0, lat_row0, ntiles;
    int na, r0, rlo;
    int fast;
};
#define MFMA32(a, b, c) __builtin_amdgcn_mfma_f32_32x32x16_bf16((a), (b), (c), 0, 0, 0)

__device__ __forceinline__ void glds16(const void* gsrc, unsigned lds_dst) { unsigned keep;
    asm volatile("s_mov_b32 %0, m0\n\ts_mov_b32 m0, %2\n\ts_nop 0\n\tglobal_load_lds_dwordx4 %1, off\n\ts_mov_b32 m0, %0" : "=&s"(keep) : "v"(gsrc), "s"(lds_dst) : "memory"); }
template <bool FAST>
__device__ __forceinline__ void att_scores(const LAS unsigned char* kb_, const bf16x8 (&qf)[4], int pi, int kx, int hi, bool local, const LAS float* bp, unsigned vmask, bool first,
                                           float& mrun, f32x16& o0, f32x16& o1, float& lrun, bf16x8 (&pf)[2][2]) {
    constexpr float THR = 8.0f;
    f32x16 s0, s1;
    if constexpr (FAST) {
#pragma unroll
        for (int i = 0; i < 16; ++i) { s0[i] = 0.f; s1[i] = 0.f; }
    } else {
        const float nm = -mrun;
#pragma unroll
        for (int i = 0; i < 16; ++i) { s0[i] = nm; s1[i] = nm; }
    }
    {
        bf16x8 a0[4], a1[4];
#pragma unroll
        for (int ks = 0; ks < 4; ++ks) { a0[ks] = *(const LAS bf16x8*)(kb_ + pi * 128 + (((2 * ks + hi) ^ kx) << 4)); a1[ks] = *(const LAS bf16x8*)(kb_ + (32 + pi) * 128 + (((2 * ks + hi) ^ kx) << 4)); }
        __builtin_amdgcn_sched_barrier(0);
#pragma unroll
        for (int ks = 0; ks < 4; ++ks) s0 = MFMA32(a0[ks], qf[ks], s0);
#pragma unroll
        for (int ks = 0; ks < 4; ++ks) s1 = MFMA32(a1[ks], qf[ks], s1);
    }
    if (local) {
#pragma unroll
        for (int i = 0; i < 16; ++i) {
            const float b0 = bp[16 * (i >> 3) + (i & 7)], b1 = bp[32 + 16 * (i >> 3) + (i & 7)];
            const unsigned m0 = (unsigned)__builtin_amdgcn_sbfe((int)vmask, i, 1), m1 = (unsigned)__builtin_amdgcn_sbfe((int)vmask, 16 + i, 1);
            const unsigned v0 = __builtin_bit_cast(unsigned, s0[i] + b0), v1 = __builtin_bit_cast(unsigned, s1[i] + b1);
            s0[i] = __builtin_bit_cast(float, (v0 & m0) | (0xf149f2cau & ~m0));
            s1[i] = __builtin_bit_cast(float, (v1 & m1) | (0xf149f2cau & ~m1));
            if ((i & 3) == 3) __builtin_amdgcn_sched_barrier(0);
        }
    }
    if constexpr (!FAST) {
    float mt = fmaxf(s0[0], s1[0]);
#pragma unroll
    for (int i = 1; i < 16; ++i) mt = fmaxf(mt, fmaxf(s0[i], s1[i]));
    mt = fmaxf(mt, __shfl_xor(mt, 32));
    if (first || __any(mt > THR)) {
        const float delta = first ? mt : (mt > THR ? mt : 0.f);
        const float alpha = first ? 1.0f : fast_exp2(-delta);
        mrun += delta;
#pragma unroll
        for (int i = 0; i < 16; ++i) { s0[i] -= delta; s1[i] -= delta; o0[i] *= alpha; o1[i] *= alpha; }
        lrun *= alpha;
    }
    }
    float rs = 0.f;
#pragma unroll
    for (int i = 0; i < 16; ++i) { s0[i] = fast_exp2(s0[i]); s1[i] = fast_exp2(s1[i]); rs += s0[i] + s1[i]; }
    lrun += rs;
#pragma unroll
    for (int cc = 0; cc < 2; ++cc) {
        u32x4 w0, w1;
        w0.x = pk2(s0[8 * cc + 0], s0[8 * cc + 1]); w0.y = pk2(s0[8 * cc + 2], s0[8 * cc + 3]); w0.z = pk2(s0[8 * cc + 4], s0[8 * cc + 5]); w0.w = pk2(s0[8 * cc + 6], s0[8 * cc + 7]);
        w1.x = pk2(s1[8 * cc + 0], s1[8 * cc + 1]); w1.y = pk2(s1[8 * cc + 2], s1[8 * cc + 3]); w1.z = pk2(s1[8 * cc + 4], s1[8 * cc + 5]); w1.w = pk2(s1[8 * cc + 6], s1[8 * cc + 7]);
        pf[0][cc] = __builtin_bit_cast(bf16x8, w0); pf[1][cc] = __builtin_bit_cast(bf16x8, w1);
    }
}
__device__ __forceinline__ void att_pv(const LAS unsigned char* vb_, int q, int vx, int hi, const bf16x8 (&pf)[2][2], f32x16& o0, f32x16& o1) {
#pragma unroll
    for (int kb = 0; kb < 2; ++kb) {
        bf16x8 v0[2], v1[2];
#pragma unroll
        for (int cc = 0; cc < 2; ++cc) { const int ch = 4 * kb + 2 * cc + hi;
            v0[cc] = *(const LAS bf16x8*)(vb_ + q * 128 + ((ch ^ vx) << 4)); v1[cc] = *(const LAS bf16x8*)(vb_ + (32 + q) * 128 + ((ch ^ vx) << 4)); }
        __builtin_amdgcn_sched_barrier(0);
#pragma unroll
        for (int cc = 0; cc < 2; ++cc) { o0 = MFMA32(v0[cc], pf[kb][cc], o0); o1 = MFMA32(v1[cc], pf[kb][cc], o1); }
        __builtin_amdgcn_sched_barrier(0);
    }
}

__device__ __forceinline__ void att_tile_fast(const LAS unsigned char* kb_, const LAS unsigned char* vb_, const bf16x8 (&qf)[4], int pi, int kx, int q, int vx, int hi,
                                              f32x16& o0, f32x16& o1, float& lrun) {
    bf16x8 a0[4], a1[4];
#pragma unroll
    for (int ks = 0; ks < 4; ++ks) { a0[ks] = *(const LAS bf16x8*)(kb_ + pi * 128 + (((2 * ks + hi) ^ kx) << 4)); a1[ks] = *(const LAS bf16x8*)(kb_ + (32 + pi) * 128 + (((2 * ks + hi) ^ kx) << 4)); }
    __builtin_amdgcn_sched_barrier(0);
    f32x16 s0, s1;
#pragma unroll
    for (int i = 0; i < 16; ++i) { s0[i] = 0.f; s1[i] = 0.f; }
#pragma unroll
    for (int ks = 0; ks < 4; ++ks) s0 = MFMA32(a0[ks], qf[ks], s0);
    __builtin_amdgcn_sched_barrier(0);
    float rs = 0.f;
#pragma unroll
    for (int ks = 0; ks < 4; ++ks) {
        s1 = MFMA32(a1[ks], qf[ks], s1);
#pragma unroll
        for (int i = 4 * ks; i < 4 * ks + 4; ++i) { s0[i] = fast_exp2(s0[i]); rs += s0[i]; }
        __builtin_amdgcn_sched_barrier(0);
    }
    bf16x8 p0[2];
#pragma unroll
    for (int cc = 0; cc < 2; ++cc) { u32x4 w; w.x = pk2(s0[8 * cc + 0], s0[8 * cc + 1]); w.y = pk2(s0[8 * cc + 2], s0[8 * cc + 3]); w.z = pk2(s0[8 * cc + 4], s0[8 * cc + 5]); w.w = pk2(s0[8 * cc + 6], s0[8 * cc + 7]); p0[cc] = __builtin_bit_cast(bf16x8, w); }
    bf16x8 va0[2], va1[2];
#pragma unroll
    for (int cc = 0; cc < 2; ++cc) { const int ch = 2 * cc + hi; va0[cc] = *(const LAS bf16x8*)(vb_ + q * 128 + ((ch ^ vx) << 4)); va1[cc] = *(const LAS bf16x8*)(vb_ + (32 + q) * 128 + ((ch ^ vx) << 4)); }
    __builtin_amdgcn_sched_barrier(0);
#pragma unroll
    for (int g = 0; g < 4; ++g) {
        if (g & 1) o1 = MFMA32(va1[g >> 1], p0[g >> 1], o1); else o0 = MFMA32(va0[g >> 1], p0[g >> 1], o0);
#pragma unroll
        for (int i = 4 * g; i < 4 * g + 4; ++i) { s1[i] = fast_exp2(s1[i]); rs += s1[i]; }
        __builtin_amdgcn_sched_barrier(0);
    }
    bf16x8 vb0[2], vb1[2];
#pragma unroll
    for (int cc = 0; cc < 2; ++cc) { const int ch = 4 + 2 * cc + hi; vb0[cc] = *(const LAS bf16x8*)(vb_ + q * 128 + ((ch ^ vx) << 4)); vb1[cc] = *(const LAS bf16x8*)(vb_ + (32 + q) * 128 + ((ch ^ vx) << 4)); }
    bf16x8 p1[2];
#pragma unroll
    for (int cc = 0; cc < 2; ++cc) { u32x4 w; w.x = pk2(s1[8 * cc + 0], s1[8 * cc + 1]); w.y = pk2(s1[8 * cc + 2], s1[8 * cc + 3]); w.z = pk2(s1[8 * cc + 4], s1[8 * cc + 5]); w.w = pk2(s1[8 * cc + 6], s1[8 * cc + 7]); p1[cc] = __builtin_bit_cast(bf16x8, w); }
#pragma unroll
    for (int cc = 0; cc < 2; ++cc) { o0 = MFMA32(vb0[cc], p1[cc], o0); o1 = MFMA32(vb1[cc], p1[cc], o1); }
    lrun += rs;
}

__device__ __forceinline__ void attn_unit(LAS unsigned char* lds, const AttnJob& J, const LAS float* biasL, int tid, int wid, int lane) {
    const int q = lane & 31, hi = lane >> 5;
    bf16x8 qf[4];
    f32x16 o0, o1; float lrun = 0.f;
#pragma unroll
    for (int i = 0; i < 16; ++i) { o0[i] = 0.f; o1[i] = 0.f; }
    float mrun = 0.f;
    bf16x8 pf[2][2];
#pragma unroll
    for (int a = 0; a < 2; ++a)
#pragma unroll
        for (int b = 0; b < 2; ++b) pf[a][b] = (bf16x8){0, 0, 0, 0, 0, 0, 0, 0};
    const int srow = tid >> 3;
    const int gch = (tid & 7) ^ ((srow >> 1) & 7);
    const int pi = (q & 0x13) | ((q & 4) << 1) | ((q & 8) >> 1);
    const int kx = (pi >> 1) & 7, vx = (q >> 1) & 7;
    const int rq = J.r0 + (wid >> 1), cq = (wid & 1) * 32 + q;
    const int rs_ = min(max(rq - 4, 0), 24), cs_ = min(max(cq - 8, 0), 48);
    unsigned vmask = 0u;
    if (J.na) {
#pragma unroll
        for (int i = 0; i < 32; ++i) { const int kc = 32 * (i >> 4) + 16 * ((i >> 3) & 1) + 8 * hi + (i & 7); vmask |= ((unsigned)(kc - cs_) < 16u ? 1u : 0u) << i; }
    }
    const int blane = 8 * hi - cq + 15 + 48;
    const bool fast = J.fast != 0;
    const bf16_t* kg = J.K + (size_t)srow * J.kpitch + gch * 8;
    const bf16_t* vg = J.Vt + (size_t)srow * T + gch * 8;
    const unsigned ldsw0 = (unsigned)(unsigned long long)lds + (unsigned)wid * 1024u;
#define ATT_ISSUE(tile, vslot) do { const int t_ = (tile); const int tk_ = t_ < 4 ? J.ctx_row0 + 64 * t_ : J.lat_row0 + 64 * (t_ - 4); \
        glds16(kg + (size_t)tk_ * J.kpitch, (unsigned)__builtin_amdgcn_readfirstlane((int)(ldsw0 + (t_ & 3) * 8192))); \
        glds16(vg + tk_, (unsigned)__builtin_amdgcn_readfirstlane((int)(ldsw0 + 32768 + (vslot) * 8192))); } while (0)
    ATT_ISSUE(0, 0); ATT_ISSUE(1, 1); ATT_ISSUE(2, 2);
    { const bf16_t* qrow = J.Q + (size_t)(wid * 32 + q) * J.qpitch + 8 * hi;
#pragma unroll
      for (int ks = 0; ks < 4; ++ks) qf[ks] = *(const bf16x8*)(qrow + 16 * ks); }
    asm volatile("s_waitcnt vmcnt(0) lgkmcnt(0)" :: "v"(qf[0]), "v"(qf[1]), "v"(qf[2]), "v"(qf[3]) : "memory");
    __builtin_amdgcn_s_barrier(); asm volatile("" ::: "memory");
    int vcur = 0, vprev = 4;
    for (int it = 0; it < J.ntiles; ++it) {
        const LAS unsigned char* kb_ = lds + (it & 3) * 8192;
        const int vnext = vcur == 4 ? 0 : vcur + 1;
        if (it + 3 < J.ntiles) { const int v3 = vcur + 3 >= 5 ? vcur - 2 : vcur + 3; ATT_ISSUE(it + 3, v3); }
        const int kr = J.rlo + it - 4;
        const bool local = J.na && it >= 4;
        const bool active = !local || (kr >= rs_ && kr < rs_ + 8);
        const LAS float* bp = biasL + (kr - rq + 7) * 128 + blane;
        if (active) {
            if (fast && !local) att_tile_fast(kb_, lds + 32768 + vcur * 8192, qf, pi, kx, q, vx, hi, o0, o1, lrun);
            else {
                if (fast) att_scores<true>(kb_, qf, pi, kx, hi, local, bp, vmask, it == 0, mrun, o0, o1, lrun, pf); else att_scores<false>(kb_, qf, pi, kx, hi, local, bp, vmask, it == 0, mrun, o0, o1, lrun, pf);
                att_pv(lds + 32768 + vcur * 8192, q, vx, hi, pf, o0, o1);
            }
        }
        const int ny = J.ntiles - (it + 2);
        if (ny >= 2) asm volatile("s_waitcnt vmcnt(4)" ::: "memory"); else if (ny == 1) asm volatile("s_waitcnt vmcnt(2)" ::: "memory"); else asm volatile("s_waitcnt vmcnt(0)" ::: "memory");
        __builtin_amdgcn_s_barrier(); asm volatile("" ::: "memory");
        vprev = vcur; vcur = vnext;
    }
#undef ATT_ISSUE
    const float inv = fast_rcp(lrun + __shfl_xor(lrun, 32));
    bf16_t* orow = J.O + (size_t)(wid * 32 + q) * D + 4 * hi;
#pragma unroll
    for (int c = 0; c < 4; ++c) {
        u32x2 w0, w1;
        w0.x = pk2(o0[4 * c] * inv, o0[4 * c + 1] * inv); w0.y = pk2(o0[4 * c + 2] * inv, o0[4 * c + 3] * inv);
        w1.x = pk2(o1[4 * c] * inv, o1[4 * c + 1] * inv); w1.y = pk2(o1[4 * c + 2] * inv, o1[4 * c + 3] * inv);
        *(u32x2*)(orow + 8 * c) = w0; *(u32x2*)(orow + 32 + 8 * c) = w1;
    }
}

__device__ __forceinline__ void pool_unit(LAS unsigned char* lds, const bf16_t* PC, const float* wpool, const float* pscale, bf16_t* Y, int unit, int tid) {
    const int row0 = unit * 64;
    const int seq0 = row0 < TL ? (row0 & ~(SEQ - 1)) : TL + ((row0 - TL) & ~(LCTX - 1));
    const int N = row0 < TL ? SEQ : LCTX;
    const int t0 = row0 - seq0;
    LAS unsigned short* vin = (LAS unsigned short*)lds;
    constexpr int PP = 264;
    LAS unsigned short* pooled = (LAS unsigned short*)(lds + 40960);
    for (int i = tid; i < 80 * 32; i += 512) {
        const int lr = i >> 5, ch8 = i & 31, t = t0 - 8 + lr;
        u32x4 v = (u32x4){0u, 0u, 0u, 0u};
        if (t >= 0 && t < N) v = *(const u32x4*)(PC + (size_t)(seq0 + t) * 256 + ch8 * 8);
        *(LAS u32x4*)(lds + (lr * 256 + ch8 * 8) * 2) = v;
    }
    __syncthreads();
    {
        const int ch = tid & 255, th = tid >> 8, g = ch >> 6, hw = 1 << g;
        const LAS unsigned short* vp = vin + (th * 32 + 8) * 256 + ch;
        float s = 0.f;
        for (int k = -hw; k < hw; ++k) s += bf2f(vp[k * 256]);
#pragma unroll 8
        for (int i = 0; i < 32; ++i) {
            const int tl = th * 32 + i, t = t0 + tl;
            const int lo = max(t - hw, 0), hi2 = min(t + hw, N);
            pooled[tl * PP + ch] = (unsigned short)f2bf(s * fast_rcp((float)(hi2 - lo)) - bf2f(vp[i * 256]));
            s += bf2f(vp[(i + hw) * 256]) - bf2f(vp[(i - hw) * 256]);
        }
    }
    __syncthreads();
    {
        const int lane = tid & 63, wid = tid >> 6, g = wid & 3, th = wid >> 2, q = lane & 31, hi = lane >> 5;
        const float* wg = wpool + (size_t)g * 64 * 64;
        bf16x8 af[4];
#pragma unroll
        for (int ks = 0; ks < 4; ++ks) af[ks] = *(const LAS bf16x8*)(pooled + (th * 32 + q) * PP + g * 64 + 16 * ks + 8 * hi);
#pragma unroll
        for (int db = 0; db < 2; ++db) {
            f32x16 dacc;
#pragma unroll
            for (int i = 0; i < 16; ++i) dacc[i] = 0.f;
#pragma unroll
            for (int ks = 0; ks < 4; ++ks) {
                const float* wp = wg + (size_t)(16 * ks + 8 * hi) * 64 + 32 * db + q;
                u32x4 w; w.x = pk2(wp[0], wp[64]); w.y = pk2(wp[128], wp[192]); w.z = pk2(wp[256], wp[320]); w.w = pk2(wp[384], wp[448]);
                dacc = MFMA32(af[ks], __builtin_bit_cast(bf16x8, w), dacc);
            }
            const int col = g * 64 + 32 * db + q;
            const float sc = pscale[col];
#pragma unroll
            for (int r = 0; r < 16; ++r) { const int tok = 8 * (r >> 2) + 4 * hi + (r & 3);
                Y[(size_t)(row0 + th * 32 + tok) * D + 768 + col] = (bf16_t)f2bf(dacc[r] * sc); }
        }
    }
    __syncthreads();
}

__device__ __forceinline__ void mixer_phase(KArgsPtr a, int l, bool lastl, LAS unsigned char* lds, unsigned* ctr, int tid_) {
    unsigned char* ws = a->ws;
    const bf16_t* big = (const bf16_t*)(ws + WS_BIG);
    bf16_t* Y = (bf16_t*)(ws + WS_U);
    constexpr int NG = NB * 6 * 8, NN = NB * 6 * 8, NCA = NB * 6, NCB = NB * 6;
    const int ncx = lastl ? 0 : NCA + NCB;
    const int npool = (lastl ? TL : T) / 64;
    const int total0 = NG + NN + ncx + npool;
    const int total = total0 + (MIX_DUP == 1 ? NG : MIX_DUP == 2 ? NN : MIX_DUP == 3 ? npool : 0);
    LAS int* shu = (LAS int*)(lds + LDS_MISC);
    LAS float* biasL = (LAS float*)(lds + 73728);
    int fastA, fastB, fastN;
    { const int ln = tid_ & 63;
      float qa = fabsf(a->in[9][l * 64 + ln]), ka = fabsf(a->in[10][l * 64 + ln]), qb = fabsf(a->in[11][l * 64 + ln]), kb = fabsf(a->in[12][l * 64 + ln]), bm = 0.f;
      for (int i = ln; i < 6 * 465; i += 64) bm = fmaxf(bm, fabsf(a->in[13][(size_t)l * 6 * 465 + i]));
#pragma unroll
      for (int o = 1; o < 64; o <<= 1) { qa = fmaxf(qa, __shfl_xor(qa, o)); ka = fmaxf(ka, __shfl_xor(ka, o)); qb = fmaxf(qb, __shfl_xor(qb, o)); kb = fmaxf(kb, __shfl_xor(kb, o)); bm = fmaxf(bm, __shfl_xor(bm, o)); }
      fastA = __builtin_amdgcn_readfirstlane((int)(11.5416f * qa * ka < 60.f));
      fastB = __builtin_amdgcn_readfirstlane((int)(11.5416f * qb * kb < 60.f));
      fastN = __builtin_amdgcn_readfirstlane((int)(11.5416f * qa * ka + bm * LOG2E < 60.f)); }
    if (tid_ == 0) shu[0] = (int)atomicAdd(ctr, 1u);
    __syncthreads();
    int u = __builtin_amdgcn_readfirstlane(shu[0]);
    for (int uit = 0;; ++uit) {
        int tid = tid_; asm volatile("" : "+v"(tid));
        const int lane = tid & 63, wid = __builtin_amdgcn_readfirstlane(tid >> 6);
        if (u >= total) break;
        if (u >= total0) u = u - total0 + (MIX_DUP == 2 ? NG : MIX_DUP == 3 ? NG + NN + ncx : 0);
        int nxt_ = 0; if (tid == 0) nxt_ = (int)atomicAdd(ctr, 1u);
        if (u < NG + NN + ncx) {
            AttnJob J;
            if (u < NG) {
                const int qb = u & 7, hq = (u >> 3) % 6, b = u / 48, hkv = hq / 3;
                J.Q = big + B_QB + (size_t)(b * SEQ + qb * 256) * 384 + hq * 64; J.qpitch = 384;
                J.K = big + B_KB + hkv * 64; J.kpitch = 128; J.Vt = big + B_VBT + (size_t)(hkv * 64) * T;
                J.O = Y + (size_t)(b * SEQ + qb * 256) * D + 384 + hq * 64;
                J.ctx_row0 = TL + b * LCTX; J.lat_row0 = b * SEQ; J.ntiles = 4 + 32; J.na = 0; J.r0 = 0; J.rlo = 0;
                J.fast = fastB;
            } else if ((u -= NG) < NN) {
                const int rg = u & 7, h = (u >> 3) % 6, b = u / 48, r0 = rg * 4;
                const int rlo = min(max(r0 - 4, 0), 24), rhi = min(max(r0 + 3 - 4, 0), 24) + 8;
                const float* rpb = a->in[13] + ((size_t)l * 6 + h) * 15 * 31;
                for (int i = tid; i < 15 * 128; i += 512) { const int dc = (i & 127) - 48; biasL[i] = (dc >= 0 && dc < 31) ? rpb[(i >> 7) * 31 + dc] * LOG2E : 0.f; }
                J.Q = big + B_QA + (size_t)(b * SEQ + r0 * 64) * 384 + h * 64; J.qpitch = 384;
                J.K = big + B_KA + h * 64; J.kpitch = 384; J.Vt = big + B_VAT + (size_t)(h * 64) * T;
                J.O = Y + (size_t)(b * SEQ + r0 * 64) * D + h * 64;
                J.ctx_row0 = TL + b * LCTX; J.lat_row0 = b * SEQ + rlo * 64; J.ntiles = 4 + (rhi - rlo); J.na = 1; J.r0 = r0; J.rlo = rlo;
                J.fast = fastN;
            } else {
                u -= NN;
                const bool second = u >= NCA; if (second) u -= NCA;
                const int h = u % 6, b = u / 6;
                if (!second) { J.Q = big + B_QA + (size_t)(TL + b * LCTX) * 384 + h * 64; J.K = big + B_KA + h * 64; J.kpitch = 384; J.Vt = big + B_VAT + (size_t)(h * 64) * T; J.O = Y + (size_t)(TL + b * LCTX) * D + h * 64; }
                else { const int hkv = h / 3; J.Q = big + B_QB + (size_t)(TL + b * LCTX) * 384 + h * 64; J.K = big + B_KB + hkv * 64; J.kpitch = 128; J.Vt = big + B_VBT + (size_t)(hkv * 64) * T; J.O = Y + (size_t)(TL + b * LCTX) * D + 384 + h * 64; }
                J.qpitch = 384; J.ctx_row0 = TL + b * LCTX; J.lat_row0 = 0; J.ntiles = 4; J.na = 0; J.r0 = 0; J.rlo = 0;
                J.fast = second ? fastB : fastA;
            }
            attn_unit(lds, J, biasL, tid, wid, lane);
        } else {
            u -= NG + NN + ncx;
            pool_unit(lds, big + B_PC, a->in[14] + (size_t)l * 4 * 64 * 64, a->in[15] + (size_t)l * 256, Y, u, tid);
        }
        if (tid == 0) shu[(uit + 1) & 1] = nxt_;
        __syncthreads();
        u = __builtin_amdgcn_readfirstlane(shu[(uit + 1) & 1]);
    }
}


#define XB_TMO      128
#define XB_XCNT(j)  (256  + 64 * (j))
#define XB_XSUB(j)  (1280 + 64 * (j))
#define XB_XGEN(j)  (2304 + 64 * (j))
#define XB_TOP      3328
#define XB_TOPGEN   3392
#define XB_SPIN_CAP (1u << 22)
constexpr int CW_BAR = 4096;
__device__ __forceinline__ unsigned xb_ld(unsigned* p)              { return __hip_atomic_load(p, __ATOMIC_RELAXED, __HIP_MEMORY_SCOPE_AGENT); }
__device__ __forceinline__ unsigned xb_add(unsigned* p, unsigned v) { return __hip_atomic_fetch_add(p, v, __ATOMIC_RELAXED, __HIP_MEMORY_SCOPE_AGENT); }
__device__ __forceinline__ unsigned xb_xcc_id() { return (unsigned)__builtin_amdgcn_s_getreg((3 << 11) | 20) & 0xFu; }
#define XB_SPIN(cond, bar) do { unsigned _sp = 0; while (cond) { __builtin_amdgcn_s_sleep(1); \
    if ((++_sp & 255u) == 0u) { if (xb_ld(&(bar)[XB_TMO])) break; if (_sp > XB_SPIN_CAP) { atomicAdd(&(bar)[XB_TMO], 1u); break; } } } } while (0)
__device__ __forceinline__ void xcd_barrier_complete(unsigned* bar, unsigned x, unsigned& nloc, unsigned& nx) {
    const unsigned G = gridDim.x * gridDim.y * gridDim.z;
    unsigned sum, cnt, mine, sp = 0u;
    for (;;) {
        sum = 0u; cnt = 0u; mine = 0u;
#pragma unroll
        for (unsigned j = 0; j < 16; ++j) { const unsigned c = xb_ld(&bar[XB_XCNT(j)]); sum += c; cnt += (c > 0u) ? 1u : 0u; mine = (j == x) ? c : mine; }
        if (sum == G) break;
        __builtin_amdgcn_s_sleep(1);
        if ((++sp & 255u) == 0u) { if (xb_ld(&bar[XB_TMO])) break; if (sp > XB_SPIN_CAP) { atomicAdd(&bar[XB_TMO], 1u); break; } }
    }
    nloc = mine > 0u ? mine : 1u; nx = cnt > 0u ? cnt : 1u;
}
__device__ __forceinline__ void xcd_barrier(unsigned* bar, volatile LAS unsigned* st) {
    asm volatile("s_waitcnt vmcnt(0)" ::: "memory");
    __syncthreads();
    if (threadIdx.x == 0) {
        const unsigned x = xb_xcc_id();
        __builtin_amdgcn_s_waitcnt(0);
        unsigned nloc = st[0], nx = st[1];
        if (nloc == 0u) { xcd_barrier_complete(bar, x, nloc, nx); st[0] = nloc; st[1] = nx; }
        const unsigned old = xb_add(&bar[XB_XSUB(x)], 1u);
        const unsigned gen = old / nloc;
        if (old + 1u == (gen + 1u) * nloc) {
            __builtin_amdgcn_fence(__ATOMIC_RELEASE, "agent");
            asm volatile("s_waitcnt vmcnt(0)" ::: "memory");
            const unsigned og = xb_add(&bar[XB_TOP], 1u);
            const unsigned tg = og / nx;
            if (og + 1u == (tg + 1u) * nx) xb_add(&bar[XB_TOPGEN], 1u);
            else XB_SPIN(xb_ld(&bar[XB_TOPGEN]) == tg, bar);
            __builtin_amdgcn_fence(__ATOMIC_ACQUIRE, "agent");
            xb_add(&bar[XB_XGEN(x)], 1u);
            asm volatile("s_waitcnt vmcnt(0)" ::: "memory");
        } else {
            XB_SPIN(xb_ld(&bar[XB_XGEN(x)]) == gen, bar);
            __builtin_amdgcn_fence(__ATOMIC_ACQUIRE, "agent");
            asm volatile("s_waitcnt vmcnt(0)" ::: "memory");
        }
    }
    __syncthreads();
}

__device__ __forceinline__ KArgsPtr fresh_args() {
    KArgsPtr p = (KArgsPtr)__builtin_amdgcn_kernarg_segment_ptr();
    asm volatile("" : "+s"(p) :: "memory");
    return p;
}
#define IN(k) (lo <= (k) && (k) < hi)
#define SEAM(k) do { if ((k) + 1 < hi) { if (lo < 0) { __threadfence(); cg::this_grid().sync(); } else xcd_barrier((unsigned*)(a_.ws + WS_CTL) + CW_BAR, (volatile LAS unsigned*)(lds + LDS_MISC + 16)); } } while (0)
#define PH_COMMON KArgsPtr a = fresh_args(); unsigned char* ws = a->ws; int tid = threadIdx.x; asm volatile("" : "+v"(tid)); const int lane = tid & 63, wid = __builtin_amdgcn_readfirstlane(tid >> 6); \
    int G = __builtin_amdgcn_readfirstlane((int)gridDim.x), c = __builtin_amdgcn_readfirstlane((int)blockIdx.x); \
    bf16_t* U = (bf16_t*)(ws + WS_U); bf16_t* BIG = (bf16_t*)(ws + WS_BIG); float* modall = (float*)(ws + WS_MOD); float* hbuf = (float*)(ws + WS_H); float* xout = a->out; \
    const bool lastl = (l == DEPTH - 1); const float* modl = modall + (size_t)l * 33 * NMOD; const float* xs = l == 0 ? a->in[0] : xout; const float* hs = l == 0 ? a->in[2] : hbuf; const int M = lastl ? TL : T; \
    (void)tid; (void)lane; (void)wid; (void)G; (void)c; (void)U; (void)BIG; (void)hbuf; (void)modl; (void)xs; (void)hs; (void)M; (void)lastl; (void)xout;
__global__ void __launch_bounds__(512, 2) mega_fwd(Args a_) {
    extern __shared__ __attribute__((aligned(16))) unsigned char lds_raw[];
    LAS unsigned char* lds = (LAS unsigned char*)lds_raw;
    const int lo = a_.ph_lo, hi = a_.ph_hi;
    if (threadIdx.x == 0) { ((volatile LAS unsigned*)(lds + LDS_MISC + 16))[0] = 0u; ((volatile LAS unsigned*)(lds + LDS_MISC + 16))[1] = 0u;
        (void)xb_add((unsigned*)(a_.ws + WS_CTL) + CW_BAR + XB_XCNT(xb_xcc_id()), 1u); }
    __syncthreads();
    if (IN(0)) { const int l = 0; PH_COMMON prep_phase(a, lds, tid, wid, lane, c, G);
#if PREP_DOUBLE
        xcd_barrier((unsigned*)(a_.ws + WS_CTL) + CW_BAR, (volatile LAS unsigned*)(lds + LDS_MISC + 16)); prep_phase(a, lds, tid, wid, lane, c, G);
#endif
        SEAM(0); }
    if (IN(1)) { const int l = 0; PH_COMMON
        pg8::Gemm g{(const bf16_t*)(ws + WS_SC), (const bf16_t*)(ws + WS_BIG), 256, DEPTH * NMOD, D};
        pg8::StaticOrder S; S.init(256, DEPTH * NMOD, G, c);
        EpiMod E{modall, a->in[5]};
        pg8::gemm_phase<EpiMod, pg8::StaticOrder, false, true>(lds, g, S, E, tid);
        SEAM(1);
    }
#pragma unroll 1
    for (int l = 0; l < DEPTH; ++l) {
        const int pb = 2 + 8 * l;
        if (IN(pb + 0) && l == 0) { for (int rep_ = 0; rep_ < ((REP_MASK >> 0) & 1) + 1; ++rep_) { if (rep_) { xcd_barrier((unsigned*)(a_.ws + WS_CTL) + CW_BAR, (volatile LAS unsigned*)(lds + LDS_MISC + 16)); } PH_COMMON norm_phase(xs, hs, a->in[6] + l * D, modl, 0, T, U, wid, lane, c, G); } SEAM(pb + 0); }
        if (IN(pb + 1)) { for (int rep_ = 0; rep_ < ((REP_MASK >> 1) & 1) + 1; ++rep_) { if (rep_) { xcd_barrier((unsigned*)(a_.ws + WS_CTL) + CW_BAR, (volatile LAS unsigned*)(lds + LDS_MISC + 16)); } PH_COMMON
            pg8::Gemm g{U, (const bf16_t*)(ws + WS_WIN) + (size_t)l * NIN * D, T, NIN, D};
            pg8::StaticOrder S; S.init(lastl ? TL : T, NIN, G, c); if (lastl) S.xtra = (TC / 256) * 5; S.rev = l & 1; S.pnrev = 1 - (l & 1);
            EpiIn E{BIG, a->in[9] + l * 64, a->in[10] + l * 64, a->in[11] + l * 64, a->in[12] + l * 64, (const f32x2*)(ws + WS_ROPE)};
            pg8::gemm_phase<EpiIn, pg8::StaticOrder, true, true>(lds, g, S, E, tid, ((c >> 3) & 3) * STG_K1024);
            } SEAM(pb + 1);
        }
        if (IN(pb + 2)) { for (int rep_ = 0; rep_ < ((REP_MASK >> 2) & 1) + 1; ++rep_) { if (rep_) { xcd_barrier((unsigned*)(a_.ws + WS_CTL) + CW_BAR, (volatile LAS unsigned*)(lds + LDS_MISC + 16)); } PH_COMMON mixer_phase(a, l, lastl, lds, (unsigned*)(ws + WS_CTL) + 64 * (1 + l + 8 * rep_), tid); } SEAM(pb + 2); }
        if (IN(pb + 3)) { for (int rep_ = 0; rep_ < ((REP_MASK >> 3) & 1) + 1; ++rep_) { if (rep_) { xcd_barrier((unsigned*)(a_.ws + WS_CTL) + CW_BAR, (volatile LAS unsigned*)(lds + LDS_MISC + 16)); } PH_COMMON
            pg8::Gemm g{U, (const bf16_t*)(ws + WS_WBR) + (size_t)l * D * D, M, D, D};
            pg8::StaticOrder S; S.init(M, D, G, c);
            S.dbl = 0; S.rev = 1 - (l & 1); EpiMerge E{BIG + B_G, BIG};
            pg8::gemm_phase<EpiMerge, pg8::StaticOrder, true, true>(lds, g, S, E, tid, ((c >> 3) & 3) * STG_K1024);
            } SEAM(pb + 3);
        }
        if (IN(pb + 4)) { PH_COMMON
            pg8::Gemm g{BIG, (const bf16_t*)(ws + WS_WOUT) + (size_t)l * D * D, M, D, D};
            pg8::PanelOrder S; S.init(M, G, c); S.rev = (l & 1) ? 1 : 2;
            EpiResNorm E{xs, xout, hs, hbuf, modl, 2 * D, a->in[7] + l * D, modl, 3 * D, U, (float*)(ws + WS_SLOTS), (unsigned*)(ws + WS_CTL + CTL_PANEL) + (l * 2 + 0) * 512, lds + LDS_XCH};
            pg8::gemm_phase<EpiResNorm, pg8::PanelOrder, true, true>(lds, g, S, E, tid);
            SEAM(pb + 4);
        }
        if (IN(pb + 6)) { for (int rep_ = 0; rep_ < ((REP_MASK >> 6) & 1) + 1; ++rep_) { if (rep_) { xcd_barrier((unsigned*)(a_.ws + WS_CTL) + CW_BAR, (volatile LAS unsigned*)(lds + LDS_MISC + 16)); } PH_COMMON
            pg8::Gemm g{U, (const bf16_t*)(ws + WS_W13) + (size_t)l * 2 * FF * D, M, 2 * FF, D};
            pg8::StaticOrder S; S.init(M, 2 * FF, G, c); S.rev = 1 - (l & 1);
            EpiFF1 E{BIG};
            pg8::gemm_phase<EpiFF1, pg8::StaticOrder, true, true>(lds, g, S, E, tid, ((c >> 3) & 3) * STG_K1024);
            } SEAM(pb + 6);
        }
        if (IN(pb + 7)) { PH_COMMON
            pg8::Gemm g{BIG, (const bf16_t*)(ws + WS_W2) + (size_t)l * D * FF, M, D, FF};
            if (lastl) {
                pg8::StaticOrder S; S.init(M, D, G, c); S.rev = 1;
                EpiRes E{xout, xout, hbuf, hbuf, modl, 5 * D};
                pg8::gemm_phase<EpiRes, pg8::StaticOrder, true, true>(lds, g, S, E, tid, ((c >> 3) & 3) * STG_K2816);
            } else {
                pg8::PanelOrder S; S.init(M, G, c); S.rev = (l & 1) ? 1 : 2;
                EpiResNorm E{xout, xout, hbuf, hbuf, modl, 5 * D, a->in[6] + (l + 1) * D, modall + (size_t)(l + 1) * 33 * NMOD, 0, U, (float*)(ws + WS_SLOTS), (unsigned*)(ws + WS_CTL + CTL_PANEL) + (l * 2 + 1) * 512, lds + LDS_XCH};
                pg8::gemm_phase<EpiResNorm, pg8::PanelOrder, true, true>(lds, g, S, E, tid);
            }
            SEAM(pb + 7);
        }
    }
}
#undef IN
#undef SEAM

extern "C" void kernel_launch(void* const* d_in, const int* in_sizes, int n_in, void* d_out, int out_size, void* d_ws, size_t ws_size, hipStream_t stream) {
    static int grid = 0;
    if (grid == 0) {
        if (n_in != 23 || out_size != TL * D || ws_size < WS_END2) { fprintf(stderr, "kernel_launch: unexpected shapes (n_in %d out %d ws %zu need %zu)\n", n_in, out_size, ws_size, (size_t)WS_END2); grid = -1; return; }
        int dev = 0, cus = 0, per_cu = 0;
        hipGetDevice(&dev); hipDeviceGetAttribute(&cus, hipDeviceAttributeMultiprocessorCount, dev);
        if (hipFuncSetAttribute((const void*)mega_fwd, hipFuncAttributeMaxDynamicSharedMemorySize, LDS_BYTES) != hipSuccess) { fprintf(stderr, "kernel_launch: hipFuncSetAttribute failed\n"); grid = -1; return; }
        if (hipOccupancyMaxActiveBlocksPerMultiprocessor(&per_cu, (const void*)mega_fwd, 512, LDS_BYTES) != hipSuccess || per_cu < 1) { fprintf(stderr, "kernel_launch: occupancy query gave %d\n", per_cu); per_cu = 1; }
        (void)hipGetLastError();
        grid = cus;
        fprintf(stderr, "kernel_launch: cus %d per_cu %d grid %d ws %zu\n", cus, per_cu, grid, ws_size);
    }
    if (grid < 0) return;
    hipMemsetAsync((char*)d_ws + WS_CTL, 0, CTL_BYTES, stream);
    Args a{};
    for (int i = 0; i < 23; ++i) a.in[i] = (const float*)d_in[i];
    a.out = (float*)d_out; a.ws = (unsigned char*)d_ws;
    for (int i = 0; i < 16; ++i) a.freq[i] = (float)pow(10000.0, -(double)i / 16.0);
#if MK_PER_PHASE
    for (int ph = 0; ph < NPH; ++ph) { a.ph_lo = ph; a.ph_hi = ph + 1; hipLaunchKernelGGL(mega_fwd, dim3(grid), dim3(512), LDS_BYTES, stream, a); }
#else
    a.ph_lo = 0; a.ph_hi = NPH;
    void* args[] = {&a};
    hipError_t e = hipLaunchCooperativeKernel((const void*)mega_fwd, dim3(grid), dim3(512), args, LDS_BYTES, stream);
    if (e != hipSuccess) fprintf(stderr, "kernel_launch: cooperative launch failed: %s (grid %d)\n", hipGetErrorString(e), grid);
#endif
}
```
